# Optimizing an MI355X kernel written in HIP

```python
import jax, jax.numpy as jnp
from jax import lax
import numpy as np

D_MODEL = 2048
BATCH = 2
SEQ = 4096
DEPTH = 2

GRID_W = 64
CTX_LEN = 256
EPS = 1e-6
GLA_WIDTH = D_MODEL // 2
POOL_WIDTH = D_MODEL - GLA_WIDTH
GLA_HEADS = 4
GLA_DV = GLA_WIDTH // GLA_HEADS
GLA_DK = GLA_DV // 2
GLA_KEY_WIDTH = GLA_HEADS * GLA_DK
GATE_RANK = 16
GATE_TAU = 16.0
CHUNK = 64
POOL_WINDOWS = (2, 4, 8, 16)
POOL_GROUPS = len(POOL_WINDOWS)
POOL_GW = POOL_WIDTH // POOL_GROUPS
IN_WIDTH = 2 * GLA_KEY_WIDTH + 2 * GLA_WIDTH + POOL_WIDTH + 2 * GATE_RANK
SPLITS = (GLA_KEY_WIDTH, 2 * GLA_KEY_WIDTH, 2 * GLA_KEY_WIDTH + GLA_WIDTH,
          2 * GLA_KEY_WIDTH + 2 * GLA_WIDTH, 2 * GLA_KEY_WIDTH + 2 * GLA_WIDTH + POOL_WIDTH)
D_FF = ((8 * D_MODEL // 3 + 255) // 256) * 256
N_EXPERTS = 8
TOP_K = 2
EXPERT_FF = D_FF
N_DENSE = (DEPTH + 1) // 2
N_MOE = DEPTH // 2

kernel_name = 'hybrid_gla_pool_moe_dit'


def rmsnorm(x, g):
    xf = x.astype(jnp.float32)
    xf = xf * lax.rsqrt(jnp.mean(xf * xf, axis=-1, keepdims=True) + EPS)
    return (xf * g.astype(jnp.float32)).astype(x.dtype)


def to_heads(t, d):
    b, l, _ = t.shape
    return t.reshape(b, l, -1, d).transpose(0, 2, 1, 3)


def gla_chunked(q, k, v, log_a, s0):
    bsz, nh, L, _ = q.shape
    dv = v.shape[-1]
    nc = L // CHUNK

    def blocks(t):
        return t.astype(jnp.float32).reshape(bsz, nh, nc, CHUNK, t.shape[-1]).transpose(2, 0, 1, 3, 4)

    lower = jnp.tril(jnp.ones((CHUNK, CHUNK), dtype=bool))[:, :, None]

    def step(state, blk):
        qb, kb, vb, ab = blk
        cum = jnp.cumsum(ab, axis=2)
        o_inter = jnp.einsum('bhtd,bhdv->bhtv', qb * jnp.exp(cum), state)
        diff = cum[:, :, :, None, :] - cum[:, :, None, :, :]
        decay = jnp.where(lower, jnp.exp(jnp.minimum(diff, 0.0)), 0.0)
        scores = jnp.einsum('bhtd,bhsd,bhtsd->bhts', qb, kb, decay)
        o_intra = jnp.einsum('bhts,bhsv->bhtv', scores, vb)
        last = cum[:, :, -1:, :]
        new_state = (jnp.exp(last[:, :, 0, :])[..., None] * state
                     + jnp.einsum('bhsd,bhsv->bhdv', kb * jnp.exp(last - cum), vb))
        return new_state, o_inter + o_intra

    s_fin, o = lax.scan(step, s0, (blocks(q), blocks(k), blocks(v), blocks(log_a)))
    o = o.transpose(1, 2, 0, 3, 4).reshape(bsz, nh, L, dv)
    return o, s_fin


def gla_bidir(q, k, v, lg_f, lg_b, s0_f, s0_b):
    o_f, s_f = gla_chunked(q, k, v, lg_f, s0_f)
    flip = lambda t: jnp.flip(t, axis=2)
    o_b, s_b = gla_chunked(flip(q), flip(k), flip(v), flip(lg_b), s0_b)
    return o_f + flip(o_b), s_f, s_b


def gla_readout(o, g, gain):
    bsz, _, L, _ = o.shape
    o = o * lax.rsqrt(jnp.mean(o * o, axis=-1, keepdims=True) + EPS)
    o = o.transpose(0, 2, 1, 3).reshape(bsz, L, GLA_WIDTH)
    return (o * gain.astype(jnp.float32) * jax.nn.silu(g.astype(jnp.float32))).astype(g.dtype)


def centred_pool_minus_self(u, window):
    L = u.shape[2]
    uf = u.astype(jnp.float32)
    cs = jnp.concatenate([jnp.zeros_like(uf[:, :, :1]), jnp.cumsum(uf, axis=2)], axis=2)
    j = np.arange(L)
    lo = np.clip(j - window // 2, 0, L)
    hi = np.clip(j - window // 2 + window, 0, L)
    win_sum = jnp.take(cs, hi, axis=2) - jnp.take(cs, lo, axis=2)
    cnt = jnp.asarray(hi - lo, dtype=jnp.float32)[:, None]
    return (win_sum / cnt - uf).astype(u.dtype)


def pool_mix(p, w_pool_l, scale_l, rows):
    bsz, L, _ = p.shape
    pg = p.reshape(bsz, rows, L // rows, POOL_GROUPS, POOL_GW)
    mixed = jnp.stack([centred_pool_minus_self(pg[..., gi, :], w) for gi, w in enumerate(POOL_WINDOWS)], axis=3)
    out = jnp.einsum('brwgc,gcd->brwgd', mixed, w_pool_l)
    return out.reshape(bsz, L, POOL_WIDTH) * scale_l


def project(h, w_in_l, w_gate_l, b_gate_l):
    u = h @ w_in_l
    q, k, v, g, p, r = jnp.split(u, SPLITS, axis=-1)
    q = to_heads(q, GLA_DK) * (GLA_DK ** -0.5)
    k = to_heads(k, GLA_DK)
    v = to_heads(v, GLA_DV)
    lgs = []
    for d in range(2):
        pre = r[..., d * GATE_RANK:(d + 1) * GATE_RANK] @ w_gate_l[d] + b_gate_l[d]
        lgs.append(to_heads(jax.nn.log_sigmoid(pre.astype(jnp.float32)) / GATE_TAU, GLA_DK))
    return q, k, v, g, p, lgs[0], lgs[1]


def swiglu(h, w1, w3, w2):
    return (jax.nn.silu(h @ w1) * (h @ w3)) @ w2


def moe_swiglu(h, w_r, b_r, w1, w3, w2):
    logits = (h @ w_r).astype(jnp.float32) + b_r.astype(jnp.float32)
    probs = jax.nn.softmax(logits, axis=-1)
    top_p, top_i = lax.top_k(probs, TOP_K)
    top_p = top_p / jnp.sum(top_p, axis=-1, keepdims=True)
    gates = jnp.sum(jax.nn.one_hot(top_i, N_EXPERTS, dtype=jnp.float32) * top_p[..., None], axis=-2)
    gates = gates.astype(h.dtype)
    y = jnp.zeros_like(h)
    for e in range(N_EXPERTS):
        y = y + gates[..., e:e + 1] * swiglu(h, w1[e], w3[e], w2[e])
    return y


def setup_inputs(seed: int = 0) -> dict:
    key = jax.random.key(seed)
    ks = jax.random.split(key, 24)
    f32 = jnp.float32
    D = D_MODEL

    def nrm(k, shape, scale):
        return jax.random.normal(k, shape, f32) * scale

    return {
        'x': nrm(ks[0], (BATCH, SEQ, D), 1.0),
        'c': nrm(ks[1], (BATCH, D), 1.0),
        'ctx': nrm(ks[2], (BATCH, CTX_LEN, D), 1.0),
        'c_ctx': nrm(ks[3], (D,), 1.0),
        'w_ada': nrm(ks[4], (DEPTH, D, 6 * D), 0.5 * D ** -0.5),
        'b_ada': nrm(ks[5], (DEPTH, 6 * D), 0.02),
        'norm1_g': 1.0 + nrm(ks[6], (DEPTH, D), 0.02),
        'norm2_g': 1.0 + nrm(ks[7], (DEPTH, D), 0.02),
        'w_in': nrm(ks[8], (DEPTH, D, IN_WIDTH), D ** -0.5),
        'w_gate': nrm(ks[9], (DEPTH, 2, GATE_RANK, GLA_KEY_WIDTH), GATE_RANK ** -0.5),
        'b_gate': nrm(ks[10], (DEPTH, 2, GLA_KEY_WIDTH), 0.5),
        'gla_norm_g': 1.0 + nrm(ks[11], (DEPTH, GLA_WIDTH), 0.02),
        'w_pool': nrm(ks[12], (DEPTH, POOL_GROUPS, POOL_GW, POOL_GW), POOL_GW ** -0.5),
        'pool_scale': 1.0 + nrm(ks[13], (DEPTH, POOL_WIDTH), 0.1),
        'w_out': nrm(ks[14], (DEPTH, D, D), D ** -0.5),
        'ffn_w1': nrm(ks[15], (N_DENSE, D, D_FF), D ** -0.5),
        'ffn_w3': nrm(ks[16], (N_DENSE, D, D_FF), D ** -0.5),
        'ffn_w2': nrm(ks[17], (N_DENSE, D_FF, D), D_FF ** -0.5),
        'moe_w_router': nrm(ks[18], (N_MOE, D, N_EXPERTS), D ** -0.5),
        'moe_b_router': nrm(ks[19], (N_MOE, N_EXPERTS), 0.01),
        'moe_w1': nrm(ks[20], (N_MOE, N_EXPERTS, D, EXPERT_FF), D ** -0.5),
        'moe_w3': nrm(ks[21], (N_MOE, N_EXPERTS, D, EXPERT_FF), D ** -0.5),
        'moe_w2': nrm(ks[22], (N_MOE, N_EXPERTS, EXPERT_FF, D), EXPERT_FF ** -0.5),
        'final_g': 1.0 + nrm(ks[23], (D,), 0.02),
    }


def reference(x, c, ctx, c_ctx, w_ada, b_ada, norm1_g, norm2_g, w_in, w_gate, b_gate, gla_norm_g,
              w_pool, pool_scale, w_out, ffn_w1, ffn_w3, ffn_w2, moe_w_router, moe_b_router,
              moe_w1, moe_w3, moe_w2, final_g):
    bsz, n_lat, _ = x.shape
    rows = n_lat // GRID_W
    zero_state = jnp.zeros((bsz, GLA_HEADS, GLA_DK, GLA_DV), jnp.float32)

    def ffn(h, i):
        if i % 2 == 0:
            j = i // 2
            return swiglu(h, ffn_w1[j], ffn_w3[j], ffn_w2[j])
        j = i // 2
        return moe_swiglu(h, moe_w_router[j], moe_b_router[j], moe_w1[j], moe_w3[j], moe_w2[j])

    x_lat = x
    x_ctx = ctx
    for i in range(DEPTH):
        last = i == DEPTH - 1
        mod = (jax.nn.silu(c) @ w_ada[i] + b_ada[i])[:, None, :]
        mod_c = (jax.nn.silu(c_ctx) @ w_ada[i] + b_ada[i])[None, None, :]
        sh1, sc1, g1, sh2, sc2, g2 = jnp.split(mod, 6, axis=-1)
        csh1, csc1, cg1, csh2, csc2, cg2 = jnp.split(mod_c, 6, axis=-1)

        h = rmsnorm(x_lat, norm1_g[i]) * (1.0 + sc1) + sh1
        hc = rmsnorm(x_ctx, norm1_g[i]) * (1.0 + csc1) + csh1
        q, k, v, g, p, lgf, lgb = project(h, w_in[i], w_gate[i], b_gate[i])
        qc, kc, vc, gc, pc, lgfc, lgbc = project(hc, w_in[i], w_gate[i], b_gate[i])
        o_c, s_f, s_b = gla_bidir(qc, kc, vc, lgfc, lgbc, zero_state, zero_state)
        o_l, _, _ = gla_bidir(q, k, v, lgf, lgb, s_f, s_b)
        y = jnp.concatenate([gla_readout(o_l, g, gla_norm_g[i]),
                             pool_mix(p, w_pool[i], pool_scale[i], rows)], axis=-1) @ w_out[i]
        x_lat = x_lat + g1 * y

        h2 = rmsnorm(x_lat, norm2_g[i]) * (1.0 + sc2) + sh2
        x_lat = x_lat + g2 * ffn(h2, i)

        if not last:
            yc = jnp.concatenate([gla_readout(o_c, gc, gla_norm_g[i]),
                                  pool_mix(pc, w_pool[i], pool_scale[i], 1)], axis=-1) @ w_out[i]
            x_ctx = x_ctx + cg1 * yc
            h2c = rmsnorm(x_ctx, norm2_g[i]) * (1.0 + csc2) + csh2
            x_ctx = x_ctx + cg2 * ffn(h2c, i)

    return rmsnorm(x_lat, final_g)
```

```cpp
#include <hip/hip_runtime.h>
#include <cstdio>
#include <cstdint>
#include <cstring>

#define LAS __attribute__((address_space(3)))
typedef unsigned short bf16_t;
typedef short bf16x8 __attribute__((ext_vector_type(8)));
typedef float f32x4 __attribute__((ext_vector_type(4)));
typedef float f32x2 __attribute__((ext_vector_type(2)));
typedef unsigned u32x4 __attribute__((ext_vector_type(4)));
typedef unsigned u32x2 __attribute__((ext_vector_type(2)));

constexpr int D = 2048, NBATCH = 2, SEQ = 4096, CTXL = 256;
constexpr int ML = NBATCH * SEQ;
constexpr int MC = NBATCH * CTXL;
constexpr int MA = ML + MC;
constexpr int INW = 4128, INWP = 4352;
constexpr int DFF = 5632, NE = 8;
constexpr int GH = 4, DK = 128, DV = 256;
constexpr int C_Q = 0, C_K = 512, C_V = 1024, C_G = 2048, C_P = 3072, C_R = 4096;
constexpr float EPS = 1e-6f;
constexpr int MODW = 6 * D;

constexpr size_t MiB = 1u << 20;
constexpr size_t WS_CTL = 0;
constexpr size_t WS_MODV = 1 * MiB;
constexpr size_t WS_GATES = 2 * MiB;
constexpr size_t WS_R = 3 * MiB;
constexpr size_t WS_WPOOL = 5 * MiB;
constexpr size_t WS_WIN = 6 * MiB;
constexpr size_t WS_WOUT = 40 * MiB;
constexpr size_t WS_W13 = 56 * MiB;
constexpr size_t WS_W2 = 100 * MiB;
constexpr size_t WS_MW13 = 122 * MiB;
constexpr size_t WS_MW2 = 474 * MiB;
constexpr size_t WS_XR = 650 * MiB;
constexpr size_t WS_XN = 718 * MiB;
constexpr size_t WS_U = 752 * MiB;
constexpr size_t WS_Y = 825 * MiB;
constexpr size_t WS_MIX = 859 * MiB;
constexpr size_t WS_HH = 876 * MiB;
constexpr size_t WS_O = 1074 * MiB;
constexpr size_t WS_END = 1142 * MiB;

namespace pg8 {
constexpr int BM = 256, BK = 64, HALF = 128, HTB = HALF * BK * 2, STAGE_BYTES = 8 * HTB, NXCD = 8, WGM = 8;
__host__ __device__ __forceinline__ int lds_byte(int r, int c) { const int st = (r >> 4) * 2 + (c >> 5), rr = r & 15, cc = c & 31, ob = rr * 64 + cc * 2; return st * 1024 + (ob ^ (((ob >> 9) & 1) << 5)); }
__host__ __device__ __forceinline__ void stage_rc(int b, int& R, int& C) { const int st = b / 1024, sb = b % 1024, swz = sb ^ (((sb >> 9) & 1) << 5); R = (st >> 1) * 16 + swz / 64; C = (st & 1) * 32 + (swz % 64) / 2; }
__host__ __device__ __forceinline__ int perm32(int rho) { const int n = rho >> 4, i = rho & 15; return 8 * (i >> 2) + 4 * n + (i & 3); }

struct Unit { const char* a; const char* b; int pm, pn; };
struct Gemm { int K, lda, ldb, pad; };

struct TileOrder {
    const char* A; const char* Bt; size_t a_mstep, a_nstep, b_nstep; int nM, nN, nwg, G, c;
    __device__ __forceinline__ bool next(int i, Unit& u) const {
        const long L = (long)i * G + c; if (L >= nwg) return false;
        int wgid = (int)L; { const int q = nwg / NXCD, r = nwg % NXCD, xcd = wgid % NXCD, off = wgid / NXCD; wgid = (xcd < r ? xcd * (q + 1) : r * (q + 1) + (xcd - r) * q) + off; }
        const int nig = WGM * nN, gid = wgid / nig, fm = gid * WGM, gsz = (nM - fm) < WGM ? (nM - fm) : WGM;
        u.pm = fm + ((wgid % nig) % gsz); u.pn = (wgid % nig) / gsz;
        u.a = A + (size_t)u.pm * a_mstep + (size_t)u.pn * a_nstep; u.b = Bt + (size_t)u.pn * b_nstep; return true;
    }
};

__device__ __forceinline__ unsigned cvt_pk_bf16(float lo, float hi) { unsigned r; asm volatile("v_cvt_pk_bf16_f32 %0, %1, %2" : "=v"(r) : "v"(lo), "v"(hi)); return r; }

template <class Epi, class Sched, bool ALIGN_EPI>
__device__ __forceinline__ void gemm_phase(LAS unsigned char* lds, const Gemm g, const Sched& S, const Epi& E) {
    const int tid = threadIdx.x, wid = __builtin_amdgcn_readfirstlane(tid >> 6), lane = tid & 63, wr = wid >> 2, wc = wid & 3, fr = lane & 15, fq = lane >> 4;
    const int K = g.K, nt = K / BK;
    unsigned voffA[2], voffB[2];
#pragma unroll
    for (int i = 0; i < 2; ++i) { int R, C; stage_rc(tid * 16 + i * 8192, R, C); const int Rb = Epi::PERM ? ((R & ~31) + perm32(R & 31)) : R;
        voffA[i] = (unsigned)(R * g.lda + C) * 2u; voffB[i] = (unsigned)(Rb * g.ldb + C) * 2u; }
    const size_t kstep = (size_t)(BK * 2);
    const size_t hA = (size_t)HALF * g.lda * 2, hB = (size_t)HALF * g.ldb * 2;
    const unsigned ldsw = (unsigned)wid * 1024u;
    const int aoff = lds_byte(wr * 64 + fr, fq * 8), boff = lds_byte(wc * 32 + fr, fq * 8);
#define PG8_SA(b, h) (((b) * 2 + (h)) * HTB)
#define PG8_SB(b, h) ((4 + (b) * 2 + (h)) * HTB)
#define PG8_STAGE(bufoff, gbase, voff) do { _Pragma("unroll") for (int _i = 0; _i < 2; ++_i) \
        __builtin_amdgcn_global_load_lds((const unsigned*)((const char*)(gbase) + (voff)[_i]), (LAS unsigned*)(lds + (bufoff) + ldsw + _i * 8192), 16, 0, 0); } while (0)
#define PG8_LDA(dst, b, h) do { _Pragma("unroll") for (int m = 0; m < 4; ++m) _Pragma("unroll") for (int k = 0; k < 2; ++k) dst[m][k] = *(const LAS bf16x8*)(lds + PG8_SA(b, h) + aoff + m * 2048 + k * 1024); } while (0)
#define PG8_LDB(dst, b, h) do { _Pragma("unroll") for (int n = 0; n < 2; ++n) _Pragma("unroll") for (int k = 0; k < 2; ++k) dst[n][k] = *(const LAS bf16x8*)(lds + PG8_SB(b, h) + boff + n * 2048 + k * 1024); } while (0)
#define PG8_MMA(ai, bj, At, Bt) do { __builtin_amdgcn_s_setprio(1); _Pragma("unroll") for (int m = 0; m < 4; ++m) _Pragma("unroll") for (int n = 0; n < 2; ++n) _Pragma("unroll") for (int k = 0; k < 2; ++k) \
        acc[ai][bj][m][n] = __builtin_amdgcn_mfma_f32_16x16x32_bf16(Bt[n][k], At[m][k], acc[ai][bj][m][n], 0, 0, 0); __builtin_amdgcn_s_setprio(0); } while (0)
#define PG8_WAIT_V(n) asm volatile("s_waitcnt vmcnt(" #n ")" ::: "memory")
#define PG8_WAIT_L(n) asm volatile("s_waitcnt lgkmcnt(" #n ")" ::: "memory")
#define PG8_BAR __builtin_amdgcn_s_barrier()
#define PG8_SCHED __builtin_amdgcn_sched_barrier(0)
    Unit cur, nxt; int ui = 0;
    if (!S.next(0, cur)) return;
    f32x4 acc[2][2][4][2];
#pragma unroll
    for (int a = 0; a < 2; ++a)
#pragma unroll
        for (int b = 0; b < 2; ++b)
#pragma unroll
            for (int m = 0; m < 4; ++m)
#pragma unroll
                for (int n = 0; n < 2; ++n) acc[a][b][m][n] = (f32x4){0.f, 0.f, 0.f, 0.f};
    bf16x8 At[4][2], B0[2][2], B1[2][2];
    const char* cA = cur.a; const char* cB = cur.b;
    PG8_STAGE(PG8_SB(0, 0), cB, voffB); PG8_STAGE(PG8_SB(0, 1), cB + hB, voffB); PG8_STAGE(PG8_SA(0, 0), cA, voffA); PG8_STAGE(PG8_SA(0, 1), cA + hA, voffA);
    if (wr == 1) PG8_BAR;
    PG8_WAIT_V(2); PG8_BAR;
    PG8_STAGE(PG8_SB(1, 0), cB + kstep, voffB); PG8_STAGE(PG8_SA(1, 0), cA + kstep, voffA); PG8_STAGE(PG8_SB(1, 1), cB + hB + kstep, voffB);
    PG8_WAIT_V(6); PG8_BAR;
    for (;;) {
        const bool has_next = S.next(ui + 1, nxt);
        const char* nA = has_next ? nxt.a : cA; const char* nB = has_next ? nxt.b : cB;
        for (int t = 0; t < nt; t += 2) {
            const bool last = (t == nt - 2);
            const char* a1 = cA + (size_t)(t + 1) * kstep;
            const char* a2 = last ? nA : cA + (size_t)(t + 2) * kstep; const char* b2 = last ? nB : cB + (size_t)(t + 2) * kstep;
            const char* a3 = a2 + kstep; const char* b3 = b2 + kstep;
            PG8_LDB(B0, 0, 0); PG8_LDB(B1, 0, 1); PG8_SCHED; PG8_LDA(At, 0, 0); PG8_STAGE(PG8_SA(1, 1), a1 + hA, voffA);
            PG8_WAIT_V(8); PG8_WAIT_L(0); PG8_BAR; PG8_MMA(0, 0, At, B0); PG8_MMA(0, 1, At, B1); PG8_BAR; PG8_SCHED;
            PG8_LDA(At, 0, 1); PG8_STAGE(PG8_SB(0, 0), b2, voffB); PG8_STAGE(PG8_SB(0, 1), b2 + hB, voffB); PG8_STAGE(PG8_SA(0, 0), a2, voffA);
            PG8_WAIT_V(8); PG8_WAIT_L(0); PG8_BAR; PG8_MMA(1, 0, At, B0); PG8_MMA(1, 1, At, B1); PG8_BAR; PG8_SCHED;
            PG8_LDB(B0, 1, 0); PG8_LDB(B1, 1, 1); PG8_SCHED; PG8_LDA(At, 1, 0); PG8_STAGE(PG8_SA(0, 1), a2 + hA, voffA);
            PG8_WAIT_V(8); PG8_WAIT_L(0); PG8_BAR; PG8_MMA(0, 0, At, B0); PG8_MMA(0, 1, At, B1); PG8_BAR; PG8_SCHED;
            PG8_LDA(At, 1, 1); PG8_STAGE(PG8_SB(1, 0), b3, voffB); PG8_STAGE(PG8_SB(1, 1), b3 + hB, voffB); PG8_STAGE(PG8_SA(1, 0), a3, voffA);
            PG8_WAIT_V(8); PG8_WAIT_L(0); PG8_BAR; PG8_MMA(1, 0, At, B0); PG8_MMA(1, 1, At, B1); PG8_BAR; PG8_SCHED;
        }
        if constexpr (ALIGN_EPI) { if (wr == 0) PG8_BAR; }
        E(acc, cur, wr, wc, fr, fq);
        if (!has_next) break;
#pragma unroll
        for (int a = 0; a < 2; ++a)
#pragma unroll
            for (int b = 0; b < 2; ++b)
#pragma unroll
                for (int m = 0; m < 4; ++m)
#pragma unroll
                    for (int n = 0; n < 2; ++n) acc[a][b][m][n] = (f32x4){0.f, 0.f, 0.f, 0.f};
        cur = nxt; cA = nA; cB = nB; ++ui;
        if constexpr (ALIGN_EPI) { if (wr == 1) PG8_BAR; }
    }
    PG8_WAIT_V(0);
    if constexpr (!ALIGN_EPI) { if (wr == 0) PG8_BAR; }
    PG8_BAR;
#undef PG8_SA
#undef PG8_SB
#undef PG8_STAGE
#undef PG8_LDA
#undef PG8_LDB
#undef PG8_MMA
#undef PG8_WAIT_V
#undef PG8_WAIT_L
#undef PG8_BAR
#undef PG8_SCHED
}
}
using pg8::cvt_pk_bf16;
typedef f32x4 Acc[2][2][4][2];

__device__ __forceinline__ float bf2f(bf16_t v) { return __uint_as_float(((unsigned)v) << 16); }
__device__ __forceinline__ float siluf(float a) { return a / (1.f + __expf(-a)); }
__device__ __forceinline__ int mod_index(int row) { return row < SEQ ? 0 : (row < ML ? 1 : 2); }

struct EpiIn {
    static constexpr bool PERM = true;
    bf16_t* U; float* R;
    __device__ __forceinline__ void operator()(const Acc& acc, const pg8::Unit& u, int wr, int wc, int fr, int fq) const {
        const int row0 = u.pm * 256 + wr * 64 + fr, col0 = u.pn * 256 + wc * 32 + 8 * fq;
        const float sc = (u.pn < 2) ? 0.08838834764831845f : 1.f;
#pragma unroll
        for (int ai = 0; ai < 2; ++ai)
#pragma unroll
            for (int m = 0; m < 4; ++m) { const int row = row0 + ai * 128 + m * 16; bf16_t* rowp = U + (size_t)row * INWP + col0;
#pragma unroll
                for (int bj = 0; bj < 2; ++bj) { const f32x4 v0 = acc[ai][bj][m][0] * sc, v1 = acc[ai][bj][m][1] * sc;
                    u32x4 w; w.x = cvt_pk_bf16(v0[0], v0[1]); w.y = cvt_pk_bf16(v0[2], v0[3]); w.z = cvt_pk_bf16(v1[0], v1[1]); w.w = cvt_pk_bf16(v1[2], v1[3]);
                    *(u32x4*)(rowp + bj * 128) = w; }
                if (u.pn == 16 && wc == 0) { float* rp = R + (size_t)row * 32 + 8 * fq; *(f32x4*)rp = acc[ai][0][m][0]; *(f32x4*)(rp + 4) = acc[ai][0][m][1]; } }
    }
};
struct EpiPool {
    static constexpr bool PERM = true;
    bf16_t* Y; const float* scale;
    __device__ __forceinline__ void operator()(const Acc& acc, const pg8::Unit& u, int wr, int wc, int fr, int fq) const {
        const int row0 = u.pm * 256 + wr * 64 + fr, col0 = u.pn * 256 + wc * 32 + 8 * fq;
        f32x4 sv[2][2];
#pragma unroll
        for (int bj = 0; bj < 2; ++bj)
#pragma unroll
            for (int n = 0; n < 2; ++n) sv[bj][n] = *(const f32x4*)(scale + col0 + bj * 128 + 4 * n);
#pragma unroll
        for (int ai = 0; ai < 2; ++ai)
#pragma unroll
            for (int m = 0; m < 4; ++m) { bf16_t* rowp = Y + (size_t)(row0 + ai * 128 + m * 16) * D + 1024 + col0;
#pragma unroll
                for (int bj = 0; bj < 2; ++bj) { const f32x4 v0 = acc[ai][bj][m][0] * sv[bj][0], v1 = acc[ai][bj][m][1] * sv[bj][1];
                    u32x4 w; w.x = cvt_pk_bf16(v0[0], v0[1]); w.y = cvt_pk_bf16(v0[2], v0[3]); w.z = cvt_pk_bf16(v1[0], v1[1]); w.w = cvt_pk_bf16(v1[2], v1[3]);
                    *(u32x4*)(rowp + bj * 128) = w; } }
    }
};
struct EpiResid {
    static constexpr bool PERM = false;
    const float* src_lat; const float* src_ctx; float* XR; const float* gate; const float* rowgate; int rg_stride, ctx_row0;
    __device__ __forceinline__ void operator()(const Acc& acc, const pg8::Unit& u, int wr, int wc, int fr, int fq) const {
        const int row0 = u.pm * 256 + wr * 64 + fr, col0 = u.pn * 256 + wc * 32 + 4 * fq;
        const int mi = u.pm < 16 ? 0 : (u.pm < 32 ? 1 : 2);
        const float* src = u.pm < 32 ? src_lat : src_ctx - (size_t)ctx_row0 * D;
        f32x4 gv[2][2];
#pragma unroll
        for (int bj = 0; bj < 2; ++bj)
#pragma unroll
            for (int n = 0; n < 2; ++n) gv[bj][n] = *(const f32x4*)(gate + (size_t)mi * MODW + col0 + bj * 128 + n * 16);
#pragma unroll
        for (int ai = 0; ai < 2; ++ai)
#pragma unroll
            for (int m = 0; m < 4; ++m) { const int row = row0 + ai * 128 + m * 16; const size_t off = (size_t)row * D + col0;
                const float rg = rowgate ? rowgate[(size_t)row * rg_stride] : 1.f;
#pragma unroll
                for (int bj = 0; bj < 2; ++bj)
#pragma unroll
                    for (int n = 0; n < 2; ++n) { const f32x4 bs = *(const f32x4*)(src + off + bj * 128 + n * 16);
                        *(f32x4*)(XR + off + bj * 128 + n * 16) = bs + gv[bj][n] * acc[ai][bj][m][n] * rg; } }
    }
};
struct EpiSwiglu {
    static constexpr bool PERM = true;
    bf16_t* H; int ldh, pad;
    __device__ __forceinline__ void operator()(const Acc& acc, const pg8::Unit& u, int wr, int wc, int fr, int fq) const {
        const int row0 = u.pm * 256 + wr * 64 + fr, col0 = u.pn * 128 + wc * 32 + 8 * fq;
#pragma unroll
        for (int ai = 0; ai < 2; ++ai)
#pragma unroll
            for (int m = 0; m < 4; ++m) { bf16_t* rowp = H + (size_t)(row0 + ai * 128 + m * 16) * ldh + col0;
                float h[8];
#pragma unroll
                for (int n = 0; n < 2; ++n)
#pragma unroll
                    for (int j = 0; j < 4; ++j) h[n * 4 + j] = siluf(acc[ai][0][m][n][j]) * acc[ai][1][m][n][j];
                u32x4 w; w.x = cvt_pk_bf16(h[0], h[1]); w.y = cvt_pk_bf16(h[2], h[3]); w.z = cvt_pk_bf16(h[4], h[5]); w.w = cvt_pk_bf16(h[6], h[7]);
                *(u32x4*)rowp = w; }
    }
};

struct GemmArgs { const char* A; const char* Bt; size_t a_mstep, a_nstep, b_nstep; int nM, nN, K, lda, ldb, pad; };
template <class Epi, bool ALIGN> __global__ void __launch_bounds__(512, 2) k_gemm(GemmArgs ga, Epi E) {
    extern __shared__ __attribute__((aligned(16))) unsigned char lds[];
    pg8::TileOrder S; S.A = ga.A; S.Bt = ga.Bt; S.a_mstep = ga.a_mstep; S.a_nstep = ga.a_nstep; S.b_nstep = ga.b_nstep; S.nM = ga.nM; S.nN = ga.nN; S.nwg = ga.nM * ga.nN; S.G = gridDim.x; S.c = blockIdx.x;
    pg8::Gemm g; g.K = ga.K; g.lda = ga.lda; g.ldb = ga.ldb; g.pad = 0;
    pg8::gemm_phase<Epi, pg8::TileOrder, ALIGN>((LAS unsigned char*)lds, g, S, E);
}

__device__ __forceinline__ float wave_sum(float v) {
#pragma unroll
    for (int o = 1; o < 64; o <<= 1) v += __shfl_xor(v, o);
    return v;
}
__device__ __forceinline__ unsigned f2bf(float f) { unsigned u = __float_as_uint(f); return (u + 0x7fffu + ((u >> 16) & 1u)) >> 16; }

struct CvtArgs { const float* src; bf16_t* dst; size_t src_mstride, dst_mstride; int K, N, NP, nb, rs, off, nmat, pad; };
__global__ void __launch_bounds__(256) k_convert(CvtArgs a) {
    __shared__ float t[64][65];
    const int ktiles = a.K / 64, ntiles = a.NP / 64, per = ktiles * ntiles, total = per * a.nmat;
    for (int it = blockIdx.x; it < total; it += gridDim.x) {
        const int mat = it / per, r = it % per, kt = r / ntiles, nt = r % ntiles, k0 = kt * 64, n0 = nt * 64;
        const float* src = a.src + (size_t)mat * a.src_mstride; bf16_t* dst = a.dst + (size_t)mat * a.dst_mstride;
        const int tid = threadIdx.x;
#pragma unroll 4
        for (int i = 0; i < 16; ++i) { const int kk = i * 4 + (tid >> 6), nn = tid & 63; t[kk][nn] = (n0 + nn < a.N) ? src[(size_t)(k0 + kk) * a.N + n0 + nn] : 0.f; }
        __syncthreads();
        const int nn = tid >> 2, kq = tid & 3, n = n0 + nn;
        const int drow = (n / a.nb) * a.rs + (n % a.nb) + a.off;
        unsigned w[8];
#pragma unroll
        for (int j = 0; j < 8; ++j) w[j] = f2bf(t[kq * 16 + 2 * j][nn]) | (f2bf(t[kq * 16 + 2 * j + 1][nn]) << 16);
        u32x4* dp = (u32x4*)(dst + (size_t)drow * a.K + k0 + kq * 16);
        dp[0] = (u32x4){w[0], w[1], w[2], w[3]}; dp[1] = (u32x4){w[4], w[5], w[6], w[7]};
        __syncthreads();
    }
}

__global__ void __launch_bounds__(256) k_ada(const float* c, const float* c_ctx, const float* w_ada, const float* b_ada, float* modv) {
    __shared__ float sc[3][D];
    for (int i = threadIdx.x; i < 3 * D; i += 256) { const int r = i / D, k = i % D; const float v = r < 2 ? c[r * D + k] : c_ctx[k]; sc[r][k] = v / (1.f + expf(-v)); }
    __syncthreads();
    const int gi = blockIdx.x * 256 + threadIdx.x; if (gi >= 2 * MODW) return;
    const int l = gi / MODW, n = gi % MODW;
    const float* w = w_ada + (size_t)l * D * MODW + n;
    float a0 = 0.f, a1 = 0.f, a2 = 0.f;
#pragma unroll 8
    for (int k = 0; k < D; ++k) { const float wv = w[(size_t)k * MODW]; a0 += sc[0][k] * wv; a1 += sc[1][k] * wv; a2 += sc[2][k] * wv; }
    const float bv = b_ada[l * MODW + n];
    modv[((size_t)l * 3 + 0) * MODW + n] = a0 + bv; modv[((size_t)l * 3 + 1) * MODW + n] = a1 + bv; modv[((size_t)l * 3 + 2) * MODW + n] = a2 + bv;
}

__global__ void __launch_bounds__(256) k_ln(const float* src_lat, const float* src_ctx, int ctx_row0, const float* gn, const float* sh, const float* sc, bf16_t* XN, int nrows) {
    const int row = blockIdx.x * 4 + (threadIdx.x >> 6), lane = threadIdx.x & 63; if (row >= nrows) return;
    const float* x = row < ML ? src_lat + (size_t)row * D : src_ctx + (size_t)(row - ctx_row0) * D;
    const int mi = mod_index(row);
    f32x4 v[8]; float s = 0.f;
#pragma unroll
    for (int j = 0; j < 8; ++j) { v[j] = *(const f32x4*)(x + 4 * lane + 256 * j); s += (v[j].x * v[j].x + v[j].y * v[j].y) + (v[j].z * v[j].z + v[j].w * v[j].w); }
    const float rstd = 1.0f / sqrtf(wave_sum(s) * (1.f / D) + EPS);
#pragma unroll
    for (int j = 0; j < 8; ++j) { const int c = 4 * lane + 256 * j;
        const f32x4 g = *(const f32x4*)(gn + c), a = *(const f32x4*)(sc + (size_t)mi * MODW + c), b = *(const f32x4*)(sh + (size_t)mi * MODW + c);
        const f32x4 h = v[j] * rstd * g * (a + 1.0f) + b;
        u32x2 w; w.x = cvt_pk_bf16(h.x, h.y); w.y = cvt_pk_bf16(h.z, h.w); *(u32x2*)(XN + (size_t)row * D + c) = w; }
}

__global__ void __launch_bounds__(256) k_gla_naive(const bf16_t* U, const float* R, const float* wg, const float* bg, float* O) {
    __shared__ float qs[DK], ks[DK], al[DK];
    const int blk = blockIdx.x, dir = blk & 1, h = (blk >> 1) & 3, b = blk >> 3, j = threadIdx.x;
    float S[DK];
#pragma unroll
    for (int d = 0; d < DK; ++d) S[d] = 0.f;
    float wgr[16]; float bgv = 0.f; const int dd = j & 127;
#pragma unroll
    for (int i = 0; i < 16; ++i) wgr[i] = wg[((size_t)dir * 16 + i) * 512 + h * DK + dd];
    bgv = bg[dir * 512 + h * DK + dd];
    for (int s = 0; s < CTXL + SEQ; ++s) {
        int row;
        if (dir == 0) row = s < CTXL ? ML + b * CTXL + s : b * SEQ + (s - CTXL);
        else row = s < CTXL ? ML + b * CTXL + (CTXL - 1 - s) : b * SEQ + (SEQ - 1 - (s - CTXL));
        if (j < DK) {
            float pre = bgv;
#pragma unroll
            for (int i = 0; i < 16; ++i) pre += R[(size_t)row * 32 + dir * 16 + i] * wgr[i];
            const float ls = fminf(pre, 0.f) - log1pf(expf(-fabsf(pre)));
            al[dd] = expf(ls * (1.f / 16.f));
            qs[dd] = bf2f(U[(size_t)row * INWP + C_Q + h * DK + dd]);
        } else ks[dd] = bf2f(U[(size_t)row * INWP + C_K + h * DK + dd]);
        __syncthreads();
        const float v = bf2f(U[(size_t)row * INWP + C_V + h * DV + j]);
        float o = 0.f;
#pragma unroll
        for (int d = 0; d < DK; ++d) { S[d] = al[d] * S[d] + ks[d] * v; o += qs[d] * S[d]; }
        O[((size_t)dir * MA + row) * 1024 + h * DV + j] = o;
        __syncthreads();
    }
}
__global__ void __launch_bounds__(256) k_readout(const float* O, const bf16_t* U, const float* gain, bf16_t* Y, int nrows) {
    const int wv = blockIdx.x * 4 + (threadIdx.x >> 6), lane = threadIdx.x & 63; if (wv >= nrows * GH) return;
    const int row = wv >> 2, h = wv & 3, c = h * DV + 4 * lane;
    const f32x4 o = *(const f32x4*)(O + (size_t)row * 1024 + c) + *(const f32x4*)(O + ((size_t)MA + row) * 1024 + c);
    const float ss = wave_sum((o.x * o.x + o.y * o.y) + (o.z * o.z + o.w * o.w));
    const float rstd = 1.0f / sqrtf(ss * (1.f / DV) + EPS);
    const f32x4 gn = *(const f32x4*)(gain + c);
    const u32x2 gw = *(const u32x2*)(U + (size_t)row * INWP + C_G + c);
    const float g0 = __uint_as_float(gw.x << 16), g1 = __uint_as_float(gw.x & 0xffff0000u), g2 = __uint_as_float(gw.y << 16), g3 = __uint_as_float(gw.y & 0xffff0000u);
    u32x2 w; w.x = cvt_pk_bf16(o.x * rstd * gn.x * siluf(g0), o.y * rstd * gn.y * siluf(g1)); w.y = cvt_pk_bf16(o.z * rstd * gn.z * siluf(g2), o.w * rstd * gn.w * siluf(g3));
    *(u32x2*)(Y + (size_t)row * D + c) = w;
}
__global__ void __launch_bounds__(256) k_pool(const bf16_t* U, bf16_t* MIX, int nrows) {
    const int gi = blockIdx.x * 256 + threadIdx.x; if (gi >= nrows * 128) return;
    const int row = gi >> 7, ch = (gi & 127) * 8, grp = ch >> 8, w = 2 << grp;
    int L, j, base;
    if (row < ML) { L = 64; j = row & 63; base = row - j; } else { L = CTXL; j = (row - ML) & (CTXL - 1); base = row - j; }
    int lo = j - w / 2, hi = lo + w; lo = lo < 0 ? 0 : lo; hi = hi > L ? L : hi;
    float s[8];
#pragma unroll
    for (int i = 0; i < 8; ++i) s[i] = 0.f;
    for (int p = lo; p < hi; ++p) { const u32x4 q = *(const u32x4*)(U + (size_t)(base + p) * INWP + C_P + ch);
        s[0] += __uint_as_float(q.x << 16); s[1] += __uint_as_float(q.x & 0xffff0000u); s[2] += __uint_as_float(q.y << 16); s[3] += __uint_as_float(q.y & 0xffff0000u);
        s[4] += __uint_as_float(q.z << 16); s[5] += __uint_as_float(q.z & 0xffff0000u); s[6] += __uint_as_float(q.w << 16); s[7] += __uint_as_float(q.w & 0xffff0000u); }
    const u32x4 q = *(const u32x4*)(U + (size_t)row * INWP + C_P + ch);
    const float self[8] = {__uint_as_float(q.x << 16), __uint_as_float(q.x & 0xffff0000u), __uint_as_float(q.y << 16), __uint_as_float(q.y & 0xffff0000u),
                           __uint_as_float(q.z << 16), __uint_as_float(q.z & 0xffff0000u), __uint_as_float(q.w << 16), __uint_as_float(q.w & 0xffff0000u)};
    const float inv = 1.f / (float)(hi - lo);
    u32x4 o; o.x = cvt_pk_bf16(s[0] * inv - self[0], s[1] * inv - self[1]); o.y = cvt_pk_bf16(s[2] * inv - self[2], s[3] * inv - self[3]);
    o.z = cvt_pk_bf16(s[4] * inv - self[4], s[5] * inv - self[5]); o.w = cvt_pk_bf16(s[6] * inv - self[6], s[7] * inv - self[7]);
    *(u32x4*)(MIX + (size_t)row * 1024 + ch) = o;
}
__global__ void __launch_bounds__(256) k_router(const float* XR, const float* gn, const float* sh, const float* sc, const float* w_r, const float* b_r, float* gates) {
    const int row = blockIdx.x * 4 + (threadIdx.x >> 6), lane = threadIdx.x & 63; if (row >= ML) return;
    const float* x = XR + (size_t)row * D; const int mi = mod_index(row);
    f32x4 v[8]; float s = 0.f;
#pragma unroll
    for (int j = 0; j < 8; ++j) { v[j] = *(const f32x4*)(x + 4 * lane + 256 * j); s += (v[j].x * v[j].x + v[j].y * v[j].y) + (v[j].z * v[j].z + v[j].w * v[j].w); }
    const float rstd = 1.0f / sqrtf(wave_sum(s) * (1.f / D) + EPS);
    float lg[8];
#pragma unroll
    for (int e = 0; e < 8; ++e) lg[e] = 0.f;
#pragma unroll
    for (int j = 0; j < 8; ++j) { const int c = 4 * lane + 256 * j;
        const f32x4 g = *(const f32x4*)(gn + c), a = *(const f32x4*)(sc + (size_t)mi * MODW + c), b = *(const f32x4*)(sh + (size_t)mi * MODW + c);
        const f32x4 h = v[j] * rstd * g * (a + 1.0f) + b;
#pragma unroll
        for (int i = 0; i < 4; ++i) { const f32x4 w0 = *(const f32x4*)(w_r + (size_t)(c + i) * 8), w1 = *(const f32x4*)(w_r + (size_t)(c + i) * 8 + 4);
            lg[0] += h[i] * w0.x; lg[1] += h[i] * w0.y; lg[2] += h[i] * w0.z; lg[3] += h[i] * w0.w; lg[4] += h[i] * w1.x; lg[5] += h[i] * w1.y; lg[6] += h[i] * w1.z; lg[7] += h[i] * w1.w; } }
#pragma unroll
    for (int e = 0; e < 8; ++e) lg[e] = wave_sum(lg[e]) + b_r[e];
    int i0 = 0; float m0 = lg[0];
#pragma unroll
    for (int e = 1; e < 8; ++e) if (lg[e] > m0) { m0 = lg[e]; i0 = e; }
    int i1 = -1; float m1 = -3.0e38f;
#pragma unroll
    for (int e = 0; e < 8; ++e) if (e != i0 && lg[e] > m1) { m1 = lg[e]; i1 = e; }
    const float p1 = expf(m1 - m0), g0 = 1.f / (1.f + p1), g1 = p1 / (1.f + p1);
    if (lane < 8) gates[(size_t)row * 8 + lane] = lane == i0 ? g0 : (lane == i1 ? g1 : 0.f);
}
__global__ void __launch_bounds__(256) k_final(const float* XR, const float* gn, float* out) {
    const int row = blockIdx.x * 4 + (threadIdx.x >> 6), lane = threadIdx.x & 63; if (row >= ML) return;
    const float* x = XR + (size_t)row * D;
    f32x4 v[8]; float s = 0.f;
#pragma unroll
    for (int j = 0; j < 8; ++j) { v[j] = *(const f32x4*)(x + 4 * lane + 256 * j); s += (v[j].x * v[j].x + v[j].y * v[j].y) + (v[j].z * v[j].z + v[j].w * v[j].w); }
    const float rstd = 1.0f / sqrtf(wave_sum(s) * (1.f / D) + EPS);
#pragma unroll
    for (int j = 0; j < 8; ++j) { const int c = 4 * lane + 256 * j; *(f32x4*)(out + (size_t)row * D + c) = v[j] * rstd * *(const f32x4*)(gn + c); }
}

template <class Epi, bool ALIGN> static void launch_gemm(hipStream_t st, const void* A, const void* Bt, size_t a_mstep, size_t a_nstep, size_t b_nstep, int nM, int nN, int K, int lda, int ldb, const Epi& E) {
    static bool attr = false;
    if (!attr) { (void)hipFuncSetAttribute((const void*)k_gemm<Epi, ALIGN>, hipFuncAttributeMaxDynamicSharedMemorySize, pg8::STAGE_BYTES); attr = true; }
    GemmArgs ga; memset(&ga, 0, sizeof ga);
    ga.A = (const char*)A; ga.Bt = (const char*)Bt; ga.a_mstep = a_mstep; ga.a_nstep = a_nstep; ga.b_nstep = b_nstep; ga.nM = nM; ga.nN = nN; ga.K = K; ga.lda = lda; ga.ldb = ldb;
    hipLaunchKernelGGL((k_gemm<Epi, ALIGN>), dim3(256), dim3(512), pg8::STAGE_BYTES, st, ga, E);
}
static void launch_cvt(hipStream_t st, const float* src, bf16_t* dst, size_t sms, size_t dms, int K, int N, int NP, int nb, int rs, int off, int nmat) {
    CvtArgs a; memset(&a, 0, sizeof a);
    a.src = src; a.dst = dst; a.src_mstride = sms; a.dst_mstride = dms; a.K = K; a.N = N; a.NP = NP; a.nb = nb; a.rs = rs; a.off = off; a.nmat = nmat;
    hipLaunchKernelGGL(k_convert, dim3(2048), dim3(256), 0, st, a);
}

extern "C" void kernel_launch(void* const* d_in, const int* in_sizes, int n_in, void* d_out, int out_size, void* d_ws, size_t ws_size, hipStream_t stream) {
    if (n_in != 24 || ws_size < WS_END || out_size != ML * D) { fprintf(stderr, "kernel_launch: unexpected sizes (n_in %d, ws %zu, out %d)\n", n_in, ws_size, out_size); return; }
    const float* x = (const float*)d_in[0]; const float* c = (const float*)d_in[1]; const float* ctx = (const float*)d_in[2]; const float* c_ctx = (const float*)d_in[3];
    const float* w_ada = (const float*)d_in[4]; const float* b_ada = (const float*)d_in[5]; const float* norm1_g = (const float*)d_in[6]; const float* norm2_g = (const float*)d_in[7];
    const float* w_in = (const float*)d_in[8]; const float* w_gate = (const float*)d_in[9]; const float* b_gate = (const float*)d_in[10]; const float* gla_g = (const float*)d_in[11];
    const float* w_pool = (const float*)d_in[12]; const float* pool_scale = (const float*)d_in[13]; const float* w_out = (const float*)d_in[14];
    const float* ffn_w1 = (const float*)d_in[15]; const float* ffn_w3 = (const float*)d_in[16]; const float* ffn_w2 = (const float*)d_in[17];
    const float* moe_wr = (const float*)d_in[18]; const float* moe_br = (const float*)d_in[19]; const float* moe_w1 = (const float*)d_in[20]; const float* moe_w3 = (const float*)d_in[21]; const float* moe_w2 = (const float*)d_in[22];
    const float* final_g = (const float*)d_in[23];
    char* ws = (char*)d_ws;
    float* MODV = (float*)(ws + WS_MODV); float* GATES = (float*)(ws + WS_GATES); float* R = (float*)(ws + WS_R);
    bf16_t* WPOOL = (bf16_t*)(ws + WS_WPOOL); bf16_t* WIN = (bf16_t*)(ws + WS_WIN); bf16_t* WOUT = (bf16_t*)(ws + WS_WOUT);
    bf16_t* W13 = (bf16_t*)(ws + WS_W13); bf16_t* W2 = (bf16_t*)(ws + WS_W2); bf16_t* MW13 = (bf16_t*)(ws + WS_MW13); bf16_t* MW2 = (bf16_t*)(ws + WS_MW2);
    float* XR = (float*)(ws + WS_XR); bf16_t* XN = (bf16_t*)(ws + WS_XN); bf16_t* U = (bf16_t*)(ws + WS_U); bf16_t* Y = (bf16_t*)(ws + WS_Y); bf16_t* MIX = (bf16_t*)(ws + WS_MIX);
    bf16_t* HH = (bf16_t*)(ws + WS_HH); float* O = (float*)(ws + WS_O);

    launch_cvt(stream, w_in, WIN, (size_t)D * INW, (size_t)INWP * D, D, INW, INWP, 1 << 30, 0, 0, 2);
    launch_cvt(stream, w_out, WOUT, (size_t)D * D, (size_t)D * D, D, D, D, 1 << 30, 0, 0, 2);
    launch_cvt(stream, w_pool, WPOOL, (size_t)256 * 256, (size_t)256 * 256, 256, 256, 256, 1 << 30, 0, 0, 8);
    launch_cvt(stream, ffn_w1, W13, 0, 0, D, DFF, DFF, 128, 256, 0, 1);
    launch_cvt(stream, ffn_w3, W13, 0, 0, D, DFF, DFF, 128, 256, 128, 1);
    launch_cvt(stream, ffn_w2, W2, 0, 0, DFF, D, D, 1 << 30, 0, 0, 1);
    launch_cvt(stream, moe_w1, MW13, (size_t)D * DFF, (size_t)2 * DFF * D, D, DFF, DFF, 128, 256, 0, NE);
    launch_cvt(stream, moe_w3, MW13, (size_t)D * DFF, (size_t)2 * DFF * D, D, DFF, DFF, 128, 256, 128, NE);
    launch_cvt(stream, moe_w2, MW2, (size_t)DFF * D, (size_t)D * DFF, DFF, D, D, 1 << 30, 0, 0, NE);
    hipLaunchKernelGGL(k_ada, dim3(2 * MODW / 256), dim3(256), 0, stream, c, c_ctx, w_ada, b_ada, MODV);

    for (int l = 0; l < 2; ++l) {
        const float* modv_l = MODV + (size_t)l * 3 * MODW;
        const float* src_lat = l == 0 ? x : XR; const float* src_ctx = l == 0 ? ctx : XR; const int ctx_row0 = l == 0 ? ML : 0;
        hipLaunchKernelGGL(k_ln, dim3(MA / 4), dim3(256), 0, stream, src_lat, src_ctx, ctx_row0, norm1_g + l * D, modv_l + 0, modv_l + D, XN, MA);
        { EpiIn E; memset(&E, 0, sizeof E); E.U = U; E.R = R;
          launch_gemm<EpiIn, true>(stream, XN, WIN + (size_t)l * INWP * D, (size_t)256 * D * 2, 0, (size_t)256 * D * 2, MA / 256, INWP / 256, D, D, D, E); }
        hipLaunchKernelGGL(k_gla_naive, dim3(16), dim3(256), 0, stream, U, R, w_gate + (size_t)l * 2 * 16 * 512, b_gate + (size_t)l * 2 * 512, O);
        hipLaunchKernelGGL(k_readout, dim3(MA), dim3(256), 0, stream, O, U, gla_g + l * 1024, Y, MA);
        hipLaunchKernelGGL(k_pool, dim3(MA * 128 / 256), dim3(256), 0, stream, U, MIX, MA);
        { EpiPool E; memset(&E, 0, sizeof E); E.Y = Y; E.scale = pool_scale + l * 1024;
          launch_gemm<EpiPool, true>(stream, MIX, WPOOL + (size_t)l * 4 * 256 * 256, (size_t)256 * 1024 * 2, (size_t)256 * 2, (size_t)256 * 256 * 2, MA / 256, 4, 256, 1024, 256, E); }
        const int nMo = (l == 0) ? MA / 256 : ML / 256;
        { EpiResid E; memset(&E, 0, sizeof E); E.src_lat = src_lat; E.src_ctx = src_ctx; E.ctx_row0 = ctx_row0; E.XR = XR; E.gate = modv_l + 2 * D; E.rowgate = nullptr; E.rg_stride = 0;
          launch_gemm<EpiResid, true>(stream, Y, WOUT + (size_t)l * D * D, (size_t)256 * D * 2, 0, (size_t)256 * D * 2, nMo, D / 256, D, D, D, E); }
        hipLaunchKernelGGL(k_ln, dim3(nMo * 256 / 4), dim3(256), 0, stream, (const float*)XR, (const float*)XR, 0, norm2_g + l * D, modv_l + 3 * D, modv_l + 4 * D, XN, nMo * 256);
        if (l == 0) {
            { EpiSwiglu E; memset(&E, 0, sizeof E); E.H = HH; E.ldh = DFF;
              launch_gemm<EpiSwiglu, true>(stream, XN, W13, (size_t)256 * D * 2, 0, (size_t)256 * D * 2, MA / 256, 2 * DFF / 256, D, D, D, E); }
            { EpiResid E; memset(&E, 0, sizeof E); E.src_lat = XR; E.src_ctx = XR; E.XR = XR; E.gate = modv_l + 5 * D; E.rowgate = nullptr; E.rg_stride = 0;
              launch_gemm<EpiResid, true>(stream, HH, W2, (size_t)256 * DFF * 2, 0, (size_t)256 * DFF * 2, MA / 256, D / 256, DFF, DFF, DFF, E); }
        } else {
            hipLaunchKernelGGL(k_router, dim3(ML / 4), dim3(256), 0, stream, (const float*)XR, norm2_g + l * D, modv_l + 3 * D, modv_l + 4 * D, moe_wr, moe_br, GATES);
            for (int e = 0; e < NE; ++e) {
                { EpiSwiglu E; memset(&E, 0, sizeof E); E.H = HH; E.ldh = DFF;
                  launch_gemm<EpiSwiglu, true>(stream, XN, MW13 + (size_t)e * 2 * DFF * D, (size_t)256 * D * 2, 0, (size_t)256 * D * 2, ML / 256, 2 * DFF / 256, D, D, D, E); }
                { EpiResid E; memset(&E, 0, sizeof E); E.src_lat = XR; E.src_ctx = XR; E.XR = XR; E.gate = modv_l + 5 * D; E.rowgate = GATES + e; E.rg_stride = 8;
                  launch_gemm<EpiResid, true>(stream, HH, MW2 + (size_t)e * D * DFF, (size_t)256 * DFF * 2, 0, (size_t)256 * DFF * 2, ML / 256, D / 256, DFF, DFF, DFF, E); }
            }
        }
    }
    hipLaunchKernelGGL(k_final, dim3(ML / 4), dim3(256), 0, stream, (const float*)XR, final_g, (float*)d_out);
}
```

```cpp
#include <hip/hip_runtime.h>
#include <cstdio>
#include <cstdint>
#include <cstring>

#define LAS __attribute__((address_space(3)))
typedef unsigned short bf16_t;
typedef short bf16x8 __attribute__((ext_vector_type(8)));
typedef float f32x4 __attribute__((ext_vector_type(4)));
typedef float f32x2 __attribute__((ext_vector_type(2)));
typedef unsigned u32x4 __attribute__((ext_vector_type(4)));
typedef unsigned u32x2 __attribute__((ext_vector_type(2)));

constexpr int D = 2048, NBATCH = 2, SEQ = 4096, CTXL = 256;
constexpr int ML = NBATCH * SEQ;
constexpr int MC = NBATCH * CTXL;
constexpr int MA = ML + MC;
constexpr int INW = 4128, INWP = 4352;
constexpr int DFF = 5632, NE = 8;
constexpr int GH = 4, DK = 128, DV = 256;
constexpr int C_Q = 0, C_K = 512, C_V = 1024, C_G = 2048, C_P = 3072, C_R = 4096;
constexpr float EPS = 1e-6f;
constexpr int MODW = 6 * D;

constexpr size_t MiB = 1u << 20;
constexpr size_t WS_CTL = 0;
constexpr size_t WS_MODV = 1 * MiB;
constexpr size_t WS_LIST = 2 * MiB;
constexpr size_t WS_GEP = WS_LIST + 256 * 1024;
constexpr size_t WS_SLOT = WS_GEP + 256 * 1024;
constexpr size_t WS_R = 3 * MiB;
constexpr size_t WS_WPOOL = 5 * MiB;
constexpr size_t WS_WIN = 6 * MiB;
constexpr size_t WS_WOUT = 40 * MiB;
constexpr size_t WS_W13 = 56 * MiB;
constexpr size_t WS_W2 = 100 * MiB;
constexpr size_t WS_MW13 = 122 * MiB;
constexpr size_t WS_MW2 = 474 * MiB;
constexpr size_t WS_XR = 650 * MiB;
constexpr size_t WS_XN = 718 * MiB;
constexpr size_t WS_U = 752 * MiB;
constexpr size_t WS_Y = 825 * MiB;
constexpr size_t WS_MIX = 859 * MiB;
constexpr size_t WS_HH = 876 * MiB;
constexpr size_t WS_QA = 1074 * MiB;
constexpr size_t WS_BT = 1096 * MiB;
constexpr size_t WS_DS = 1182 * MiB;
constexpr size_t WS_DEC = 1318 * MiB;
constexpr size_t WS_YD = WS_QA;
constexpr size_t WS_END = 1320 * MiB;
constexpr int CW_CNT = 1024;
constexpr int MOE_TAB = 131072, MOE_ROWS = 131072 + 256, MOE_MAXU = 15, MOE_LDS = MOE_ROWS + MOE_MAXU * 1024;

namespace pg8 {
constexpr int BM = 256, BK = 64, HALF = 128, HTB = HALF * BK * 2, STAGE_BYTES = 8 * HTB, NXCD = 8, WGM = 8;
__host__ __device__ __forceinline__ int lds_byte(int r, int c) { const int st = (r >> 4) * 2 + (c >> 5), rr = r & 15, cc = c & 31, ob = rr * 64 + cc * 2; return st * 1024 + (ob ^ (((ob >> 9) & 1) << 5)); }
__host__ __device__ __forceinline__ void stage_rc(int b, int& R, int& C) { const int st = b / 1024, sb = b % 1024, swz = sb ^ (((sb >> 9) & 1) << 5); R = (st >> 1) * 16 + swz / 64; C = (st & 1) * 32 + (swz % 64) / 2; }
__host__ __device__ __forceinline__ int perm32(int rho) { const int n = rho >> 4, i = rho & 15; return 8 * (i >> 2) + 4 * n + (i & 3); }

struct Unit { const char* a; const char* b; int pm, pn, e, pml; };
struct Gemm { int K, lda, ldb, pad; };

struct TileOrder {
    const char* A; const char* Bt; size_t a_mstep, a_nstep, b_nstep; int nM, nN, nwg, G, c;
    __device__ __forceinline__ bool next(int i, Unit& u) const {
        const long L = (long)i * G + c; if (L >= nwg) return false;
        int wgid = (int)L; { const int q = nwg / NXCD, r = nwg % NXCD, xcd = wgid % NXCD, off = wgid / NXCD; wgid = (xcd < r ? xcd * (q + 1) : r * (q + 1) + (xcd - r) * q) + off; }
        const int nig = WGM * nN, gid = wgid / nig, fm = gid * WGM, gsz = (nM - fm) < WGM ? (nM - fm) : WGM;
        u.pm = fm + ((wgid % nig) % gsz); u.pn = (wgid % nig) / gsz;
        u.a = A + (size_t)u.pm * a_mstep + (size_t)u.pn * a_nstep; u.b = Bt + (size_t)u.pn * b_nstep; u.e = 0; u.pml = u.pm; return true;
    }
    __device__ __forceinline__ void a_off(int, const Unit&, const int (&R)[2], const int (&C)[2], int lda, unsigned (&v)[4]) const {
#pragma unroll
        for (int hh = 0; hh < 2; ++hh)
#pragma unroll
            for (int i = 0; i < 2; ++i) v[hh * 2 + i] = (unsigned)((R[i] + hh * HALF) * lda + C[i]) * 2u;
    }
};

__device__ __forceinline__ unsigned cvt_pk_bf16(float lo, float hi) { unsigned r; asm volatile("v_cvt_pk_bf16_f32 %0, %1, %2" : "=v"(r) : "v"(lo), "v"(hi)); return r; }

template <class Epi, class Sched, bool ALIGN_EPI>
__device__ __forceinline__ void gemm_phase(LAS unsigned char* lds, const Gemm g, const Sched& S, const Epi& E) {
    const int tid = threadIdx.x, wid = __builtin_amdgcn_readfirstlane(tid >> 6), lane = tid & 63, wr = wid >> 2, wc = wid & 3, fr = lane & 15, fq = lane >> 4;
    const int K = g.K, nt = K / BK;
    unsigned voffB[2]; int sR[2], sC[2];
#pragma unroll
    for (int i = 0; i < 2; ++i) { int R, C; stage_rc(tid * 16 + i * 8192, R, C); const int Rb = Epi::PERM ? ((R & ~31) + perm32(R & 31)) : R;
        sR[i] = R; sC[i] = C; voffB[i] = (unsigned)(Rb * g.ldb + C) * 2u; }
    const size_t kstep = (size_t)(BK * 2);
    const size_t hB = (size_t)HALF * g.ldb * 2;
    const unsigned ldsw = (unsigned)wid * 1024u;
    const int aoff = lds_byte(wr * 64 + fr, fq * 8), boff = lds_byte(wc * 32 + fr, fq * 8);
#define PG8_SA(b, h) (((b) * 2 + (h)) * HTB)
#define PG8_SB(b, h) ((4 + (b) * 2 + (h)) * HTB)
#define PG8_STAGE(bufoff, gbase, voff) do { _Pragma("unroll") for (int _i = 0; _i < 2; ++_i) \
        __builtin_amdgcn_global_load_lds((const unsigned*)((const char*)(gbase) + (voff)[_i]), (LAS unsigned*)(lds + (bufoff) + ldsw + _i * 8192), 16, 0, 0); } while (0)
#define PG8_STAGEA(bufoff, gbase, voff, hh) do { _Pragma("unroll") for (int _i = 0; _i < 2; ++_i) \
        __builtin_amdgcn_global_load_lds((const unsigned*)((const char*)(gbase) + (voff)[(hh) * 2 + _i]), (LAS unsigned*)(lds + (bufoff) + ldsw + _i * 8192), 16, 0, 0); } while (0)
#define PG8_LDA(dst, b, h) do { _Pragma("unroll") for (int m = 0; m < 4; ++m) _Pragma("unroll") for (int k = 0; k < 2; ++k) dst[m][k] = *(const LAS bf16x8*)(lds + PG8_SA(b, h) + aoff + m * 2048 + k * 1024); } while (0)
#define PG8_LDB(dst, b, h) do { _Pragma("unroll") for (int n = 0; n < 2; ++n) _Pragma("unroll") for (int k = 0; k < 2; ++k) dst[n][k] = *(const LAS bf16x8*)(lds + PG8_SB(b, h) + boff + n * 2048 + k * 1024); } while (0)
#define PG8_MMA(ai, bj, At, Bt) do { __builtin_amdgcn_s_setprio(1); _Pragma("unroll") for (int m = 0; m < 4; ++m) _Pragma("unroll") for (int n = 0; n < 2; ++n) _Pragma("unroll") for (int k = 0; k < 2; ++k) \
        acc[ai][bj][m][n] = __builtin_amdgcn_mfma_f32_16x16x32_bf16(Bt[n][k], At[m][k], acc[ai][bj][m][n], 0, 0, 0); __builtin_amdgcn_s_setprio(0); } while (0)
#define PG8_WAIT_V(n) asm volatile("s_waitcnt vmcnt(" #n ")" ::: "memory")
#define PG8_WAIT_L(n) asm volatile("s_waitcnt lgkmcnt(" #n ")" ::: "memory")
#define PG8_BAR __builtin_amdgcn_s_barrier()
#define PG8_SCHED __builtin_amdgcn_sched_barrier(0)
    Unit cur, nxt; int ui = 0;
    if (!S.next(0, cur)) return;
    f32x4 acc[2][2][4][2];
#pragma unroll
    for (int a = 0; a < 2; ++a)
#pragma unroll
        for (int b = 0; b < 2; ++b)
#pragma unroll
            for (int m = 0; m < 4; ++m)
#pragma unroll
                for (int n = 0; n < 2; ++n) acc[a][b][m][n] = (f32x4){0.f, 0.f, 0.f, 0.f};
    bf16x8 At[4][2], B0[2][2], B1[2][2];
    const char* cA = cur.a; const char* cB = cur.b;
    unsigned vA[4], vN[4];
    S.a_off(0, cur, sR, sC, g.lda, vA);
    PG8_STAGE(PG8_SB(0, 0), cB, voffB); PG8_STAGE(PG8_SB(0, 1), cB + hB, voffB); PG8_STAGEA(PG8_SA(0, 0), cA, vA, 0); PG8_STAGEA(PG8_SA(0, 1), cA, vA, 1);
    if (wr == 1) PG8_BAR;
    PG8_WAIT_V(2); PG8_BAR;
    PG8_STAGE(PG8_SB(1, 0), cB + kstep, voffB); PG8_STAGEA(PG8_SA(1, 0), cA + kstep, vA, 0); PG8_STAGE(PG8_SB(1, 1), cB + hB + kstep, voffB);
    PG8_WAIT_V(6); PG8_BAR;
    for (;;) {
        const bool has_next = S.next(ui + 1, nxt);
        const char* nA = has_next ? nxt.a : cA; const char* nB = has_next ? nxt.b : cB;
        if (has_next) S.a_off(ui + 1, nxt, sR, sC, g.lda, vN);
        else {
#pragma unroll
            for (int x = 0; x < 4; ++x) vN[x] = vA[x]; }
        for (int t = 0; t < nt; t += 2) {
            const bool last = (t == nt - 2);
            const char* a1 = cA + (size_t)(t + 1) * kstep;
            const char* a2 = last ? nA : cA + (size_t)(t + 2) * kstep; const char* b2 = last ? nB : cB + (size_t)(t + 2) * kstep;
            const char* a3 = a2 + kstep; const char* b3 = b2 + kstep;
            unsigned v2[4];
#pragma unroll
            for (int x = 0; x < 4; ++x) v2[x] = last ? vN[x] : vA[x];
            PG8_LDB(B0, 0, 0); PG8_LDB(B1, 0, 1); PG8_SCHED; PG8_LDA(At, 0, 0); PG8_STAGEA(PG8_SA(1, 1), a1, vA, 1);
            PG8_WAIT_V(8); PG8_WAIT_L(0); PG8_BAR; PG8_MMA(0, 0, At, B0); PG8_MMA(0, 1, At, B1); PG8_BAR; PG8_SCHED;
            PG8_LDA(At, 0, 1); PG8_STAGE(PG8_SB(0, 0), b2, voffB); PG8_STAGE(PG8_SB(0, 1), b2 + hB, voffB); PG8_STAGEA(PG8_SA(0, 0), a2, v2, 0);
            PG8_WAIT_V(8); PG8_WAIT_L(0); PG8_BAR; PG8_MMA(1, 0, At, B0); PG8_MMA(1, 1, At, B1); PG8_BAR; PG8_SCHED;
            PG8_LDB(B0, 1, 0); PG8_LDB(B1, 1, 1); PG8_SCHED; PG8_LDA(At, 1, 0); PG8_STAGEA(PG8_SA(0, 1), a2, v2, 1);
            PG8_WAIT_V(8); PG8_WAIT_L(0); PG8_BAR; PG8_MMA(0, 0, At, B0); PG8_MMA(0, 1, At, B1); PG8_BAR; PG8_SCHED;
            PG8_LDA(At, 1, 1); PG8_STAGE(PG8_SB(1, 0), b3, voffB); PG8_STAGE(PG8_SB(1, 1), b3 + hB, voffB); PG8_STAGEA(PG8_SA(1, 0), a3, v2, 0);
            PG8_WAIT_V(8); PG8_WAIT_L(0); PG8_BAR; PG8_MMA(1, 0, At, B0); PG8_MMA(1, 1, At, B1); PG8_BAR; PG8_SCHED;
        }
        if constexpr (ALIGN_EPI) { if (wr == 0) PG8_BAR; }
        E(acc, cur, wr, wc, fr, fq);
        if (!has_next) break;
#pragma unroll
        for (int a = 0; a < 2; ++a)
#pragma unroll
            for (int b = 0; b < 2; ++b)
#pragma unroll
                for (int m = 0; m < 4; ++m)
#pragma unroll
                    for (int n = 0; n < 2; ++n) acc[a][b][m][n] = (f32x4){0.f, 0.f, 0.f, 0.f};
        cur = nxt; cA = nA; cB = nB; ++ui;
#pragma unroll
        for (int x = 0; x < 4; ++x) vA[x] = vN[x];
        if constexpr (ALIGN_EPI) { if (wr == 1) PG8_BAR; }
    }
    PG8_WAIT_V(0);
    if constexpr (!ALIGN_EPI) { if (wr == 0) PG8_BAR; }
    PG8_BAR;
#undef PG8_SA
#undef PG8_SB
#undef PG8_STAGE
#undef PG8_STAGEA
#undef PG8_LDA
#undef PG8_LDB
#undef PG8_MMA
#undef PG8_WAIT_V
#undef PG8_WAIT_L
#undef PG8_BAR
#undef PG8_SCHED
}
}
using pg8::cvt_pk_bf16;
typedef f32x4 Acc[2][2][4][2];

__device__ __forceinline__ float bf2f(bf16_t v) { return __uint_as_float(((unsigned)v) << 16); }
__device__ __forceinline__ float siluf(float a) { return a / (1.f + __expf(-a)); }
__device__ __forceinline__ int mod_index(int row) { return row < SEQ ? 0 : (row < ML ? 1 : 2); }

struct EpiIn {
    static constexpr bool PERM = true;
    bf16_t* U; float* R;
    __device__ __forceinline__ void operator()(const Acc& acc, const pg8::Unit& u, int wr, int wc, int fr, int fq) const {
        const int row0 = u.pm * 256 + wr * 64 + fr, col0 = u.pn * 256 + wc * 32 + 8 * fq;
        const float sc = (u.pn < 2) ? 0.08838834764831845f : 1.f;
#pragma unroll
        for (int ai = 0; ai < 2; ++ai)
#pragma unroll
            for (int m = 0; m < 4; ++m) { const int row = row0 + ai * 128 + m * 16; bf16_t* rowp = U + (size_t)row * INWP + col0;
#pragma unroll
                for (int bj = 0; bj < 2; ++bj) { const f32x4 v0 = acc[ai][bj][m][0] * sc, v1 = acc[ai][bj][m][1] * sc;
                    u32x4 w; w.x = cvt_pk_bf16(v0[0], v0[1]); w.y = cvt_pk_bf16(v0[2], v0[3]); w.z = cvt_pk_bf16(v1[0], v1[1]); w.w = cvt_pk_bf16(v1[2], v1[3]);
                    *(u32x4*)(rowp + bj * 128) = w; }
                if (u.pn == 16 && wc == 0) { float* rp = R + (size_t)row * 32 + 8 * fq; *(f32x4*)rp = acc[ai][0][m][0]; *(f32x4*)(rp + 4) = acc[ai][0][m][1]; } }
    }
};
struct EpiPool {
    static constexpr bool PERM = true;
    bf16_t* Y; const float* scale;
    __device__ __forceinline__ void operator()(const Acc& acc, const pg8::Unit& u, int wr, int wc, int fr, int fq) const {
        const int row0 = u.pm * 256 + wr * 64 + fr, col0 = u.pn * 256 + wc * 32 + 8 * fq;
        f32x4 sv[2][2];
#pragma unroll
        for (int bj = 0; bj < 2; ++bj)
#pragma unroll
            for (int n = 0; n < 2; ++n) sv[bj][n] = *(const f32x4*)(scale + col0 + bj * 128 + 4 * n);
#pragma unroll
        for (int ai = 0; ai < 2; ++ai)
#pragma unroll
            for (int m = 0; m < 4; ++m) { bf16_t* rowp = Y + (size_t)(row0 + ai * 128 + m * 16) * D + 1024 + col0;
#pragma unroll
                for (int bj = 0; bj < 2; ++bj) { const f32x4 v0 = acc[ai][bj][m][0] * sv[bj][0], v1 = acc[ai][bj][m][1] * sv[bj][1];
                    u32x4 w; w.x = cvt_pk_bf16(v0[0], v0[1]); w.y = cvt_pk_bf16(v0[2], v0[3]); w.z = cvt_pk_bf16(v1[0], v1[1]); w.w = cvt_pk_bf16(v1[2], v1[3]);
                    *(u32x4*)(rowp + bj * 128) = w; } }
    }
};
struct EpiResid {
    static constexpr bool PERM = false;
    const float* src_lat; const float* src_ctx; float* XR; const float* gate; const float* rowgate; int rg_stride, ctx_row0;
    __device__ __forceinline__ void operator()(const Acc& acc, const pg8::Unit& u, int wr, int wc, int fr, int fq) const {
        const int row0 = u.pm * 256 + wr * 64 + fr, col0 = u.pn * 256 + wc * 32 + 4 * fq;
        const int mi = u.pm < 16 ? 0 : (u.pm < 32 ? 1 : 2);
        const float* src = u.pm < 32 ? src_lat : src_ctx - (size_t)ctx_row0 * D;
        f32x4 gv[2][2];
#pragma unroll
        for (int bj = 0; bj < 2; ++bj)
#pragma unroll
            for (int n = 0; n < 2; ++n) gv[bj][n] = *(const f32x4*)(gate + (size_t)mi * MODW + col0 + bj * 128 + n * 16);
#pragma unroll
        for (int ai = 0; ai < 2; ++ai)
#pragma unroll
            for (int m = 0; m < 4; ++m) { const int row = row0 + ai * 128 + m * 16; const size_t off = (size_t)row * D + col0;
                const float rg = rowgate ? rowgate[(size_t)row * rg_stride] : 1.f;
#pragma unroll
                for (int bj = 0; bj < 2; ++bj)
#pragma unroll
                    for (int n = 0; n < 2; ++n) { const f32x4 bs = *(const f32x4*)(src + off + bj * 128 + n * 16);
                        *(f32x4*)(XR + off + bj * 128 + n * 16) = bs + gv[bj][n] * acc[ai][bj][m][n] * rg; } }
    }
};
struct EpiSwiglu {
    static constexpr bool PERM = true;
    bf16_t* H; int ldh, pad;
    __device__ __forceinline__ void operator()(const Acc& acc, const pg8::Unit& u, int wr, int wc, int fr, int fq) const {
        const int row0 = u.pm * 256 + wr * 64 + fr, col0 = u.pn * 128 + wc * 32 + 8 * fq;
#pragma unroll
        for (int ai = 0; ai < 2; ++ai)
#pragma unroll
            for (int m = 0; m < 4; ++m) { bf16_t* rowp = H + (size_t)(row0 + ai * 128 + m * 16) * ldh + col0;
                float h[8];
#pragma unroll
                for (int n = 0; n < 2; ++n)
#pragma unroll
                    for (int j = 0; j < 4; ++j) h[n * 4 + j] = siluf(acc[ai][0][m][n][j]) * acc[ai][1][m][n][j];
                u32x4 w; w.x = cvt_pk_bf16(h[0], h[1]); w.y = cvt_pk_bf16(h[2], h[3]); w.z = cvt_pk_bf16(h[4], h[5]); w.w = cvt_pk_bf16(h[6], h[7]);
                *(u32x4*)rowp = w; }
    }
};

struct GemmArgs { const char* A; const char* Bt; size_t a_mstep, a_nstep, b_nstep; int nM, nN, K, lda, ldb, pad; };
template <class Epi, bool ALIGN> __global__ void __launch_bounds__(512, 2) k_gemm(GemmArgs ga, Epi E) {
    extern __shared__ __attribute__((aligned(16))) unsigned char lds[];
    pg8::TileOrder S; S.A = ga.A; S.Bt = ga.Bt; S.a_mstep = ga.a_mstep; S.a_nstep = ga.a_nstep; S.b_nstep = ga.b_nstep; S.nM = ga.nM; S.nN = ga.nN; S.nwg = ga.nM * ga.nN; S.G = gridDim.x; S.c = blockIdx.x;
    pg8::Gemm g; g.K = ga.K; g.lda = ga.lda; g.ldb = ga.ldb; g.pad = 0;
    pg8::gemm_phase<Epi, pg8::TileOrder, ALIGN>((LAS unsigned char*)lds, g, S, E);
}


__device__ __forceinline__ void moe_tab_init(LAS int* tab, const unsigned* cnt, int nN) {
    if (threadIdx.x == 0) { int tb = 0, hr = 0;
        for (int e = 0; e < NE; ++e) { const int n = (int)cnt[64 * e], r = (n + 255) >> 8; tab[e] = tb; tab[16 + e] = hr; tab[32 + e] = r; tab[48 + e] = n; tb += r * nN; hr += r; }
        tab[8] = tb; tab[24] = hr; }
    __syncthreads();
}
struct MoeOrder {
    const char* A; const char* Bt; size_t a_mstep, b_estep, b_nstep; const LAS int* tab; const LAS int* rows; int nN, G, c, gather;
    __device__ __forceinline__ bool next(int i, pg8::Unit& u) const {
        const int nwg = tab[8]; const long L = (long)i * G + c; if (L >= nwg || i >= MOE_MAXU) return false;
        int wgid = (int)L; { const int q = nwg / 8, r = nwg % 8, xcd = wgid % 8, off = wgid / 8; wgid = (xcd < r ? xcd * (q + 1) : r * (q + 1) + (xcd - r) * q) + off; }
        int e = 0;
#pragma unroll
        for (int k = 1; k < NE; ++k) e += (wgid >= tab[k]) ? 1 : 0;
        const int loc = wgid - tab[e], nM = tab[32 + e];
        const int nig = 8 * nN, gid = loc / nig, fm = gid * 8, gsz = (nM - fm) < 8 ? (nM - fm) : 8;
        u.pml = fm + ((loc % nig) % gsz); u.pn = (loc % nig) / gsz; u.e = e; u.pm = tab[16 + e] + u.pml;
        u.a = gather ? A : A + (size_t)u.pm * a_mstep; u.b = Bt + (size_t)e * b_estep + (size_t)u.pn * b_nstep; return true;
    }
    __device__ __forceinline__ void a_off(int ui, const pg8::Unit&, const int (&R)[2], const int (&C)[2], int lda, unsigned (&v)[4]) const {
#pragma unroll
        for (int hh = 0; hh < 2; ++hh)
#pragma unroll
            for (int i = 0; i < 2; ++i) { const int row = gather ? rows[ui * 256 + hh * 128 + R[i]] : (R[i] + hh * 128); v[hh * 2 + i] = (unsigned)(row * lda + C[i]) * 2u; }
    }
};
struct EpiMoeDown {
    static constexpr bool PERM = true;
    bf16_t* YD; const float* GEP; const unsigned* cnt;
    __device__ __forceinline__ void operator()(const Acc& acc, const pg8::Unit& u, int wr, int wc, int fr, int fq) const {
        const int rl0 = u.pml * 256 + wr * 64 + fr, row0 = u.pm * 256 + wr * 64 + fr, col0 = u.pn * 256 + wc * 32 + 8 * fq;
        const int n = (int)cnt[64 * u.e];
#pragma unroll
        for (int ai = 0; ai < 2; ++ai)
#pragma unroll
            for (int m = 0; m < 4; ++m) { const int rl = rl0 + ai * 128 + m * 16; const float gt = rl < n ? GEP[(size_t)u.e * 8192 + rl] : 0.f;
                bf16_t* rowp = YD + (size_t)(row0 + ai * 128 + m * 16) * D + col0;
#pragma unroll
                for (int bj = 0; bj < 2; ++bj) { const f32x4 v0 = acc[ai][bj][m][0] * gt, v1 = acc[ai][bj][m][1] * gt;
                    u32x4 w; w.x = cvt_pk_bf16(v0[0], v0[1]); w.y = cvt_pk_bf16(v0[2], v0[3]); w.z = cvt_pk_bf16(v1[0], v1[1]); w.w = cvt_pk_bf16(v1[2], v1[3]);
                    *(u32x4*)(rowp + bj * 128) = w; } }
    }
};
struct MoeArgs { const char* A; const char* Bt; const unsigned* cnt; const int* list; size_t a_mstep, b_estep, b_nstep; int nN, K, lda, ldb, gather, pad; };
template <class Epi> __global__ void __launch_bounds__(512, 2) k_moe_gemm(MoeArgs ma, Epi E) {
    extern __shared__ __attribute__((aligned(16))) unsigned char lds[];
    LAS int* tab = (LAS int*)((LAS unsigned char*)lds + MOE_TAB); LAS int* rows = (LAS int*)((LAS unsigned char*)lds + MOE_ROWS);
    moe_tab_init(tab, ma.cnt, ma.nN);
    MoeOrder S; S.A = ma.A; S.Bt = ma.Bt; S.a_mstep = ma.a_mstep; S.b_estep = ma.b_estep; S.b_nstep = ma.b_nstep; S.tab = tab; S.rows = rows; S.nN = ma.nN; S.G = gridDim.x; S.c = blockIdx.x; S.gather = ma.gather;
    if (ma.gather) {
        pg8::Unit u;
        for (int ui = 0; S.next(ui, u); ++ui) { const int n = tab[48 + u.e];
            for (int r = threadIdx.x; r < 256; r += 512) { const int p = u.pml * 256 + r; rows[ui * 256 + r] = ma.list[(size_t)u.e * 8192 + (p < n ? p : 0)]; } }
        __syncthreads();
    }
    pg8::Gemm g; g.K = ma.K; g.lda = ma.lda; g.ldb = ma.ldb; g.pad = 0;
    pg8::gemm_phase<Epi, MoeOrder, true>((LAS unsigned char*)lds, g, S, E);
}

__device__ __forceinline__ float wave_sum(float v) {
#pragma unroll
    for (int o = 1; o < 64; o <<= 1) v += __shfl_xor(v, o);
    return v;
}
__device__ __forceinline__ unsigned f2bf(float f) { unsigned u = __float_as_uint(f); return (u + 0x7fffu + ((u >> 16) & 1u)) >> 16; }

struct CvtArgs { const float* src; bf16_t* dst; size_t src_mstride, dst_mstride; int K, N, NP, nb, rs, off, nmat, pad; };
__global__ void __launch_bounds__(256) k_convert(CvtArgs a) {
    __shared__ float t[64][65];
    const int ktiles = a.K / 64, ntiles = a.NP / 64, per = ktiles * ntiles, total = per * a.nmat;
    for (int it = blockIdx.x; it < total; it += gridDim.x) {
        const int mat = it / per, r = it % per, kt = r / ntiles, nt = r % ntiles, k0 = kt * 64, n0 = nt * 64;
        const float* src = a.src + (size_t)mat * a.src_mstride; bf16_t* dst = a.dst + (size_t)mat * a.dst_mstride;
        const int tid = threadIdx.x;
#pragma unroll 4
        for (int i = 0; i < 16; ++i) { const int kk = i * 4 + (tid >> 6), nn = tid & 63; t[kk][nn] = (n0 + nn < a.N) ? src[(size_t)(k0 + kk) * a.N + n0 + nn] : 0.f; }
        __syncthreads();
        const int nn = tid >> 2, kq = tid & 3, n = n0 + nn;
        const int drow = (n / a.nb) * a.rs + (n % a.nb) + a.off;
        unsigned w[8];
#pragma unroll
        for (int j = 0; j < 8; ++j) w[j] = f2bf(t[kq * 16 + 2 * j][nn]) | (f2bf(t[kq * 16 + 2 * j + 1][nn]) << 16);
        u32x4* dp = (u32x4*)(dst + (size_t)drow * a.K + k0 + kq * 16);
        dp[0] = (u32x4){w[0], w[1], w[2], w[3]}; dp[1] = (u32x4){w[4], w[5], w[6], w[7]};
        __syncthreads();
    }
}

__global__ void __launch_bounds__(256) k_ada(const float* c, const float* c_ctx, const float* w_ada, const float* b_ada, float* modv) {
    __shared__ float sc[3][D];
    for (int i = threadIdx.x; i < 3 * D; i += 256) { const int r = i / D, k = i % D; const float v = r < 2 ? c[r * D + k] : c_ctx[k]; sc[r][k] = v / (1.f + expf(-v)); }
    __syncthreads();
    const int gi = blockIdx.x * 256 + threadIdx.x; if (gi >= 2 * MODW) return;
    const int l = gi / MODW, n = gi % MODW;
    const float* w = w_ada + (size_t)l * D * MODW + n;
    float a0 = 0.f, a1 = 0.f, a2 = 0.f;
#pragma unroll 8
    for (int k = 0; k < D; ++k) { const float wv = w[(size_t)k * MODW]; a0 += sc[0][k] * wv; a1 += sc[1][k] * wv; a2 += sc[2][k] * wv; }
    const float bv = b_ada[l * MODW + n];
    modv[((size_t)l * 3 + 0) * MODW + n] = a0 + bv; modv[((size_t)l * 3 + 1) * MODW + n] = a1 + bv; modv[((size_t)l * 3 + 2) * MODW + n] = a2 + bv;
}

__global__ void __launch_bounds__(256) k_ln(const float* src_lat, const float* src_ctx, int ctx_row0, const float* gn, const float* sh, const float* sc, bf16_t* XN, int nrows) {
    const int row = blockIdx.x * 4 + (threadIdx.x >> 6), lane = threadIdx.x & 63; if (row >= nrows) return;
    const float* x = row < ML ? src_lat + (size_t)row * D : src_ctx + (size_t)(row - ctx_row0) * D;
    const int mi = mod_index(row);
    f32x4 v[8]; float s = 0.f;
#pragma unroll
    for (int j = 0; j < 8; ++j) { v[j] = *(const f32x4*)(x + 4 * lane + 256 * j); s += (v[j].x * v[j].x + v[j].y * v[j].y) + (v[j].z * v[j].z + v[j].w * v[j].w); }
    const float rstd = 1.0f / sqrtf(wave_sum(s) * (1.f / D) + EPS);
#pragma unroll
    for (int j = 0; j < 8; ++j) { const int c = 4 * lane + 256 * j;
        const f32x4 g = *(const f32x4*)(gn + c), a = *(const f32x4*)(sc + (size_t)mi * MODW + c), b = *(const f32x4*)(sh + (size_t)mi * MODW + c);
        const f32x4 h = v[j] * rstd * g * (a + 1.0f) + b;
        u32x2 w; w.x = cvt_pk_bf16(h.x, h.y); w.y = cvt_pk_bf16(h.z, h.w); *(u32x2*)(XN + (size_t)row * D + c) = w; }
}

constexpr int NCH = 68, NUN = 8 * NCH, KQ = 320;
constexpr int G1_RS = 0, G1_CUM = 8192, G1_QP = 41984, G1_KI = 59392, G1_KT = 76800, G1_VT = 95232, G1_AS = 132096, G1_LDS = 141312;
__device__ __forceinline__ int gla_row0(int b, int c) { return c < 4 ? ML + b * CTXL + c * 64 : b * SEQ + (c - 4) * 64; }
__device__ __forceinline__ float bflo(unsigned w) { return __uint_as_float(w << 16); }
__device__ __forceinline__ float bfhi(unsigned w) { return __uint_as_float(w & 0xffff0000u); }

__device__ __forceinline__ void gla_g1_unit(LAS unsigned char* lds, int un, const bf16_t* U, const float* R, const float* wg, const float* bg, bf16_t* QA, bf16_t* BT, float* DS, float* DEC) {
    const int tid = threadIdx.x, lane = tid & 63, wid = tid >> 6, fr = lane & 15, fq = lane >> 4;
    const int bh = un / NCH, c = un % NCH, b = bh >> 2, h = bh & 3;
    const int row0 = gla_row0(b, c);
    LAS float* RS = (LAS float*)(lds + G1_RS); LAS float* CUM = (LAS float*)(lds + G1_CUM);
    LAS bf16_t* QP = (LAS bf16_t*)(lds + G1_QP); LAS bf16_t* KI = (LAS bf16_t*)(lds + G1_KI); LAS bf16_t* KT = (LAS bf16_t*)(lds + G1_KT);
    LAS bf16_t* VT = (LAS bf16_t*)(lds + G1_VT); LAS bf16_t* AS = (LAS bf16_t*)(lds + G1_AS);
    { const int t = tid >> 3, i4 = (tid & 7) * 4; *(LAS f32x4*)(RS + t * 32 + i4) = *(const f32x4*)(R + (size_t)(row0 + t) * 32 + i4); }
#pragma unroll
    for (int i = 0; i < 4; ++i) { const int idx = tid + 512 * i, jg = idx >> 6, s = idx & 63;
        const u32x4 q = *(const u32x4*)(U + (size_t)(row0 + s) * INWP + C_V + h * DV + jg * 8);
        LAS bf16_t* vp = VT + (jg * 8) * 72 + s;
        vp[0] = (bf16_t)(q.x & 0xffffu); vp[72] = (bf16_t)(q.x >> 16); vp[144] = (bf16_t)(q.y & 0xffffu); vp[216] = (bf16_t)(q.y >> 16);
        vp[288] = (bf16_t)(q.z & 0xffffu); vp[360] = (bf16_t)(q.z >> 16); vp[432] = (bf16_t)(q.w & 0xffffu); vp[504] = (bf16_t)(q.w >> 16); }
    __syncthreads();
    { const int j = tid >> 1, hf = tid & 1;
#pragma unroll
      for (int i = 0; i < 4; ++i) *(u32x4*)(BT + ((size_t)un * 256 + j) * KQ + 256 + hf * 32 + i * 8) = *(const LAS u32x4*)(VT + j * 72 + hf * 32 + i * 8); }
    f32x4 Aacc[2]; Aacc[0] = (f32x4){0.f, 0.f, 0.f, 0.f}; Aacc[1] = (f32x4){0.f, 0.f, 0.f, 0.f};
    for (int dir = 0; dir < 2; ++dir) {
        { const int d = tid & 127; float wgr[16];
#pragma unroll
          for (int i = 0; i < 16; ++i) wgr[i] = wg[(size_t)(dir * 16 + i) * 512 + h * DK + d];
          const float bgv = bg[dir * 512 + h * DK + d];
          for (int i = 0; i < 16; ++i) { const int t = (tid >> 7) + 4 * i; float pre = bgv;
#pragma unroll
              for (int k = 0; k < 16; ++k) pre += RS[t * 32 + dir * 16 + k] * wgr[k];
              const float ls = fminf(pre, 0.f) - log1pf(expf(-fabsf(pre)));
              CUM[t * 132 + d] = ls * (1.f / 16.f); } }
        __syncthreads();
        if (tid < 128) { float a = 0.f;
            if (dir == 0) { for (int t = 0; t < 64; ++t) { a += CUM[t * 132 + tid]; CUM[t * 132 + tid] = a; } }
            else { for (int t = 63; t >= 0; --t) { a += CUM[t * 132 + tid]; CUM[t * 132 + tid] = a; } } }
        __syncthreads();
        const int tl = dir == 0 ? 63 : 0;
#pragma unroll
        for (int i = 0; i < 2; ++i) { const int idx = tid + 512 * i, dg = idx >> 6, s = idx & 63;
            const u32x4 qv = *(const u32x4*)(U + (size_t)(row0 + s) * INWP + C_Q + h * DK + dg * 8), kv = *(const u32x4*)(U + (size_t)(row0 + s) * INWP + C_K + h * DK + dg * 8);
            const f32x4 c0 = *(const LAS f32x4*)(CUM + s * 132 + dg * 8), c1 = *(const LAS f32x4*)(CUM + s * 132 + dg * 8 + 4);
            const f32x4 l0 = *(const LAS f32x4*)(CUM + tl * 132 + dg * 8), l1 = *(const LAS f32x4*)(CUM + tl * 132 + dg * 8 + 4);
            const float qf[8] = {bflo(qv.x), bfhi(qv.x), bflo(qv.y), bfhi(qv.y), bflo(qv.z), bfhi(qv.z), bflo(qv.w), bfhi(qv.w)};
            const float kf[8] = {bflo(kv.x), bfhi(kv.x), bflo(kv.y), bfhi(kv.y), bflo(kv.z), bfhi(kv.z), bflo(kv.w), bfhi(kv.w)};
            const float cc[8] = {c0.x, c0.y, c0.z, c0.w, c1.x, c1.y, c1.z, c1.w}, cl[8] = {l0.x, l0.y, l0.z, l0.w, l1.x, l1.y, l1.z, l1.w};
            float qp[8], ki[8], ke[8];
#pragma unroll
            for (int e = 0; e < 8; ++e) { qp[e] = qf[e] * __expf(cc[e]); ki[e] = kf[e] * __expf(fminf(-cc[e], 80.f)); ke[e] = kf[e] * __expf(cl[e] - cc[e]); }
            u32x4 w; w.x = cvt_pk_bf16(qp[0], qp[1]); w.y = cvt_pk_bf16(qp[2], qp[3]); w.z = cvt_pk_bf16(qp[4], qp[5]); w.w = cvt_pk_bf16(qp[6], qp[7]);
            *(LAS u32x4*)(QP + s * 136 + dg * 8) = w;
            *(u32x4*)(QA + ((size_t)un * 64 + s) * KQ + dir * 128 + dg * 8) = w;
            u32x4 w2; w2.x = cvt_pk_bf16(ki[0], ki[1]); w2.y = cvt_pk_bf16(ki[2], ki[3]); w2.z = cvt_pk_bf16(ki[4], ki[5]); w2.w = cvt_pk_bf16(ki[6], ki[7]);
            *(LAS u32x4*)(KI + s * 136 + dg * 8) = w2;
#pragma unroll
            for (int e = 0; e < 8; ++e) KT[(dg * 8 + e) * 72 + s] = (bf16_t)f2bf(ke[e]);
            if (s == tl) { float* dp = DEC + ((size_t)un * 2 + dir) * 128 + dg * 8;
                *(f32x4*)dp = (f32x4){__expf(cl[0]), __expf(cl[1]), __expf(cl[2]), __expf(cl[3])}; *(f32x4*)(dp + 4) = (f32x4){__expf(cl[4]), __expf(cl[5]), __expf(cl[6]), __expf(cl[7])}; } }
        __syncthreads();
        { const int tb = wid >> 1;
#pragma unroll
          for (int x = 0; x < 2; ++x) { const int sb = (wid & 1) * 2 + x; f32x4 a = (f32x4){0.f, 0.f, 0.f, 0.f};
#pragma unroll
              for (int ks = 0; ks < 4; ++ks) { const bf16x8 Af = *(const LAS bf16x8*)(QP + (tb * 16 + fr) * 136 + ks * 32 + fq * 8), Bf = *(const LAS bf16x8*)(KI + (sb * 16 + fr) * 136 + ks * 32 + fq * 8);
                  a = __builtin_amdgcn_mfma_f32_16x16x32_bf16(Af, Bf, a, 0, 0, 0); }
#pragma unroll
              for (int jj = 0; jj < 4; ++jj) { const int t = tb * 16 + 4 * fq + jj, sx = sb * 16 + fr; const bool keep = dir == 0 ? (sx <= t) : (sx >= t); Aacc[x][jj] += keep ? a[jj] : 0.f; } } }
#pragma unroll
        for (int jbi = 0; jbi < 2; ++jbi) { const int jb = wid * 2 + jbi;
            const bf16x8 Bf0 = *(const LAS bf16x8*)(VT + (jb * 16 + fr) * 72 + fq * 8), Bf1 = *(const LAS bf16x8*)(VT + (jb * 16 + fr) * 72 + 32 + fq * 8);
#pragma unroll
            for (int db = 0; db < 8; ++db) { const bf16x8 Af0 = *(const LAS bf16x8*)(KT + (db * 16 + fr) * 72 + fq * 8), Af1 = *(const LAS bf16x8*)(KT + (db * 16 + fr) * 72 + 32 + fq * 8);
                f32x4 a = (f32x4){0.f, 0.f, 0.f, 0.f};
                a = __builtin_amdgcn_mfma_f32_16x16x32_bf16(Af0, Bf0, a, 0, 0, 0); a = __builtin_amdgcn_mfma_f32_16x16x32_bf16(Af1, Bf1, a, 0, 0, 0);
                *(f32x4*)(DS + (((size_t)un * 2 + dir) * 256 + jb * 16 + fr) * 128 + db * 16 + 4 * fq) = a; } }
        __syncthreads();
    }
    { const int tb = wid >> 1;
#pragma unroll
      for (int x = 0; x < 2; ++x) { const int sb = (wid & 1) * 2 + x;
#pragma unroll
          for (int jj = 0; jj < 4; ++jj) AS[(tb * 16 + 4 * fq + jj) * 72 + sb * 16 + fr] = (bf16_t)f2bf(Aacc[x][jj]); } }
    __syncthreads();
    { const int t = tid >> 3, seg = tid & 7; *(u32x4*)(QA + ((size_t)un * 64 + t) * KQ + 256 + seg * 8) = *(const LAS u32x4*)(AS + t * 72 + seg * 8); }
    __syncthreads();
}
__global__ void __launch_bounds__(512, 2) k_gla_g1(const bf16_t* U, const float* R, const float* wg, const float* bg, bf16_t* QA, bf16_t* BT, float* DS, float* DEC) {
    extern __shared__ __attribute__((aligned(16))) unsigned char lds[];
    for (int un = blockIdx.x; un < NUN; un += gridDim.x) gla_g1_unit((LAS unsigned char*)lds, un, U, R, wg, bg, QA, BT, DS, DEC);
}
__global__ void __launch_bounds__(256) k_gla_g2(const float* DS, const float* DEC, bf16_t* BT) {
    const int gi = blockIdx.x * 256 + threadIdx.x, d4 = gi & 31, j = (gi >> 5) & 255, chain = gi >> 13, dir = chain & 1, bh = chain >> 1;
    f32x4 S = (f32x4){0.f, 0.f, 0.f, 0.f};
#pragma unroll 4
    for (int step = 0; step < NCH; ++step) {
        const int c = dir == 0 ? step : (step < 4 ? 3 - step : 71 - step), un = bh * NCH + c;
        u32x2 w; w.x = cvt_pk_bf16(S.x, S.y); w.y = cvt_pk_bf16(S.z, S.w);
        *(u32x2*)(BT + ((size_t)un * 256 + j) * KQ + dir * 128 + d4 * 4) = w;
        const f32x4 dec = *(const f32x4*)(DEC + ((size_t)un * 2 + dir) * 128 + d4 * 4), ds = *(const f32x4*)(DS + (((size_t)un * 2 + dir) * 256 + j) * 128 + d4 * 4);
        S = dec * S + ds;
    }
}
__device__ __forceinline__ void gla_g3_unit(LAS unsigned char* lds, int un, const bf16_t* QA, const bf16_t* BT, const bf16_t* U, const float* gain, bf16_t* Y) {
    const int tid = threadIdx.x, lane = tid & 63, wid = tid >> 6, fr = lane & 15, fq = lane >> 4;
    const int bh = un / NCH, c = un % NCH, b = bh >> 2, h = bh & 3, row0 = gla_row0(b, c);
    const int tb = wid & 3, jh = wid >> 2;
    const bf16_t* qa = QA + ((size_t)un * 64 + tb * 16 + fr) * KQ + fq * 8;
    const bf16_t* bt = BT + ((size_t)un * 256 + jh * 128 + fr) * KQ + fq * 8;
    f32x4 acc[8];
#pragma unroll
    for (int jb = 0; jb < 8; ++jb) acc[jb] = (f32x4){0.f, 0.f, 0.f, 0.f};
#pragma unroll 2
    for (int ks = 0; ks < 10; ++ks) { const bf16x8 Bf = *(const bf16x8*)(qa + ks * 32);
#pragma unroll
        for (int jb = 0; jb < 8; ++jb) { const bf16x8 Af = *(const bf16x8*)(bt + (size_t)jb * 16 * KQ + ks * 32); acc[jb] = __builtin_amdgcn_mfma_f32_16x16x32_bf16(Af, Bf, acc[jb], 0, 0, 0); } }
    float ss = 0.f;
#pragma unroll
    for (int jb = 0; jb < 8; ++jb) ss += (acc[jb].x * acc[jb].x + acc[jb].y * acc[jb].y) + (acc[jb].z * acc[jb].z + acc[jb].w * acc[jb].w);
    ss += __shfl_xor(ss, 16); ss += __shfl_xor(ss, 32);
    LAS float* P = (LAS float*)lds;
    if (fq == 0) P[wid * 16 + fr] = ss;
    __syncthreads();
    const float tot = P[wid * 16 + fr] + P[(wid ^ 4) * 16 + fr];
    const float rstd = 1.0f / sqrtf(tot * (1.f / DV) + EPS);
    const int row = row0 + tb * 16 + fr;
#pragma unroll
    for (int jb = 0; jb < 8; ++jb) { const int col = h * DV + jh * 128 + jb * 16 + 4 * fq;
        const f32x4 gn = *(const f32x4*)(gain + col); const u32x2 gw = *(const u32x2*)(U + (size_t)row * INWP + C_G + col);
        const f32x4 o = acc[jb] * rstd * gn;
        u32x2 w; w.x = cvt_pk_bf16(o.x * siluf(bflo(gw.x)), o.y * siluf(bfhi(gw.x))); w.y = cvt_pk_bf16(o.z * siluf(bflo(gw.y)), o.w * siluf(bfhi(gw.y)));
        *(u32x2*)(Y + (size_t)row * D + col) = w; }
    __syncthreads();
}
__global__ void __launch_bounds__(512, 2) k_gla_g3(const bf16_t* QA, const bf16_t* BT, const bf16_t* U, const float* gain, bf16_t* Y, int skip_ctx) {
    extern __shared__ __attribute__((aligned(16))) unsigned char lds[];
    for (int un = blockIdx.x; un < NUN; un += gridDim.x) { if (skip_ctx && (un % NCH) < 4) continue; gla_g3_unit((LAS unsigned char*)lds, un, QA, BT, U, gain, Y); }
}
__global__ void __launch_bounds__(256) k_pool(const bf16_t* U, bf16_t* MIX, int nrows) {
    const int gi = blockIdx.x * 256 + threadIdx.x; if (gi >= nrows * 128) return;
    const int row = gi >> 7, ch = (gi & 127) * 8, grp = ch >> 8, w = 2 << grp;
    int L, j, base;
    if (row < ML) { L = 64; j = row & 63; base = row - j; } else { L = CTXL; j = (row - ML) & (CTXL - 1); base = row - j; }
    int lo = j - w / 2, hi = lo + w; lo = lo < 0 ? 0 : lo; hi = hi > L ? L : hi;
    float s[8];
#pragma unroll
    for (int i = 0; i < 8; ++i) s[i] = 0.f;
    for (int p = lo; p < hi; ++p) { const u32x4 q = *(const u32x4*)(U + (size_t)(base + p) * INWP + C_P + ch);
        s[0] += __uint_as_float(q.x << 16); s[1] += __uint_as_float(q.x & 0xffff0000u); s[2] += __uint_as_float(q.y << 16); s[3] += __uint_as_float(q.y & 0xffff0000u);
        s[4] += __uint_as_float(q.z << 16); s[5] += __uint_as_float(q.z & 0xffff0000u); s[6] += __uint_as_float(q.w << 16); s[7] += __uint_as_float(q.w & 0xffff0000u); }
    const u32x4 q = *(const u32x4*)(U + (size_t)row * INWP + C_P + ch);
    const float self[8] = {__uint_as_float(q.x << 16), __uint_as_float(q.x & 0xffff0000u), __uint_as_float(q.y << 16), __uint_as_float(q.y & 0xffff0000u),
                           __uint_as_float(q.z << 16), __uint_as_float(q.z & 0xffff0000u), __uint_as_float(q.w << 16), __uint_as_float(q.w & 0xffff0000u)};
    const float inv = 1.f / (float)(hi - lo);
    u32x4 o; o.x = cvt_pk_bf16(s[0] * inv - self[0], s[1] * inv - self[1]); o.y = cvt_pk_bf16(s[2] * inv - self[2], s[3] * inv - self[3]);
    o.z = cvt_pk_bf16(s[4] * inv - self[4], s[5] * inv - self[5]); o.w = cvt_pk_bf16(s[6] * inv - self[6], s[7] * inv - self[7]);
    *(u32x4*)(MIX + (size_t)row * 1024 + ch) = o;
}
__global__ void __launch_bounds__(256) k_router(const float* XR, const float* gn, const float* sh, const float* sc, const float* w_r, const float* b_r, unsigned* cnt, int* list, float* gep, int* slot) {
    const int row = blockIdx.x * 4 + (threadIdx.x >> 6), lane = threadIdx.x & 63; if (row >= ML) return;
    const float* x = XR + (size_t)row * D; const int mi = mod_index(row);
    f32x4 v[8]; float s = 0.f;
#pragma unroll
    for (int j = 0; j < 8; ++j) { v[j] = *(const f32x4*)(x + 4 * lane + 256 * j); s += (v[j].x * v[j].x + v[j].y * v[j].y) + (v[j].z * v[j].z + v[j].w * v[j].w); }
    const float rstd = 1.0f / sqrtf(wave_sum(s) * (1.f / D) + EPS);
    float lg[8];
#pragma unroll
    for (int e = 0; e < 8; ++e) lg[e] = 0.f;
#pragma unroll
    for (int j = 0; j < 8; ++j) { const int c = 4 * lane + 256 * j;
        const f32x4 g = *(const f32x4*)(gn + c), a = *(const f32x4*)(sc + (size_t)mi * MODW + c), b = *(const f32x4*)(sh + (size_t)mi * MODW + c);
        const f32x4 h = v[j] * rstd * g * (a + 1.0f) + b;
#pragma unroll
        for (int i = 0; i < 4; ++i) { const f32x4 w0 = *(const f32x4*)(w_r + (size_t)(c + i) * 8), w1 = *(const f32x4*)(w_r + (size_t)(c + i) * 8 + 4);
            lg[0] += h[i] * w0.x; lg[1] += h[i] * w0.y; lg[2] += h[i] * w0.z; lg[3] += h[i] * w0.w; lg[4] += h[i] * w1.x; lg[5] += h[i] * w1.y; lg[6] += h[i] * w1.z; lg[7] += h[i] * w1.w; } }
#pragma unroll
    for (int e = 0; e < 8; ++e) lg[e] = wave_sum(lg[e]) + b_r[e];
    int i0 = 0; float m0 = lg[0];
#pragma unroll
    for (int e = 1; e < 8; ++e) if (lg[e] > m0) { m0 = lg[e]; i0 = e; }
    int i1 = -1; float m1 = -3.0e38f;
#pragma unroll
    for (int e = 0; e < 8; ++e) if (e != i0 && lg[e] > m1) { m1 = lg[e]; i1 = e; }
    const float p1 = expf(m1 - m0), g0 = 1.f / (1.f + p1), g1 = p1 / (1.f + p1);
    if (lane == 0) {
        const unsigned q0 = atomicAdd(cnt + 64 * i0, 1u), q1 = atomicAdd(cnt + 64 * i1, 1u);
        list[(size_t)i0 * 8192 + q0] = row; list[(size_t)i1 * 8192 + q1] = row; gep[(size_t)i0 * 8192 + q0] = g0; gep[(size_t)i1 * 8192 + q1] = g1;
        slot[row * 2] = i0 * 8192 + (int)q0; slot[row * 2 + 1] = i1 * 8192 + (int)q1; }
}
__global__ void __launch_bounds__(256) k_final(const float* XR, const bf16_t* YD, const int* slot, const unsigned* cnt, const float* g2, const float* gn, float* out) {
    const int row = blockIdx.x * 4 + (threadIdx.x >> 6), lane = threadIdx.x & 63; if (row >= ML) return;
    const float* x = XR + (size_t)row * D; const int mi = mod_index(row);
    const int s0 = slot[row * 2], s1 = slot[row * 2 + 1], e0 = s0 >> 13, e1 = s1 >> 13;
    int h0 = 0, h1 = 0;
#pragma unroll
    for (int e = 0; e < NE; ++e) { const int r = ((int)cnt[64 * e] + 255) >> 8; h0 += e < e0 ? r : 0; h1 += e < e1 ? r : 0; }
    const bf16_t* y0 = YD + ((size_t)h0 * 256 + (s0 & 8191)) * D; const bf16_t* y1 = YD + ((size_t)h1 * 256 + (s1 & 8191)) * D;
    f32x4 v[8]; float s = 0.f;
#pragma unroll
    for (int j = 0; j < 8; ++j) { const int c = 4 * lane + 256 * j; const u32x2 a = *(const u32x2*)(y0 + c), b = *(const u32x2*)(y1 + c);
        const f32x4 ya = (f32x4){bflo(a.x) + bflo(b.x), bfhi(a.x) + bfhi(b.x), bflo(a.y) + bflo(b.y), bfhi(a.y) + bfhi(b.y)};
        v[j] = *(const f32x4*)(x + c) + *(const f32x4*)(g2 + (size_t)mi * MODW + c) * ya;
        s += (v[j].x * v[j].x + v[j].y * v[j].y) + (v[j].z * v[j].z + v[j].w * v[j].w); }
    const float rstd = 1.0f / sqrtf(wave_sum(s) * (1.f / D) + EPS);
#pragma unroll
    for (int j = 0; j < 8; ++j) { const int c = 4 * lane + 256 * j; *(f32x4*)(out + (size_t)row * D + c) = v[j] * rstd * *(const f32x4*)(gn + c); }
}

template <class Epi, bool ALIGN> static void launch_gemm(hipStream_t st, const void* A, const void* Bt, size_t a_mstep, size_t a_nstep, size_t b_nstep, int nM, int nN, int K, int lda, int ldb, const Epi& E) {
    static bool attr = false;
    if (!attr) { (void)hipFuncSetAttribute((const void*)k_gemm<Epi, ALIGN>, hipFuncAttributeMaxDynamicSharedMemorySize, pg8::STAGE_BYTES); attr = true; }
    GemmArgs ga; memset(&ga, 0, sizeof ga);
    ga.A = (const char*)A; ga.Bt = (const char*)Bt; ga.a_mstep = a_mstep; ga.a_nstep = a_nstep; ga.b_nstep = b_nstep; ga.nM = nM; ga.nN = nN; ga.K = K; ga.lda = lda; ga.ldb = ldb;
    hipLaunchKernelGGL((k_gemm<Epi, ALIGN>), dim3(256), dim3(512), pg8::STAGE_BYTES, st, ga, E);
}
static void launch_cvt(hipStream_t st, const float* src, bf16_t* dst, size_t sms, size_t dms, int K, int N, int NP, int nb, int rs, int off, int nmat) {
    CvtArgs a; memset(&a, 0, sizeof a);
    a.src = src; a.dst = dst; a.src_mstride = sms; a.dst_mstride = dms; a.K = K; a.N = N; a.NP = NP; a.nb = nb; a.rs = rs; a.off = off; a.nmat = nmat;
    hipLaunchKernelGGL(k_convert, dim3(2048), dim3(256), 0, st, a);
}

extern "C" void kernel_launch(void* const* d_in, const int* in_sizes, int n_in, void* d_out, int out_size, void* d_ws, size_t ws_size, hipStream_t stream) {
    if (n_in != 24 || ws_size < WS_END || out_size != ML * D) { fprintf(stderr, "kernel_launch: unexpected sizes (n_in %d, ws %zu, out %d)\n", n_in, ws_size, out_size); return; }
    const float* x = (const float*)d_in[0]; const float* c = (const float*)d_in[1]; const float* ctx = (const float*)d_in[2]; const float* c_ctx = (const float*)d_in[3];
    const float* w_ada = (const float*)d_in[4]; const float* b_ada = (const float*)d_in[5]; const float* norm1_g = (const float*)d_in[6]; const float* norm2_g = (const float*)d_in[7];
    const float* w_in = (const float*)d_in[8]; const float* w_gate = (const float*)d_in[9]; const float* b_gate = (const float*)d_in[10]; const float* gla_g = (const float*)d_in[11];
    const float* w_pool = (const float*)d_in[12]; const float* pool_scale = (const float*)d_in[13]; const float* w_out = (const float*)d_in[14];
    const float* ffn_w1 = (const float*)d_in[15]; const float* ffn_w3 = (const float*)d_in[16]; const float* ffn_w2 = (const float*)d_in[17];
    const float* moe_wr = (const float*)d_in[18]; const float* moe_br = (const float*)d_in[19]; const float* moe_w1 = (const float*)d_in[20]; const float* moe_w3 = (const float*)d_in[21]; const float* moe_w2 = (const float*)d_in[22];
    const float* final_g = (const float*)d_in[23];
    char* ws = (char*)d_ws;
    float* MODV = (float*)(ws + WS_MODV); float* R = (float*)(ws + WS_R); unsigned* CNT = (unsigned*)(ws + WS_CTL) + CW_CNT; int* LIST = (int*)(ws + WS_LIST); float* GEP = (float*)(ws + WS_GEP); int* SLOT = (int*)(ws + WS_SLOT); bf16_t* YD = (bf16_t*)(ws + WS_YD);
    bf16_t* WPOOL = (bf16_t*)(ws + WS_WPOOL); bf16_t* WIN = (bf16_t*)(ws + WS_WIN); bf16_t* WOUT = (bf16_t*)(ws + WS_WOUT);
    bf16_t* W13 = (bf16_t*)(ws + WS_W13); bf16_t* W2 = (bf16_t*)(ws + WS_W2); bf16_t* MW13 = (bf16_t*)(ws + WS_MW13); bf16_t* MW2 = (bf16_t*)(ws + WS_MW2);
    float* XR = (float*)(ws + WS_XR); bf16_t* XN = (bf16_t*)(ws + WS_XN); bf16_t* U = (bf16_t*)(ws + WS_U); bf16_t* Y = (bf16_t*)(ws + WS_Y); bf16_t* MIX = (bf16_t*)(ws + WS_MIX);
    bf16_t* HH = (bf16_t*)(ws + WS_HH); bf16_t* QA = (bf16_t*)(ws + WS_QA); bf16_t* BT = (bf16_t*)(ws + WS_BT); float* DS = (float*)(ws + WS_DS); float* DEC = (float*)(ws + WS_DEC);

    (void)hipMemsetAsync(ws + WS_CTL, 0, 1 * MiB, stream);
    launch_cvt(stream, w_in, WIN, (size_t)D * INW, (size_t)INWP * D, D, INW, INWP, 1 << 30, 0, 0, 2);
    launch_cvt(stream, w_out, WOUT, (size_t)D * D, (size_t)D * D, D, D, D, 1 << 30, 0, 0, 2);
    launch_cvt(stream, w_pool, WPOOL, (size_t)256 * 256, (size_t)256 * 256, 256, 256, 256, 1 << 30, 0, 0, 8);
    launch_cvt(stream, ffn_w1, W13, 0, 0, D, DFF, DFF, 128, 256, 0, 1);
    launch_cvt(stream, ffn_w3, W13, 0, 0, D, DFF, DFF, 128, 256, 128, 1);
    launch_cvt(stream, ffn_w2, W2, 0, 0, DFF, D, D, 1 << 30, 0, 0, 1);
    launch_cvt(stream, moe_w1, MW13, (size_t)D * DFF, (size_t)2 * DFF * D, D, DFF, DFF, 128, 256, 0, NE);
    launch_cvt(stream, moe_w3, MW13, (size_t)D * DFF, (size_t)2 * DFF * D, D, DFF, DFF, 128, 256, 128, NE);
    launch_cvt(stream, moe_w2, MW2, (size_t)DFF * D, (size_t)D * DFF, DFF, D, D, 1 << 30, 0, 0, NE);
    hipLaunchKernelGGL(k_ada, dim3(2 * MODW / 256), dim3(256), 0, stream, c, c_ctx, w_ada, b_ada, MODV);

    for (int l = 0; l < 2; ++l) {
        const float* modv_l = MODV + (size_t)l * 3 * MODW;
        const float* src_lat = l == 0 ? x : XR; const float* src_ctx = l == 0 ? ctx : XR; const int ctx_row0 = l == 0 ? ML : 0;
        hipLaunchKernelGGL(k_ln, dim3(MA / 4), dim3(256), 0, stream, src_lat, src_ctx, ctx_row0, norm1_g + l * D, modv_l + 0, modv_l + D, XN, MA);
        { EpiIn E; memset(&E, 0, sizeof E); E.U = U; E.R = R;
          launch_gemm<EpiIn, true>(stream, XN, WIN + (size_t)l * INWP * D, (size_t)256 * D * 2, 0, (size_t)256 * D * 2, MA / 256, INWP / 256, D, D, D, E); }
        { static bool attr = false; if (!attr) { (void)hipFuncSetAttribute((const void*)k_gla_g1, hipFuncAttributeMaxDynamicSharedMemorySize, G1_LDS); attr = true; } }
        hipLaunchKernelGGL(k_gla_g1, dim3(256), dim3(512), G1_LDS, stream, (const bf16_t*)U, (const float*)R, w_gate + (size_t)l * 2 * 16 * 512, b_gate + (size_t)l * 2 * 512, QA, BT, DS, DEC);
        hipLaunchKernelGGL(k_gla_g2, dim3(512), dim3(256), 0, stream, (const float*)DS, (const float*)DEC, BT);
        hipLaunchKernelGGL(k_gla_g3, dim3(256), dim3(512), 1024, stream, (const bf16_t*)QA, (const bf16_t*)BT, (const bf16_t*)U, gla_g + l * 1024, Y, l == 1 ? 1 : 0);
        hipLaunchKernelGGL(k_pool, dim3(MA * 128 / 256), dim3(256), 0, stream, U, MIX, MA);
        { EpiPool E; memset(&E, 0, sizeof E); E.Y = Y; E.scale = pool_scale + l * 1024;
          launch_gemm<EpiPool, true>(stream, MIX, WPOOL + (size_t)l * 4 * 256 * 256, (size_t)256 * 1024 * 2, (size_t)256 * 2, (size_t)256 * 256 * 2, MA / 256, 4, 256, 1024, 256, E); }
        const int nMo = (l == 0) ? MA / 256 : ML / 256;
        { EpiResid E; memset(&E, 0, sizeof E); E.src_lat = src_lat; E.src_ctx = src_ctx; E.ctx_row0 = ctx_row0; E.XR = XR; E.gate = modv_l + 2 * D; E.rowgate = nullptr; E.rg_stride = 0;
          launch_gemm<EpiResid, true>(stream, Y, WOUT + (size_t)l * D * D, (size_t)256 * D * 2, 0, (size_t)256 * D * 2, nMo, D / 256, D, D, D, E); }
        hipLaunchKernelGGL(k_ln, dim3(nMo * 256 / 4), dim3(256), 0, stream, (const float*)XR, (const float*)XR, 0, norm2_g + l * D, modv_l + 3 * D, modv_l + 4 * D, XN, nMo * 256);
        if (l == 0) {
            { EpiSwiglu E; memset(&E, 0, sizeof E); E.H = HH; E.ldh = DFF;
              launch_gemm<EpiSwiglu, true>(stream, XN, W13, (size_t)256 * D * 2, 0, (size_t)256 * D * 2, MA / 256, 2 * DFF / 256, D, D, D, E); }
            { EpiResid E; memset(&E, 0, sizeof E); E.src_lat = XR; E.src_ctx = XR; E.XR = XR; E.gate = modv_l + 5 * D; E.rowgate = nullptr; E.rg_stride = 0;
              launch_gemm<EpiResid, true>(stream, HH, W2, (size_t)256 * DFF * 2, 0, (size_t)256 * DFF * 2, MA / 256, D / 256, DFF, DFF, DFF, E); }
        } else {
            hipLaunchKernelGGL(k_router, dim3(ML / 4), dim3(256), 0, stream, (const float*)XR, norm2_g + l * D, modv_l + 3 * D, modv_l + 4 * D, moe_wr, moe_br, CNT, LIST, GEP, SLOT);
            { static bool attr = false; if (!attr) { (void)hipFuncSetAttribute((const void*)k_moe_gemm<EpiSwiglu>, hipFuncAttributeMaxDynamicSharedMemorySize, MOE_LDS); (void)hipFuncSetAttribute((const void*)k_moe_gemm<EpiMoeDown>, hipFuncAttributeMaxDynamicSharedMemorySize, MOE_LDS); attr = true; } }
            { EpiSwiglu E; memset(&E, 0, sizeof E); E.H = HH; E.ldh = DFF;
              MoeArgs ma; memset(&ma, 0, sizeof ma); ma.A = (const char*)XN; ma.Bt = (const char*)MW13; ma.cnt = CNT; ma.list = LIST; ma.a_mstep = 0; ma.b_estep = (size_t)2 * DFF * D * 2; ma.b_nstep = (size_t)256 * D * 2;
              ma.nN = 2 * DFF / 256; ma.K = D; ma.lda = D; ma.ldb = D; ma.gather = 1;
              hipLaunchKernelGGL((k_moe_gemm<EpiSwiglu>), dim3(256), dim3(512), MOE_LDS, stream, ma, E); }
            { EpiMoeDown E; memset(&E, 0, sizeof E); E.YD = YD; E.GEP = GEP; E.cnt = CNT;
              MoeArgs ma; memset(&ma, 0, sizeof ma); ma.A = (const char*)HH; ma.Bt = (const char*)MW2; ma.cnt = CNT; ma.list = LIST; ma.a_mstep = (size_t)256 * DFF * 2; ma.b_estep = (size_t)D * DFF * 2; ma.b_nstep = (size_t)256 * DFF * 2;
              ma.nN = D / 256; ma.K = DFF; ma.lda = DFF; ma.ldb = DFF; ma.gather = 0;
              hipLaunchKernelGGL((k_moe_gemm<EpiMoeDown>), dim3(256), dim3(512), MOE_LDS, stream, ma, E); }
        }
    }
    hipLaunchKernelGGL(k_final, dim3(ML / 4), dim3(256), 0, stream, (const float*)XR, (const bf16_t*)YD, (const int*)SLOT, (const unsigned*)CNT, (const float*)(MODV + 3 * MODW + 5 * D), final_g, (float*)d_out);
}
```

```cpp
#include <hip/hip_runtime.h>
#include <cstdio>
#include <cstdint>
#include <cstring>

#define LAS __attribute__((address_space(3)))
typedef unsigned short bf16_t;
typedef short bf16x8 __attribute__((ext_vector_type(8)));
typedef float f32x4 __attribute__((ext_vector_type(4)));
typedef float f32x2 __attribute__((ext_vector_type(2)));
typedef unsigned u32x4 __attribute__((ext_vector_type(4)));
typedef unsigned u32x2 __attribute__((ext_vector_type(2)));

constexpr int D = 2048, NBATCH = 2, SEQ = 4096, CTXL = 256;
constexpr int ML = NBATCH * SEQ;
constexpr int MC = NBATCH * CTXL;
constexpr int MA = ML + MC;
constexpr int INW = 4128, INWP = 4352;
constexpr int DFF = 5632, NE = 8;
constexpr int GH = 4, DK = 128, DV = 256;
constexpr int C_Q = 0, C_K = 512, C_V = 1024, C_G = 2048, C_P = 3072, C_R = 4096;
constexpr float EPS = 1e-6f;
constexpr int MODW = 6 * D;

constexpr size_t MiB = 1u << 20;
constexpr size_t WS_CTL = 0;
constexpr size_t WS_MODV = 1 * MiB;
constexpr size_t WS_LIST = 2 * MiB;
constexpr size_t WS_GEP = WS_LIST + 256 * 1024;
constexpr size_t WS_SLOT = WS_GEP + 256 * 1024;
constexpr size_t WS_R = 3 * MiB;
constexpr size_t WS_WPOOL = 5 * MiB;
constexpr size_t WS_WIN = 6 * MiB;
constexpr size_t WS_WOUT = 40 * MiB;
constexpr size_t WS_W13 = 56 * MiB;
constexpr size_t WS_W2 = 100 * MiB;
constexpr size_t WS_MW13 = 122 * MiB;
constexpr size_t WS_MW2 = 474 * MiB;
constexpr size_t WS_XR = 650 * MiB;
constexpr size_t WS_XN = 718 * MiB;
constexpr size_t WS_U = 752 * MiB;
constexpr size_t WS_Y = 825 * MiB;
constexpr size_t WS_MIX = 859 * MiB;
constexpr size_t WS_HH = 876 * MiB;
constexpr size_t WS_QA = 1074 * MiB;
constexpr size_t WS_BT = 1096 * MiB;
constexpr size_t WS_DS = 1182 * MiB;
constexpr size_t WS_DEC = 1318 * MiB;
constexpr size_t WS_YD = WS_QA;
constexpr size_t WS_END = 1320 * MiB;
constexpr int CW_CNT = 1024;
constexpr int LDS_MISC = 147456;
constexpr int MOE_TAB = 131072, MOE_ROWS = 131072 + 256, MOE_MAXU = 15, MOE_LDS = MOE_ROWS + MOE_MAXU * 1024;

__device__ __forceinline__ int my_tid(int wv) { int t = wv * 64 + (int)__builtin_amdgcn_mbcnt_hi(~0u, __builtin_amdgcn_mbcnt_lo(~0u, 0u)); asm volatile("" : "+v"(t)); return t; }
namespace pg8 {
constexpr int BM = 256, BK = 64, HALF = 128, HTB = HALF * BK * 2, STAGE_BYTES = 8 * HTB, NXCD = 8, WGM = 8;
__host__ __device__ __forceinline__ int lds_byte(int r, int c) { const int st = (r >> 4) * 2 + (c >> 5), rr = r & 15, cc = c & 31, ob = rr * 64 + cc * 2; return st * 1024 + (ob ^ (((ob >> 9) & 1) << 5)); }
__host__ __device__ __forceinline__ void stage_rc(int b, int& R, int& C) { const int st = b / 1024, sb = b % 1024, swz = sb ^ (((sb >> 9) & 1) << 5); R = (st >> 1) * 16 + swz / 64; C = (st & 1) * 32 + (swz % 64) / 2; }
__host__ __device__ __forceinline__ int perm32(int rho) { const int n = rho >> 4, i = rho & 15; return 8 * (i >> 2) + 4 * n + (i & 3); }

struct Unit { const char* a; const char* b; int pm, pn, e, pml; };
struct Gemm { int K, lda, ldb, pad; };

struct TileOrder {
    static constexpr bool GATHER = false;
    const char* A; const char* Bt; size_t a_mstep, a_nstep, b_nstep; int nM, nN, nwg, G, c;
    __device__ __forceinline__ bool next(int i, Unit& u) const {
        const long L = (long)i * G + c; if (L >= nwg) return false;
        int wgid = (int)L; { const int q = nwg / NXCD, r = nwg % NXCD, xcd = wgid % NXCD, off = wgid / NXCD; wgid = (xcd < r ? xcd * (q + 1) : r * (q + 1) + (xcd - r) * q) + off; }
        const int nig = WGM * nN, gid = wgid / nig, fm = gid * WGM, gsz = (nM - fm) < WGM ? (nM - fm) : WGM;
        u.pm = fm + ((wgid % nig) % gsz); u.pn = (wgid % nig) / gsz;
        u.a = A + (size_t)u.pm * a_mstep + (size_t)u.pn * a_nstep; u.b = Bt + (size_t)u.pn * b_nstep; u.e = 0; u.pml = u.pm; return true;
    }
    __device__ __forceinline__ void a_off(int, const Unit&, int tid, int lda, unsigned (&v)[4]) const {
#pragma unroll
        for (int i = 0; i < 2; ++i) { int R, C; stage_rc(tid * 16 + i * 8192, R, C); v[i] = (unsigned)(R * lda + C) * 2u; v[2 + i] = (unsigned)((R + HALF) * lda + C) * 2u; }
    }
};

typedef __bf16 bf16x2_hw __attribute__((ext_vector_type(2)));
__device__ __forceinline__ unsigned cvt_pk_bf16(float lo, float hi) { const f32x2 v = {lo, hi}; const bf16x2_hw b = __builtin_convertvector(v, bf16x2_hw); return __builtin_bit_cast(unsigned, b); }

__device__ __forceinline__ void glds16(unsigned voff, const char* sbase, unsigned lds_dst) {
    unsigned keep;
    asm volatile("s_nop 4\n\ts_mov_b32 %0, m0\n\ts_mov_b32 m0, %2\n\ts_nop 0\n\tglobal_load_lds_dwordx4 %1, %3\n\ts_mov_b32 m0, %0" : "=&s"(keep) : "v"(voff), "s"(lds_dst), "s"(sbase) : "memory");
}
__device__ __forceinline__ const char* ubase(const char* p) {
    const unsigned long long v = (unsigned long long)p;
    const unsigned lo = __builtin_amdgcn_readfirstlane((unsigned)v), hi = __builtin_amdgcn_readfirstlane((unsigned)(v >> 32));
    return (const char*)(((unsigned long long)hi << 32) | lo);
}
typedef int v4i_t __attribute__((ext_vector_type(4)));
typedef int v8i_t __attribute__((ext_vector_type(8)));
__device__ __forceinline__ v8i_t cat8(bf16x8 lo, bf16x8 hi) { const v4i_t a = __builtin_bit_cast(v4i_t, lo), b = __builtin_bit_cast(v4i_t, hi); return __builtin_shufflevector(a, b, 0, 1, 2, 3, 4, 5, 6, 7); }
template <class Epi, class Sched, bool ALIGN_EPI, bool FP8 = false>
__device__ __forceinline__ void gemm_phase(const int wv, LAS unsigned char* lds, const Gemm g, const Sched& S, const Epi& E) {
    int tid = my_tid(wv);
    const int wid = __builtin_amdgcn_readfirstlane(tid >> 6), lane = tid & 63, wr = wid >> 2, wc = wid & 3, fr = lane & 15, fq = lane >> 4;
    const int K = g.K, nt = K / BK;
    unsigned voffB[2];
#pragma unroll
    for (int i = 0; i < 2; ++i) { int R, C; stage_rc(tid * 16 + i * 8192, R, C); const int Rb = Epi::PERM ? ((R & ~31) + perm32(R & 31)) : R;
        voffB[i] = (unsigned)(Rb * g.ldb + C) * 2u; }
    const size_t kstep = (size_t)(BK * 2);
    const size_t hB = (size_t)HALF * g.ldb * 2, hA = (size_t)HALF * g.lda * 2;
    const unsigned ldsw = (unsigned)wid * 1024u;
    constexpr bool ASMDMA = FP8 && !Sched::GATHER;
    const unsigned ldsb = (unsigned)__builtin_amdgcn_readfirstlane((int)(unsigned)(unsigned long long)(lds + ldsw));
    const int scl8 = 0x7c7c7c7c;
    const int aoff = lds_byte(wr * 64 + fr, fq * 8), boff = lds_byte(wc * 32 + fr, fq * 8);
#define PG8_SA(b, h) (((b) * 2 + (h)) * HTB)
#define PG8_SB(b, h) ((4 + (b) * 2 + (h)) * HTB)
#define PG8_STAGE(bufoff, gbase, voff) do { if constexpr (ASMDMA) { const char* _gb = ubase((const char*)(gbase)); _Pragma("unroll") for (int _i = 0; _i < 2; ++_i) glds16((voff)[_i], _gb, ldsb + (unsigned)((bufoff) + _i * 8192)); } \
        else { _Pragma("unroll") for (int _i = 0; _i < 2; ++_i) __builtin_amdgcn_global_load_lds((const unsigned*)((const char*)(gbase) + (voff)[_i]), (LAS unsigned*)(lds + (bufoff) + ldsw + _i * 8192), 16, 0, 0); } } while (0)
#define PG8_STAGEA(bufoff, gbase, voff, hh) do { if constexpr (ASMDMA) { const char* _gb = ubase((const char*)(gbase) + (hh) * hA); _Pragma("unroll") for (int _i = 0; _i < 2; ++_i) glds16((voff)[_i], _gb, ldsb + (unsigned)((bufoff) + _i * 8192)); } \
        else { _Pragma("unroll") for (int _i = 0; _i < 2; ++_i) { \
        if constexpr (Sched::GATHER) __builtin_amdgcn_global_load_lds((const unsigned*)((const char*)(gbase) + (voff)[(hh) * 2 + _i]), (LAS unsigned*)(lds + (bufoff) + ldsw + _i * 8192), 16, 0, 0); \
        else __builtin_amdgcn_global_load_lds((const unsigned*)((const char*)(gbase) + (hh) * hA + (voff)[_i]), (LAS unsigned*)(lds + (bufoff) + ldsw + _i * 8192), 16, 0, 0); } } } while (0)
#define PG8_LDA(dst, b, h) do { _Pragma("unroll") for (int m = 0; m < 4; ++m) _Pragma("unroll") for (int k = 0; k < 2; ++k) dst[m][k] = *(const LAS bf16x8*)(lds + PG8_SA(b, h) + aoff + m * 2048 + k * 1024); } while (0)
#define PG8_LDB(dst, b, h) do { _Pragma("unroll") for (int n = 0; n < 2; ++n) _Pragma("unroll") for (int k = 0; k < 2; ++k) dst[n][k] = *(const LAS bf16x8*)(lds + PG8_SB(b, h) + boff + n * 2048 + k * 1024); } while (0)
#define PG8_MMA(ai, bj, At, Bt) do { __builtin_amdgcn_s_setprio(1); \
        if constexpr (FP8) { _Pragma("unroll") for (int m = 0; m < 4; ++m) _Pragma("unroll") for (int n = 0; n < 2; ++n) \
            acc[ai][bj][m][n] = __builtin_amdgcn_mfma_scale_f32_16x16x128_f8f6f4(cat8(Bt[n][0], Bt[n][1]), cat8(At[m][0], At[m][1]), acc[ai][bj][m][n], 0, 0, 0, scl8, 0, scl8); } \
        else { _Pragma("unroll") for (int m = 0; m < 4; ++m) _Pragma("unroll") for (int n = 0; n < 2; ++n) _Pragma("unroll") for (int k = 0; k < 2; ++k) \
            acc[ai][bj][m][n] = __builtin_amdgcn_mfma_f32_16x16x32_bf16(Bt[n][k], At[m][k], acc[ai][bj][m][n], 0, 0, 0); } \
        __builtin_amdgcn_s_setprio(0); } while (0)
#define PG8_WAIT_V(n) asm volatile("s_waitcnt vmcnt(" #n ")" ::: "memory")
#define PG8_WAIT_L(n) asm volatile("s_waitcnt lgkmcnt(" #n ")" ::: "memory")
#define PG8_BAR __builtin_amdgcn_s_barrier()
#define PG8_SCHED __builtin_amdgcn_sched_barrier(0)
    Unit cur, nxt; int ui = 0;
    if (!S.next(0, cur)) return;
    f32x4 acc[2][2][4][2];
#pragma unroll
    for (int a = 0; a < 2; ++a)
#pragma unroll
        for (int b = 0; b < 2; ++b)
#pragma unroll
            for (int m = 0; m < 4; ++m)
#pragma unroll
                for (int n = 0; n < 2; ++n) acc[a][b][m][n] = (f32x4){0.f, 0.f, 0.f, 0.f};
    bf16x8 At[4][2], B0[2][2], B1[2][2];
    const char* cA = cur.a; const char* cB = cur.b;
    unsigned vA[4];
    S.a_off(0, cur, tid, g.lda, vA);
    PG8_STAGE(PG8_SB(0, 0), cB, voffB); PG8_STAGE(PG8_SB(0, 1), cB + hB, voffB); PG8_STAGEA(PG8_SA(0, 0), cA, vA, 0); PG8_STAGEA(PG8_SA(0, 1), cA, vA, 1);
    if (wr == 1) PG8_BAR;
    PG8_WAIT_V(2); PG8_BAR;
    PG8_STAGE(PG8_SB(1, 0), cB + kstep, voffB); PG8_STAGEA(PG8_SA(1, 0), cA + kstep, vA, 0); PG8_STAGE(PG8_SB(1, 1), cB + hB + kstep, voffB);
    PG8_WAIT_V(6); PG8_BAR;
    for (;;) {
        const bool has_next = S.next(ui + 1, nxt);
        const char* nA = has_next ? nxt.a : cA; const char* nB = has_next ? nxt.b : cB;
        for (int t = 0; t < nt; t += 2) {
            const bool last = (t == nt - 2);
            const char* a1 = cA + (size_t)(t + 1) * kstep;
            const char* a2 = last ? nA : cA + (size_t)(t + 2) * kstep; const char* b2 = last ? nB : cB + (size_t)(t + 2) * kstep;
            const char* a3 = a2 + kstep; const char* b3 = b2 + kstep;
            PG8_LDB(B0, 0, 0); PG8_LDB(B1, 0, 1); PG8_SCHED; PG8_LDA(At, 0, 0); PG8_STAGEA(PG8_SA(1, 1), a1, vA, 1);
            if constexpr (Sched::GATHER) { if (last && has_next) S.a_off(ui + 1, nxt, my_tid(wv), g.lda, vA); }
            PG8_WAIT_V(8); PG8_WAIT_L(0); PG8_BAR; PG8_MMA(0, 0, At, B0); PG8_MMA(0, 1, At, B1); PG8_BAR; PG8_SCHED;
            PG8_LDA(At, 0, 1); PG8_STAGE(PG8_SB(0, 0), b2, voffB); PG8_STAGE(PG8_SB(0, 1), b2 + hB, voffB); PG8_STAGEA(PG8_SA(0, 0), a2, vA, 0);
            PG8_WAIT_V(8); PG8_WAIT_L(0); PG8_BAR; PG8_MMA(1, 0, At, B0); PG8_MMA(1, 1, At, B1); PG8_BAR; PG8_SCHED;
            PG8_LDB(B0, 1, 0); PG8_LDB(B1, 1, 1); PG8_SCHED; PG8_LDA(At, 1, 0); PG8_STAGEA(PG8_SA(0, 1), a2, vA, 1);
            PG8_WAIT_V(8); PG8_WAIT_L(0); PG8_BAR; PG8_MMA(0, 0, At, B0); PG8_MMA(0, 1, At, B1); PG8_BAR; PG8_SCHED;
            PG8_LDA(At, 1, 1); PG8_STAGE(PG8_SB(1, 0), b3, voffB); PG8_STAGE(PG8_SB(1, 1), b3 + hB, voffB); PG8_STAGEA(PG8_SA(1, 0), a3, vA, 0);
            PG8_WAIT_V(8); PG8_WAIT_L(0); PG8_BAR; PG8_MMA(1, 0, At, B0); PG8_MMA(1, 1, At, B1); PG8_BAR; PG8_SCHED;
        }
        if constexpr (ALIGN_EPI) { if (wr == 0) PG8_BAR; }
        { const int te = my_tid(wv), le = te & 63, we = __builtin_amdgcn_readfirstlane(te >> 6); E(acc, cur, we >> 2, we & 3, le & 15, le >> 4); }
        if (!has_next) break;
#pragma unroll
        for (int a = 0; a < 2; ++a)
#pragma unroll
            for (int b = 0; b < 2; ++b)
#pragma unroll
                for (int m = 0; m < 4; ++m)
#pragma unroll
                    for (int n = 0; n < 2; ++n) acc[a][b][m][n] = (f32x4){0.f, 0.f, 0.f, 0.f};
        cur = nxt; cA = nA; cB = nB; ++ui;
        if constexpr (ALIGN_EPI) { if (wr == 1) PG8_BAR; }
    }
    PG8_WAIT_V(0);
    if constexpr (!ALIGN_EPI) { if (wr == 0) PG8_BAR; }
    PG8_BAR;
#undef PG8_SA
#undef PG8_SB
#undef PG8_STAGE
#undef PG8_STAGEA
#undef PG8_LDA
#undef PG8_LDB
#undef PG8_MMA
#undef PG8_WAIT_V
#undef PG8_WAIT_L
#undef PG8_BAR
#undef PG8_SCHED
}
}
using pg8::cvt_pk_bf16;
typedef f32x4 Acc[2][2][4][2];

__device__ __forceinline__ float bf2f(bf16_t v) { return __uint_as_float(((unsigned)v) << 16); }
__device__ __forceinline__ float siluf(float a) { return a * __builtin_amdgcn_rcpf(1.f + __expf(-a)); }
__device__ __forceinline__ int mod_index(int row) { return row < SEQ ? 0 : (row < ML ? 1 : 2); }

struct EpiIn {
    static constexpr bool PERM = true;
    bf16_t* U; float* R;
    __device__ __forceinline__ void operator()(const Acc& acc, const pg8::Unit& u, int wr, int wc, int fr, int fq) const {
        const int row0 = u.pm * 256 + wr * 64 + fr, col0 = u.pn * 256 + wc * 32 + 8 * fq;
        const float sc = (u.pn < 2) ? 0.08838834764831845f : 1.f;
#pragma unroll
        for (int ai = 0; ai < 2; ++ai)
#pragma unroll
            for (int m = 0; m < 4; ++m) { const int row = row0 + ai * 128 + m * 16; bf16_t* rowp = U + (size_t)row * INWP + col0;
#pragma unroll
                for (int bj = 0; bj < 2; ++bj) { const f32x4 v0 = acc[ai][bj][m][0] * sc, v1 = acc[ai][bj][m][1] * sc;
                    u32x4 w; w.x = cvt_pk_bf16(v0[0], v0[1]); w.y = cvt_pk_bf16(v0[2], v0[3]); w.z = cvt_pk_bf16(v1[0], v1[1]); w.w = cvt_pk_bf16(v1[2], v1[3]);
                    *(u32x4*)(rowp + bj * 128) = w; }
                if (u.pn == 16 && wc == 0) { float* rp = R + (size_t)row * 32 + 8 * fq; *(f32x4*)rp = acc[ai][0][m][0]; *(f32x4*)(rp + 4) = acc[ai][0][m][1]; } }
    }
};
struct EpiPool {
    static constexpr bool PERM = true;
    bf16_t* Y; const float* scale;
    __device__ __forceinline__ void operator()(const Acc& acc, const pg8::Unit& u, int wr, int wc, int fr, int fq) const {
        const int row0 = u.pm * 256 + wr * 64 + fr, col0 = u.pn * 256 + wc * 32 + 8 * fq;
        f32x4 sv[2][2];
#pragma unroll
        for (int bj = 0; bj < 2; ++bj)
#pragma unroll
            for (int n = 0; n < 2; ++n) sv[bj][n] = *(const f32x4*)(scale + col0 + bj * 128 + 4 * n);
#pragma unroll
        for (int ai = 0; ai < 2; ++ai)
#pragma unroll
            for (int m = 0; m < 4; ++m) { bf16_t* rowp = Y + (size_t)(row0 + ai * 128 + m * 16) * D + 1024 + col0;
#pragma unroll
                for (int bj = 0; bj < 2; ++bj) { const f32x4 v0 = acc[ai][bj][m][0] * sv[bj][0], v1 = acc[ai][bj][m][1] * sv[bj][1];
                    u32x4 w; w.x = cvt_pk_bf16(v0[0], v0[1]); w.y = cvt_pk_bf16(v0[2], v0[3]); w.z = cvt_pk_bf16(v1[0], v1[1]); w.w = cvt_pk_bf16(v1[2], v1[3]);
                    *(u32x4*)(rowp + bj * 128) = w; } }
    }
};
struct EpiResid {
    static constexpr bool PERM = false;
    const float* src_lat; const float* src_ctx; float* XR; const float* gate; const float* rowgate; int rg_stride, ctx_row0;
    __device__ __forceinline__ void operator()(const Acc& acc, const pg8::Unit& u, int wr, int wc, int fr, int fq) const {
        const int row0 = u.pm * 256 + wr * 64 + fr, col0 = u.pn * 256 + wc * 32 + 4 * fq;
        const int mi = u.pm < 16 ? 0 : (u.pm < 32 ? 1 : 2);
        const float* src = u.pm < 32 ? src_lat : src_ctx - (size_t)ctx_row0 * D;
        f32x4 gv[2][2];
#pragma unroll
        for (int bj = 0; bj < 2; ++bj)
#pragma unroll
            for (int n = 0; n < 2; ++n) gv[bj][n] = *(const f32x4*)(gate + (size_t)mi * MODW + col0 + bj * 128 + n * 16);
#pragma unroll
        for (int ai = 0; ai < 2; ++ai)
#pragma unroll
            for (int mp = 0; mp < 2; ++mp) { f32x4 bs[2][2][2];
#pragma unroll
                for (int mm = 0; mm < 2; ++mm) { const size_t off = (size_t)(row0 + ai * 128 + (2 * mp + mm) * 16) * D + col0;
#pragma unroll
                    for (int bj = 0; bj < 2; ++bj)
#pragma unroll
                        for (int n = 0; n < 2; ++n) bs[mm][bj][n] = *(const f32x4*)(src + off + bj * 128 + n * 16); }
#pragma unroll
                for (int mm = 0; mm < 2; ++mm) { const size_t off = (size_t)(row0 + ai * 128 + (2 * mp + mm) * 16) * D + col0;
#pragma unroll
                    for (int bj = 0; bj < 2; ++bj)
#pragma unroll
                        for (int n = 0; n < 2; ++n) *(f32x4*)(XR + off + bj * 128 + n * 16) = bs[mm][bj][n] + gv[bj][n] * acc[ai][bj][2 * mp + mm][n]; } }
    }
};
struct EpiSwiglu {
    static constexpr bool PERM = true;
    bf16_t* H; int ldh, pad;
    __device__ __forceinline__ void operator()(const Acc& acc, const pg8::Unit& u, int wr, int wc, int fr, int fq) const {
        const int row0 = u.pm * 256 + wr * 64 + fr, col0 = u.pn * 128 + wc * 32 + 8 * fq;
#pragma unroll
        for (int ai = 0; ai < 2; ++ai)
#pragma unroll
            for (int m = 0; m < 4; ++m) { bf16_t* rowp = H + (size_t)(row0 + ai * 128 + m * 16) * ldh + col0;
                float h[8];
#pragma unroll
                for (int n = 0; n < 2; ++n)
#pragma unroll
                    for (int j = 0; j < 4; ++j) h[n * 4 + j] = siluf(acc[ai][0][m][n][j]) * acc[ai][1][m][n][j];
                u32x4 w; w.x = cvt_pk_bf16(h[0], h[1]); w.y = cvt_pk_bf16(h[2], h[3]); w.z = cvt_pk_bf16(h[4], h[5]); w.w = cvt_pk_bf16(h[6], h[7]);
                *(u32x4*)rowp = w; }
    }
};

struct EpiSwiglu8 {
    static constexpr bool PERM = true;
    unsigned char* H; int ldh, pad;
    __device__ __forceinline__ void operator()(const Acc& acc, const pg8::Unit& u, int wr, int wc, int fr, int fq) const {
        const int row0 = u.pm * 256 + wr * 64 + fr, col0 = u.pn * 128 + wc * 32 + 8 * fq;
#pragma unroll
        for (int ai = 0; ai < 2; ++ai)
#pragma unroll
            for (int m = 0; m < 4; ++m) { unsigned char* rowp = H + (size_t)(row0 + ai * 128 + m * 16) * ldh + col0;
                float h[8];
#pragma unroll
                for (int n = 0; n < 2; ++n)
#pragma unroll
                    for (int j = 0; j < 4; ++j) h[n * 4 + j] = siluf(acc[ai][0][m][n][j]) * acc[ai][1][m][n][j];
                int x0 = 0, x1 = 0;
                x0 = __builtin_amdgcn_cvt_pk_fp8_f32(h[0], h[1], x0, false); x0 = __builtin_amdgcn_cvt_pk_fp8_f32(h[2], h[3], x0, true);
                x1 = __builtin_amdgcn_cvt_pk_fp8_f32(h[4], h[5], x1, false); x1 = __builtin_amdgcn_cvt_pk_fp8_f32(h[6], h[7], x1, true);
                *(u32x2*)rowp = (u32x2){(unsigned)x0, (unsigned)x1}; }
    }
};
__device__ __forceinline__ void moe_tab_init(const int wv, LAS int* tab, const unsigned* cnt, int nN) {
    if (my_tid(wv) == 0) { int tb = 0, hr = 0;
        for (int e = 0; e < NE; ++e) { const int n = (int)cnt[64 * e], r = (n + 255) >> 8; tab[e] = tb; tab[16 + e] = hr; tab[32 + e] = r; tab[48 + e] = n; tb += r * nN; hr += r; }
        tab[8] = tb; tab[24] = hr; }
    __syncthreads();
}
template <bool GATHER_> struct MoeOrder {
    static constexpr bool GATHER = GATHER_; static constexpr int gather = GATHER_ ? 1 : 0;
    const char* A; const char* Bt; size_t a_mstep, b_estep, b_nstep; const LAS int* tab; const LAS int* rows; int nN, G, c;
    __device__ __forceinline__ bool next(int i, pg8::Unit& u) const {
        const int nwg = __builtin_amdgcn_readfirstlane(tab[8]); const long L = (long)i * G + c; if (L >= nwg || i >= MOE_MAXU) return false;
        int wgid = (int)L; { const int q = nwg / 8, r = nwg % 8, xcd = wgid % 8, off = wgid / 8; wgid = (xcd < r ? xcd * (q + 1) : r * (q + 1) + (xcd - r) * q) + off; }
        int e = 0;
#pragma unroll
        for (int k = 1; k < NE; ++k) e += (wgid >= tab[k]) ? 1 : 0;
        e = __builtin_amdgcn_readfirstlane(e);
        const int loc = wgid - __builtin_amdgcn_readfirstlane(tab[e]), nM = __builtin_amdgcn_readfirstlane(tab[32 + e]);
        const int nig = 8 * nN, gid = loc / nig, fm = gid * 8, gsz = (nM - fm) < 8 ? (nM - fm) : 8;
        u.pml = fm + ((loc % nig) % gsz); u.pn = (loc % nig) / gsz; u.e = e; u.pm = __builtin_amdgcn_readfirstlane(tab[16 + e]) + u.pml;
        u.a = gather ? A : A + (size_t)u.pm * a_mstep; u.b = Bt + (size_t)e * b_estep + (size_t)u.pn * b_nstep; return true;
    }
    __device__ __forceinline__ void a_off(int ui, const pg8::Unit&, int tid, int lda, unsigned (&v)[4]) const {
#pragma unroll
        for (int i = 0; i < 2; ++i) { int R, C; pg8::stage_rc(tid * 16 + i * 8192, R, C);
#pragma unroll
            for (int hh = 0; hh < 2; ++hh) { const int row = gather ? rows[ui * 256 + hh * 128 + R] : (R + hh * 128); v[hh * 2 + i] = (unsigned)(row * lda + C) * 2u; } }
    }
};
struct EpiMoeDown {
    static constexpr bool PERM = true;
    bf16_t* YD;
    __device__ __forceinline__ void operator()(const Acc& acc, const pg8::Unit& u, int wr, int wc, int fr, int fq) const {
        const int row0 = u.pm * 256 + wr * 64 + fr, col0 = u.pn * 256 + wc * 32 + 8 * fq;
#pragma unroll
        for (int ai = 0; ai < 2; ++ai)
#pragma unroll
            for (int m = 0; m < 4; ++m) { bf16_t* rowp = YD + (size_t)(row0 + ai * 128 + m * 16) * D + col0;
#pragma unroll
                for (int bj = 0; bj < 2; ++bj) { const f32x4 v0 = acc[ai][bj][m][0], v1 = acc[ai][bj][m][1];
                    u32x4 w; w.x = cvt_pk_bf16(v0[0], v0[1]); w.y = cvt_pk_bf16(v0[2], v0[3]); w.z = cvt_pk_bf16(v1[0], v1[1]); w.w = cvt_pk_bf16(v1[2], v1[3]);
                    *(u32x4*)(rowp + bj * 128) = w; } }
    }
};
__device__ __forceinline__ float wave_sum(float v) {
#pragma unroll
    for (int o = 1; o < 64; o <<= 1) v += __shfl_xor(v, o);
    return v;
}
__device__ __forceinline__ unsigned f2bf(float f) { unsigned u = __float_as_uint(f); return (u + 0x7fffu + ((u >> 16) & 1u)) >> 16; }
constexpr int NCH = 68, NUN = 8 * NCH, KQ = 320;
constexpr int G1_CUM = 0, G1_QP = 33792, G1_KI = 51200, G1_KT = 68608, G1_VT = 87040, G1_WG = 123904, G1_BG = 140288, G1_AS = G1_QP  , G1_LDS = 141312;
__device__ __forceinline__ int gla_row0(int b, int c) { return c < 4 ? ML + b * CTXL + c * 64 : b * SEQ + (c - 4) * 64; }
__device__ __forceinline__ float bflo(unsigned w) { return __uint_as_float(w << 16); }
__device__ __forceinline__ float bfhi(unsigned w) { return __uint_as_float(w & 0xffff0000u); }
__device__ __forceinline__ float wave_scan_incl(float x, int lane) {
    x += __builtin_bit_cast(float, __builtin_amdgcn_update_dpp(0, __builtin_bit_cast(int, x), 0x111, 0xf, 0xf, false));
    x += __builtin_bit_cast(float, __builtin_amdgcn_update_dpp(0, __builtin_bit_cast(int, x), 0x112, 0xf, 0xf, false));
    x += __builtin_bit_cast(float, __builtin_amdgcn_update_dpp(0, __builtin_bit_cast(int, x), 0x114, 0xf, 0xf, false));
    x += __builtin_bit_cast(float, __builtin_amdgcn_update_dpp(0, __builtin_bit_cast(int, x), 0x118, 0xf, 0xf, false));
    const float t0 = __builtin_bit_cast(float, __builtin_amdgcn_readlane(__builtin_bit_cast(int, x), 15)), t1 = __builtin_bit_cast(float, __builtin_amdgcn_readlane(__builtin_bit_cast(int, x), 31)),
                t2 = __builtin_bit_cast(float, __builtin_amdgcn_readlane(__builtin_bit_cast(int, x), 47));
    return x + (lane >= 16 ? t0 : 0.f) + (lane >= 32 ? t1 : 0.f) + (lane >= 48 ? t2 : 0.f);
}
__device__ __forceinline__ float log_sigmoid_fast(float x) { return fminf(x, 0.f) - __logf(1.f + __expf(-fabsf(x))); }

__device__ __forceinline__ void gla_g1_unit(const int wv, LAS unsigned char* lds, int un, const bf16_t* U, const float* R, const float* wg, const float* bg, bf16_t* QAF, bf16_t* BTF, bf16_t* DSF, float* DEC) {
    int tid = my_tid(wv);
    const int lane = tid & 63, wid = __builtin_amdgcn_readfirstlane(tid >> 6), fr = lane & 15, fq = lane >> 4;
    const int bh = un / NCH, c = un % NCH, b = bh >> 2, h = bh & 3;
    const int row0 = gla_row0(b, c);
    LAS float* CUM = (LAS float*)(lds + G1_CUM);
    LAS bf16_t* QP = (LAS bf16_t*)(lds + G1_QP); LAS bf16_t* KI = (LAS bf16_t*)(lds + G1_KI); LAS bf16_t* KT = (LAS bf16_t*)(lds + G1_KT);
    LAS bf16_t* VT = (LAS bf16_t*)(lds + G1_VT); LAS bf16_t* AS = (LAS bf16_t*)(lds + G1_AS);
    LAS float* WG = (LAS float*)(lds + G1_WG); LAS float* BG = (LAS float*)(lds + G1_BG);
    u32x4 qv[2], kv[2];
#pragma unroll
    for (int i = 0; i < 2; ++i) { const int dg = (tid + 512 * i) >> 6;
        qv[i] = *(const u32x4*)(U + (size_t)(row0 + lane) * INWP + C_Q + h * DK + dg * 8); kv[i] = *(const u32x4*)(U + (size_t)(row0 + lane) * INWP + C_K + h * DK + dg * 8); }
    f32x4 rq[2][4];
#pragma unroll
    for (int dr = 0; dr < 2; ++dr) { const float* rp = R + (size_t)(row0 + (dr == 0 ? lane : 63 - lane)) * 32 + dr * 16;
#pragma unroll
        for (int x = 0; x < 4; ++x) rq[dr][x] = *(const f32x4*)(rp + 4 * x); }
    { const int e0 = tid * 8, rw = e0 >> 7, d0 = e0 & 127;
      const f32x4 w0 = *(const f32x4*)(wg + (size_t)rw * 512 + h * DK + d0), w1 = *(const f32x4*)(wg + (size_t)rw * 512 + h * DK + d0 + 4);
      *(LAS f32x4*)(WG + e0) = w0; *(LAS f32x4*)(WG + e0 + 4) = w1;
      if (tid < 64) { const int b0 = tid * 4; *(LAS f32x4*)(BG + b0) = *(const f32x4*)(bg + (size_t)(b0 >> 7) * 512 + h * DK + (b0 & 127)); } }
#pragma unroll
    for (int i = 0; i < 4; ++i) { const int idx = tid + 512 * i, jg = idx >> 6, s = idx & 63;
        const u32x4 q = *(const u32x4*)(U + (size_t)(row0 + s) * INWP + C_V + h * DV + jg * 8);
        LAS bf16_t* vp = VT + (jg * 8) * 72 + s;
        vp[0] = (bf16_t)(q.x & 0xffffu); vp[72] = (bf16_t)(q.x >> 16); vp[144] = (bf16_t)(q.y & 0xffffu); vp[216] = (bf16_t)(q.y >> 16);
        vp[288] = (bf16_t)(q.z & 0xffffu); vp[360] = (bf16_t)(q.z >> 16); vp[432] = (bf16_t)(q.w & 0xffffu); vp[504] = (bf16_t)(q.w >> 16); }
    f32x4 Aacc[2]; Aacc[0] = (f32x4){0.f, 0.f, 0.f, 0.f}; Aacc[1] = (f32x4){0.f, 0.f, 0.f, 0.f};
    __syncthreads();
    for (int dir = 0; dir < 2; ++dir) {
        { const int t = dir == 0 ? lane : 63 - lane;
          const float rr[16] = {rq[dir][0].x, rq[dir][0].y, rq[dir][0].z, rq[dir][0].w, rq[dir][1].x, rq[dir][1].y, rq[dir][1].z, rq[dir][1].w, rq[dir][2].x, rq[dir][2].y, rq[dir][2].z, rq[dir][2].w, rq[dir][3].x, rq[dir][3].y, rq[dir][3].z, rq[dir][3].w};
          for (int dd = 0; dd < 16; dd += 4) { const int d = wid * 16 + dd;
              const f32x4 b4 = *(const LAS f32x4*)(BG + dir * 128 + d);
              float pre[4] = {b4.x, b4.y, b4.z, b4.w};
#pragma unroll
              for (int k = 0; k < 16; ++k) { const f32x4 w4 = *(const LAS f32x4*)(WG + (dir * 16 + k) * 128 + d); pre[0] += rr[k] * w4.x; pre[1] += rr[k] * w4.y; pre[2] += rr[k] * w4.z; pre[3] += rr[k] * w4.w; }
#pragma unroll
              for (int q = 0; q < 4; ++q) CUM[t * 132 + d + q] = wave_scan_incl(log_sigmoid_fast(pre[q]) * (1.f / 16.f), lane); } }
        __syncthreads();
        if (dir == 0) {
#pragma unroll
            for (int i = 0; i < 4; ++i) { const int idx = tid + 512 * i, j = idx >> 3, sg = idx & 7;
                *(u32x4*)(BTF + ((((size_t)un * 16 + (j >> 4)) * 10 + 8 + (sg >> 2)) * 64 + (sg & 3) * 16 + (j & 15)) * 8) = *(const LAS u32x4*)(VT + j * 72 + sg * 8); } }
        const int tl = dir == 0 ? 63 : 0;
#pragma unroll
        for (int i = 0; i < 2; ++i) { const int dg = (tid + 512 * i) >> 6, s = lane;
            const f32x4 c0 = *(const LAS f32x4*)(CUM + s * 132 + dg * 8), c1 = *(const LAS f32x4*)(CUM + s * 132 + dg * 8 + 4);
            const f32x4 l0 = *(const LAS f32x4*)(CUM + tl * 132 + dg * 8), l1 = *(const LAS f32x4*)(CUM + tl * 132 + dg * 8 + 4);
            const float qf[8] = {bflo(qv[i].x), bfhi(qv[i].x), bflo(qv[i].y), bfhi(qv[i].y), bflo(qv[i].z), bfhi(qv[i].z), bflo(qv[i].w), bfhi(qv[i].w)};
            const float kf[8] = {bflo(kv[i].x), bfhi(kv[i].x), bflo(kv[i].y), bfhi(kv[i].y), bflo(kv[i].z), bfhi(kv[i].z), bflo(kv[i].w), bfhi(kv[i].w)};
            const float cc[8] = {c0.x, c0.y, c0.z, c0.w, c1.x, c1.y, c1.z, c1.w}, cl[8] = {l0.x, l0.y, l0.z, l0.w, l1.x, l1.y, l1.z, l1.w};
            float qp[8], ki[8], ke[8];
#pragma unroll
            for (int e = 0; e < 8; ++e) { qp[e] = qf[e] * __expf(cc[e]); ki[e] = kf[e] * __expf(fminf(-cc[e], 80.f)); ke[e] = kf[e] * __expf(cl[e] - cc[e]); }
            u32x4 w; w.x = cvt_pk_bf16(qp[0], qp[1]); w.y = cvt_pk_bf16(qp[2], qp[3]); w.z = cvt_pk_bf16(qp[4], qp[5]); w.w = cvt_pk_bf16(qp[6], qp[7]);
            *(LAS u32x4*)(QP + s * 136 + dg * 8) = w;
            *(u32x4*)(QAF + ((((size_t)un * 4 + (s >> 4)) * 10 + dir * 4 + (dg >> 2)) * 64 + (dg & 3) * 16 + (s & 15)) * 8) = w;
            u32x4 w2; w2.x = cvt_pk_bf16(ki[0], ki[1]); w2.y = cvt_pk_bf16(ki[2], ki[3]); w2.z = cvt_pk_bf16(ki[4], ki[5]); w2.w = cvt_pk_bf16(ki[6], ki[7]);
            *(LAS u32x4*)(KI + s * 136 + dg * 8) = w2;
#pragma unroll
            for (int e = 0; e < 8; ++e) KT[(dg * 8 + e) * 72 + s] = (bf16_t)f2bf(ke[e]);
            if (s == tl) { float* dp = DEC + ((size_t)un * 2 + dir) * 128 + dg * 8;
                *(f32x4*)dp = (f32x4){__expf(cl[0]), __expf(cl[1]), __expf(cl[2]), __expf(cl[3])}; *(f32x4*)(dp + 4) = (f32x4){__expf(cl[4]), __expf(cl[5]), __expf(cl[6]), __expf(cl[7])}; } }
        __syncthreads();
        { const int tb = wid >> 1;
#pragma unroll
          for (int x = 0; x < 2; ++x) { const int sb = (wid & 1) * 2 + x; f32x4 a = (f32x4){0.f, 0.f, 0.f, 0.f};
#pragma unroll
              for (int ks = 0; ks < 4; ++ks) { const bf16x8 Af = *(const LAS bf16x8*)(QP + (tb * 16 + fr) * 136 + ks * 32 + fq * 8), Bf = *(const LAS bf16x8*)(KI + (sb * 16 + fr) * 136 + ks * 32 + fq * 8);
                  a = __builtin_amdgcn_mfma_f32_16x16x32_bf16(Af, Bf, a, 0, 0, 0); }
#pragma unroll
              for (int jj = 0; jj < 4; ++jj) { const int t = tb * 16 + 4 * fq + jj, sx = sb * 16 + fr; const bool keep = dir == 0 ? (sx <= t) : (sx >= t); Aacc[x][jj] += keep ? a[jj] : 0.f; } } }
#pragma unroll
        for (int jbi = 0; jbi < 2; ++jbi) { const int jb = wid * 2 + jbi;
            const bf16x8 Bf0 = *(const LAS bf16x8*)(VT + (jb * 16 + fr) * 72 + fq * 8), Bf1 = *(const LAS bf16x8*)(VT + (jb * 16 + fr) * 72 + 32 + fq * 8);
#pragma unroll
            for (int db = 0; db < 8; ++db) { const bf16x8 Af0 = *(const LAS bf16x8*)(KT + (db * 16 + fr) * 72 + fq * 8), Af1 = *(const LAS bf16x8*)(KT + (db * 16 + fr) * 72 + 32 + fq * 8);
                f32x4 a = (f32x4){0.f, 0.f, 0.f, 0.f};
                a = __builtin_amdgcn_mfma_f32_16x16x32_bf16(Af0, Bf0, a, 0, 0, 0); a = __builtin_amdgcn_mfma_f32_16x16x32_bf16(Af1, Bf1, a, 0, 0, 0);
                u32x2 w; w.x = cvt_pk_bf16(a.x, a.y); w.y = cvt_pk_bf16(a.z, a.w);
                *(u32x2*)(DSF + (((((size_t)un * 2 + dir) * 16 + jb) * 4 + (db >> 1)) * 64 + ((db & 1) * 2 + (fq >> 1)) * 16 + fr) * 8 + (fq & 1) * 4) = w; } }
        __syncthreads();
    }
    { const int tb = wid >> 1;
#pragma unroll
      for (int x = 0; x < 2; ++x) { const int sb = (wid & 1) * 2 + x;
#pragma unroll
          for (int jj = 0; jj < 4; ++jj) AS[(tb * 16 + 4 * fq + jj) * 72 + sb * 16 + fr] = (bf16_t)f2bf(Aacc[x][jj]); } }
    __syncthreads();
    { const int t = tid >> 3, sg = tid & 7;
      *(u32x4*)(QAF + ((((size_t)un * 4 + (t >> 4)) * 10 + 8 + (sg >> 2)) * 64 + (sg & 3) * 16 + (t & 15)) * 8) = *(const LAS u32x4*)(AS + t * 72 + sg * 8); }
    __syncthreads();
}
__device__ __forceinline__ void gla_g3_unit(const int wv, LAS unsigned char* lds, int un, const bf16_t* QAF, const bf16_t* BTF, const bf16_t* U, const float* gain, bf16_t* Y) {
    int tid = my_tid(wv);
    const int lane = tid & 63, wid = __builtin_amdgcn_readfirstlane(tid >> 6), fr = lane & 15, fq = lane >> 4;
    const int bh = un / NCH, c = un % NCH, b = bh >> 2, h = bh & 3, row0 = gla_row0(b, c);
    const int tb = wid & 3, jh = wid >> 2;
    const bf16_t* qa = QAF + ((size_t)un * 4 + tb) * 10 * 512 + lane * 8;
    const bf16_t* bt = BTF + ((size_t)un * 16 + jh * 8) * 10 * 512 + lane * 8;
    f32x4 acc[8];
#pragma unroll
    for (int jb = 0; jb < 8; ++jb) acc[jb] = (f32x4){0.f, 0.f, 0.f, 0.f};
    bf16x8 Bc = *(const bf16x8*)qa, Ac[8];
#pragma unroll
    for (int jb = 0; jb < 8; ++jb) Ac[jb] = *(const bf16x8*)(bt + (size_t)jb * 10 * 512);
#pragma unroll
    for (int ks = 0; ks < 10; ++ks) {
        bf16x8 Bn = Bc, An[8];
#pragma unroll
        for (int jb = 0; jb < 8; ++jb) An[jb] = Ac[jb];
        if (ks < 9) { Bn = *(const bf16x8*)(qa + (ks + 1) * 512);
#pragma unroll
            for (int jb = 0; jb < 8; ++jb) An[jb] = *(const bf16x8*)(bt + ((size_t)jb * 10 + ks + 1) * 512); }
#pragma unroll
        for (int jb = 0; jb < 8; ++jb) acc[jb] = __builtin_amdgcn_mfma_f32_16x16x32_bf16(Ac[jb], Bc, acc[jb], 0, 0, 0);
        Bc = Bn;
#pragma unroll
        for (int jb = 0; jb < 8; ++jb) Ac[jb] = An[jb];
    }
    float ss = 0.f;
#pragma unroll
    for (int jb = 0; jb < 8; ++jb) ss += (acc[jb].x * acc[jb].x + acc[jb].y * acc[jb].y) + (acc[jb].z * acc[jb].z + acc[jb].w * acc[jb].w);
    ss += __shfl_xor(ss, 16); ss += __shfl_xor(ss, 32);
    LAS float* P = (LAS float*)lds;
    if (fq == 0) P[wid * 16 + fr] = ss;
    __syncthreads();
    const float tot = P[wid * 16 + fr] + P[(wid ^ 4) * 16 + fr];
    const float rstd = 1.0f / sqrtf(tot * (1.f / DV) + EPS);
    const int row = row0 + tb * 16 + fr;
#pragma unroll
    for (int jb = 0; jb < 8; ++jb) { const int col = h * DV + jh * 128 + jb * 16 + 4 * fq;
        const f32x4 gn = *(const f32x4*)(gain + col); const u32x2 gw = *(const u32x2*)(U + (size_t)row * INWP + C_G + col);
        const f32x4 o = acc[jb] * rstd * gn;
        u32x2 w; w.x = cvt_pk_bf16(o.x * siluf(bflo(gw.x)), o.y * siluf(bfhi(gw.x))); w.y = cvt_pk_bf16(o.z * siluf(bflo(gw.y)), o.w * siluf(bfhi(gw.y)));
        *(u32x2*)(Y + (size_t)row * D + col) = w; }
    __syncthreads();
}

__device__ __forceinline__ const void* ldptr(volatile LAS unsigned long long* tab, int i) {
    const unsigned long long v = tab[i];
    const unsigned lo = __builtin_amdgcn_readfirstlane((unsigned)v), hi = __builtin_amdgcn_readfirstlane((unsigned)(v >> 32));
    return (const void*)(((unsigned long long)hi << 32) | lo);
}
constexpr int CVT_TILE_F = 128 * 33;
__device__ __forceinline__ void cvt_item(LAS float* t, int lane, const float* srcb, bf16_t* dstb, size_t sms, size_t dms, int K, int N, int nb, int rs, int off, int ktiles, int per, int it) {
    const int lr = lane >> 4, lc = (lane & 15) * 4;
    const int sr = lane >> 3, sk = (lane & 7) * 8;
    const int mat = it / per, r = it % per, nt = r / ktiles, kt = r % ktiles, k0 = kt * 64, n0 = nt * 64;
    const float* src = srcb + (size_t)mat * sms + (size_t)(k0 + lr) * N + n0 + lc;
    const bool inb = (n0 + lc) < N;
    f32x4 v[16];
#pragma unroll
    for (int i = 0; i < 16; ++i) v[i] = inb ? __builtin_nontemporal_load((const f32x4*)(src + (size_t)(4 * i) * N)) : (f32x4){0.f, 0.f, 0.f, 0.f};
#pragma unroll
    for (int i = 0; i < 16; ++i) { LAS float* tp = t + (lr + 4 * i) * 65 + lc; tp[0] = v[i].x; tp[1] = v[i].y; tp[2] = v[i].z; tp[3] = v[i].w; }
    asm volatile("s_waitcnt lgkmcnt(0)" ::: "memory");
    bf16_t* dst = dstb + (size_t)mat * dms;
#pragma unroll
    for (int p = 0; p < 8; ++p) { const int nn = sr + 8 * p, n = n0 + nn; const int drow = (n / nb) * rs + (n % nb) + off;
        const LAS float* tp = t + sk * 65 + nn;
        u32x4 w; w.x = cvt_pk_bf16(tp[0], tp[65]); w.y = cvt_pk_bf16(tp[2 * 65], tp[3 * 65]); w.z = cvt_pk_bf16(tp[4 * 65], tp[5 * 65]); w.w = cvt_pk_bf16(tp[6 * 65], tp[7 * 65]);
        __builtin_nontemporal_store(w, (u32x4*)(dst + (size_t)drow * K + k0 + sk)); }
    asm volatile("s_waitcnt lgkmcnt(0)" ::: "memory");
}
__device__ __forceinline__ void p_convert(const int wv, LAS unsigned char* lds, const float* srcb, bf16_t* dstb, size_t sms, size_t dms, int K, int N, int NP, int nb, int rs, int off, int nmat) {
    int tid = my_tid(wv);
    const int lane = tid & 63, wave = tid >> 6;
    LAS float* t = (LAS float*)lds + wave * CVT_TILE_F;
    const int ktiles = K / 64, ntiles = NP / 64, per = ktiles * ntiles, total = per * nmat;
    for (int it = blockIdx.x * 8 + wave; it < total; it += gridDim.x * 8) cvt_item(t, lane, srcb, dstb, sms, dms, K, N, nb, rs, off, ktiles, per, it);
}
__device__ __forceinline__ void cvt8_item(LAS float* t, int lane, const float* srcb, unsigned char* dstb, size_t sms, size_t dms, int K, int N, int nb, int rs, int off, int ktiles, int per, int it) {
    const int lr = lane >> 3, lc = (lane & 7) * 4;
    const int sr = lane >> 3, sk = (lane & 7) * 16;
    const int mat = it / per, r = it % per, nt = r / ktiles, kt = r % ktiles, k0 = kt * 128, n0 = nt * 32;
    const float* src = srcb + (size_t)mat * sms + (size_t)(k0 + lr) * N + n0 + lc;
    f32x4 v[16];
#pragma unroll
    for (int i = 0; i < 16; ++i) v[i] = __builtin_nontemporal_load((const f32x4*)(src + (size_t)(8 * i) * N));
#pragma unroll
    for (int i = 0; i < 16; ++i) { LAS float* tp = t + (lr + 8 * i) * 33 + lc; tp[0] = v[i].x * 64.f; tp[1] = v[i].y * 64.f; tp[2] = v[i].z * 64.f; tp[3] = v[i].w * 64.f; }
    asm volatile("s_waitcnt lgkmcnt(0)" ::: "memory");
    unsigned char* dst = dstb + (size_t)mat * dms;
#pragma unroll
    for (int p = 0; p < 4; ++p) { const int nn = sr + 8 * p, n = n0 + nn; const int drow = (n / nb) * rs + (n % nb) + off;
        const LAS float* tp = t + sk * 33 + nn;
        unsigned w[4];
#pragma unroll
        for (int q = 0; q < 4; ++q) { int x = 0; x = __builtin_amdgcn_cvt_pk_fp8_f32(tp[(4 * q) * 33], tp[(4 * q + 1) * 33], x, false); x = __builtin_amdgcn_cvt_pk_fp8_f32(tp[(4 * q + 2) * 33], tp[(4 * q + 3) * 33], x, true); w[q] = (unsigned)x; }
        __builtin_nontemporal_store((u32x4){w[0], w[1], w[2], w[3]}, (u32x4*)(dst + (size_t)drow * K + k0 + sk)); }
    asm volatile("s_waitcnt lgkmcnt(0)" ::: "memory");
}
constexpr int CW_Q = 2048, CW_DONE = 2112;
constexpr int QJ_WOUT = (D / 64) * (D / 64), QJ_F13 = (D / 64) * (DFF / 64), QJ_WIN = (D / 64) * (INWP / 64), QJ_MOE = NE * QJ_F13;
constexpr int Q_WOUT0 = QJ_WOUT, Q_F3 = Q_WOUT0 + 2 * QJ_F13, Q_F2 = Q_F3 + QJ_F13, Q_WIN1 = Q_F2 + QJ_WIN, Q_WOUT1 = Q_WIN1 + QJ_WOUT, Q_ALL = Q_WOUT1 + 3 * QJ_MOE;
__device__ __forceinline__ void q_item(LAS float* t, int lane, int item, volatile LAS unsigned long long* PT) {
    unsigned char* ws = (unsigned char*)ldptr(PT, 25);
    const float* src; bf16_t* dst; size_t sms = 0, dms = 0; int K = D, N = D, NP = D, nb = 1 << 30, rs = 0, off = 0, it = item;
    if (item < Q_WOUT0) { src = (const float*)ldptr(PT, 14); dst = (bf16_t*)(ws + WS_WOUT); }
    else if (item < Q_F3) { const int j = (item - Q_WOUT0) / QJ_F13; it = item - Q_WOUT0 - j * QJ_F13; src = (const float*)ldptr(PT, 15 + j); dst = (bf16_t*)(ws + WS_W13); N = DFF; NP = DFF; nb = 128; rs = 256; off = j * 128; }
    else if (item < Q_F2) { it = item - Q_F3; src = (const float*)ldptr(PT, 17); dst = (bf16_t*)(ws + WS_W2); K = DFF; }
    else if (item < Q_WIN1) { it = item - Q_F2; src = (const float*)ldptr(PT, 8) + (size_t)D * INW; dst = (bf16_t*)(ws + WS_WIN) + (size_t)INWP * D; N = INW; NP = INWP; }
    else if (item < Q_WOUT1) { it = item - Q_WIN1; src = (const float*)ldptr(PT, 14) + (size_t)D * D; dst = (bf16_t*)(ws + WS_WOUT) + (size_t)D * D; }
    else { const int j = (item - Q_WOUT1) / QJ_MOE; it = item - Q_WOUT1 - j * QJ_MOE; src = (const float*)ldptr(PT, 20 + j); sms = (size_t)D * DFF;
        if (j < 2) { cvt8_item(t, lane, src, ws + WS_MW13, sms, (size_t)2 * DFF * D, D, DFF, 128, 256, j * 128, D / 128, (D / 128) * (DFF / 32), it); return; }
        cvt8_item(t, lane, src, ws + WS_MW2, sms, (size_t)D * DFF, DFF, D, 1 << 30, 0, 0, DFF / 128, (DFF / 128) * (D / 32), it); return; }
    cvt_item(t, lane, src, dst, sms, dms, K, N, nb, rs, off, K / 64, (K / 64) * (NP / 64), it);
}
__device__ __forceinline__ void q_help(const int wv, LAS unsigned char* lds, volatile LAS unsigned long long* PT, int phase, int LIMIT) {
    int tid = my_tid(wv);
    const int lane = tid & 63, wave = __builtin_amdgcn_readfirstlane(tid >> 6);
    LAS float* t = (LAS float*)lds + wave * CVT_TILE_F;
    volatile LAS unsigned* MISC = (volatile LAS unsigned*)(lds + LDS_MISC);
    unsigned* ctl = (unsigned*)((unsigned char*)ldptr(PT, 25) + WS_CTL);
    const unsigned G = gridDim.x;
    __syncthreads();
    if (LIMIT < 0 && tid == 0) (void)__hip_atomic_fetch_add(ctl + CW_DONE + 64 * phase, 1u, __ATOMIC_RELAXED, __HIP_MEMORY_SCOPE_AGENT);
    for (;;) {
        if (tid == 0) { unsigned base = 0xffffffffu;
            const bool pull = LIMIT < 0 ? __hip_atomic_load(ctl + CW_DONE + 64 * phase, __ATOMIC_RELAXED, __HIP_MEMORY_SCOPE_AGENT) < G
                                        : __hip_atomic_load(ctl + CW_Q, __ATOMIC_RELAXED, __HIP_MEMORY_SCOPE_AGENT) < (unsigned)LIMIT;
            if (pull) base = __hip_atomic_fetch_add(ctl + CW_Q, 8u, __ATOMIC_RELAXED, __HIP_MEMORY_SCOPE_AGENT);
            MISC[4] = base; }
        __syncthreads();
        const unsigned base = MISC[4];
        __syncthreads();
        if (base == 0xffffffffu) break;
        { const unsigned item = base + wave; if (item < (unsigned)Q_ALL) q_item(t, lane, (int)item, PT); }
        if (base >= (unsigned)Q_ALL) break;
    }
}
__device__ __forceinline__ void p_ada(const int wv, LAS unsigned char* lds, const float* c, const float* c_ctx, const float* w_ada, const float* b_ada, float* modv) {
    int tid = my_tid(wv);
    LAS float* scv = (LAS float*)lds; LAS float* red = scv + 3 * D;
    for (int i = tid; i < 3 * D; i += 512) { const int r = i / D, k = i % D; const float v = r < 2 ? c[r * D + k] : c_ctx[k]; scv[i] = v / (1.f + expf(-v)); }
    __syncthreads();
    for (int cb = blockIdx.x; cb < 2 * MODW / 96; cb += gridDim.x) {
        const int colg = cb * 96, l = colg / MODW, n0 = colg % MODW;
        if (tid < 504) { const int kg = tid / 24, c4 = tid % 24;
            f32x4 a0 = (f32x4){0.f, 0.f, 0.f, 0.f}, a1 = a0, a2 = a0;
            const float* w = w_ada + (size_t)l * D * MODW + n0 + c4 * 4;
#pragma unroll 7
            for (int k = kg; k < D; k += 21) { const f32x4 wv = __builtin_nontemporal_load((const f32x4*)(w + (size_t)k * MODW)); a0 += wv * scv[k]; a1 += wv * scv[D + k]; a2 += wv * scv[2 * D + k]; }
            *(LAS f32x4*)(red + kg * 288 + c4 * 4) = a0; *(LAS f32x4*)(red + kg * 288 + 96 + c4 * 4) = a1; *(LAS f32x4*)(red + kg * 288 + 192 + c4 * 4) = a2; }
        __syncthreads();
        if (tid < 288) { const int r = tid / 96, cl = tid % 96; float sacc = 0.f;
#pragma unroll
            for (int kg = 0; kg < 21; ++kg) sacc += red[kg * 288 + tid];
            modv[((size_t)l * 3 + r) * MODW + n0 + cl] = sacc + b_ada[l * MODW + n0 + cl]; }
        __syncthreads();
    }
}
template <bool OUT8> __device__ __forceinline__ void p_ln(const int wv, const float* src_lat, const float* src_ctx, int ctx_row0, const float* gn, const float* sh, const float* sc, bf16_t* XN, int nrows) {
    int tz = my_tid(wv);
    const int lane = tz & 63, gw = blockIdx.x * 8 + (tz >> 6), NGW = gridDim.x * 8;
    for (int row = gw; row < nrows; row += NGW) {
        const float* x = row < ML ? src_lat + (size_t)row * D : src_ctx + (size_t)(row - ctx_row0) * D;
        const int mi = mod_index(row);
        f32x4 v[8]; float s = 0.f;
#pragma unroll
        for (int j = 0; j < 8; ++j) { v[j] = *(const f32x4*)(x + 4 * lane + 256 * j); s += (v[j].x * v[j].x + v[j].y * v[j].y) + (v[j].z * v[j].z + v[j].w * v[j].w); }
        const float rstd = 1.0f / sqrtf(wave_sum(s) * (1.f / D) + EPS);
#pragma unroll
        for (int j = 0; j < 8; ++j) { const int cc = 4 * lane + 256 * j;
            const f32x4 g = *(const f32x4*)(gn + cc), a = *(const f32x4*)(sc + (size_t)mi * MODW + cc), b = *(const f32x4*)(sh + (size_t)mi * MODW + cc);
            const f32x4 h = v[j] * rstd * g * (a + 1.0f) + b;
            if constexpr (OUT8) { int x = 0; x = __builtin_amdgcn_cvt_pk_fp8_f32(h.x, h.y, x, false); x = __builtin_amdgcn_cvt_pk_fp8_f32(h.z, h.w, x, true); *(unsigned*)((unsigned char*)XN + (size_t)row * D + cc) = (unsigned)x; }
            else { u32x2 w; w.x = cvt_pk_bf16(h.x, h.y); w.y = cvt_pk_bf16(h.z, h.w); *(u32x2*)(XN + (size_t)row * D + cc) = w; } }
    }
}
__device__ __forceinline__ void p_gla_g2(const int wv, const bf16_t* DSF, const float* DEC, bf16_t* BTF) {
    int tz = my_tid(wv);
    for (int gi = blockIdx.x * 512 + tz; gi < 16 * 16 * 4 * 128; gi += gridDim.x * 512) {
        const int sl = gi & 127, kd = (gi >> 7) & 3, jb = (gi >> 9) & 15, chain = gi >> 13, dir = chain & 1, bh = chain >> 1;
        const int d = kd * 32 + (sl >> 5) * 8 + (sl & 1) * 4;
        f32x4 S = (f32x4){0.f, 0.f, 0.f, 0.f};
        for (int s0 = 0; s0 < NCH; s0 += 17) {
            f32x4 dec[17]; u32x2 q[17];
#pragma unroll
            for (int i = 0; i < 17; ++i) { const int step = s0 + i, c = dir == 0 ? step : (step < 4 ? 3 - step : 71 - step), un = bh * NCH + c;
                dec[i] = *(const f32x4*)(DEC + ((size_t)un * 2 + dir) * 128 + d);
                q[i] = __builtin_nontemporal_load((const u32x2*)(DSF + ((((size_t)un * 2 + dir) * 16 + jb) * 4 + kd) * 512 + sl * 4)); }
#pragma unroll
            for (int i = 0; i < 17; ++i) { const int step = s0 + i, c = dir == 0 ? step : (step < 4 ? 3 - step : 71 - step), un = bh * NCH + c;
                u32x2 w; w.x = cvt_pk_bf16(S.x, S.y); w.y = cvt_pk_bf16(S.z, S.w);
                *(u32x2*)(BTF + (((size_t)un * 16 + jb) * 10 + dir * 4 + kd) * 512 + sl * 4) = w;
                S = dec[i] * S + (f32x4){bflo(q[i].x), bfhi(q[i].x), bflo(q[i].y), bfhi(q[i].y)}; }
        }
    }
}
template <int W> __device__ __forceinline__ void pool_item(const bf16_t* U, bf16_t* MIX, int row, int ch) {
    int L, j, base;
    if (row < ML) { L = 64; j = row & 63; base = row - j; } else { L = CTXL; j = (row - ML) & (CTXL - 1); base = row - j; }
    const bf16_t* up = U + (size_t)base * INWP + C_P + ch;
    u32x4 q[W];
#pragma unroll
    for (int p = 0; p < W; ++p) { const int r = j - W / 2 + p; const bool ok = r >= 0 && r < L; q[p] = ok ? *(const u32x4*)(up + (size_t)r * INWP) : (u32x4){0u, 0u, 0u, 0u}; }
    float s[8];
#pragma unroll
    for (int i = 0; i < 8; ++i) s[i] = 0.f;
#pragma unroll
    for (int p = 0; p < W; ++p) { s[0] += bflo(q[p].x); s[1] += bfhi(q[p].x); s[2] += bflo(q[p].y); s[3] += bfhi(q[p].y); s[4] += bflo(q[p].z); s[5] += bfhi(q[p].z); s[6] += bflo(q[p].w); s[7] += bfhi(q[p].w); }
    int lo = j - W / 2, hi = lo + W; lo = lo < 0 ? 0 : lo; hi = hi > L ? L : hi;
    const u32x4 me = q[W / 2];
    const float inv = 1.f / (float)(hi - lo);
    u32x4 o; o.x = cvt_pk_bf16(s[0] * inv - bflo(me.x), s[1] * inv - bfhi(me.x)); o.y = cvt_pk_bf16(s[2] * inv - bflo(me.y), s[3] * inv - bfhi(me.y));
    o.z = cvt_pk_bf16(s[4] * inv - bflo(me.z), s[5] * inv - bfhi(me.z)); o.w = cvt_pk_bf16(s[6] * inv - bflo(me.w), s[7] * inv - bfhi(me.w));
    *(u32x4*)(MIX + (size_t)row * 1024 + ch) = o;
}
__device__ __forceinline__ void p_pool(const int wv, const bf16_t* U, bf16_t* MIX, int nrows) {
    int tz = my_tid(wv);
    const int per = nrows * 32;
    for (int gi = blockIdx.x * 512 + tz; gi < per; gi += gridDim.x * 512) { const int row = gi >> 5, cb = (gi & 31) * 8;
        pool_item<2>(U, MIX, row, cb); pool_item<4>(U, MIX, row, 256 + cb); pool_item<8>(U, MIX, row, 512 + cb); pool_item<16>(U, MIX, row, 768 + cb); }
}
__device__ __forceinline__ void p_router(const int wv, const float* XR, const float* gn, const float* sh, const float* sc, const float* w_r, const float* b_r, unsigned* cnt, int* list, float* gep, int* slot, unsigned char* XN8) {
    int tz = my_tid(wv);
    const int lane = tz & 63, gw = blockIdx.x * 8 + (tz >> 6), NGW = gridDim.x * 8;
    for (int row = gw; row < ML; row += NGW) {
        const float* x = XR + (size_t)row * D; const int mi = mod_index(row);
        float s = 0.f;
#pragma unroll
        for (int j = 0; j < 8; ++j) { const f32x4 v = *(const f32x4*)(x + 4 * lane + 256 * j); s += (v.x * v.x + v.y * v.y) + (v.z * v.z + v.w * v.w); }
        const float rstd = 1.0f / sqrtf(wave_sum(s) * (1.f / D) + EPS);
        float lg0 = 0.f, lg1 = 0.f, lg2 = 0.f, lg3 = 0.f, lg4 = 0.f, lg5 = 0.f, lg6 = 0.f, lg7 = 0.f;
#pragma unroll 1
        for (int j = 0; j < 8; ++j) { const int cc = 4 * lane + 256 * j;
            const f32x4 v = *(const f32x4*)(x + cc), g = *(const f32x4*)(gn + cc), a = *(const f32x4*)(sc + (size_t)mi * MODW + cc), b = *(const f32x4*)(sh + (size_t)mi * MODW + cc);
            const f32x4 h = v * rstd * g * (a + 1.0f) + b;
            { int x8 = 0; x8 = __builtin_amdgcn_cvt_pk_fp8_f32(h.x, h.y, x8, false); x8 = __builtin_amdgcn_cvt_pk_fp8_f32(h.z, h.w, x8, true); *(unsigned*)(XN8 + (size_t)row * D + cc) = (unsigned)x8; }
            const float* wp = w_r + (size_t)cc * 8;
#pragma unroll
            for (int i = 0; i < 4; ++i) { const f32x4 w0 = *(const f32x4*)(wp + i * 8), w1 = *(const f32x4*)(wp + i * 8 + 4);
                lg0 += h[i] * w0.x; lg1 += h[i] * w0.y; lg2 += h[i] * w0.z; lg3 += h[i] * w0.w; lg4 += h[i] * w1.x; lg5 += h[i] * w1.y; lg6 += h[i] * w1.z; lg7 += h[i] * w1.w; } }
        float lg[8] = {lg0, lg1, lg2, lg3, lg4, lg5, lg6, lg7};
#pragma unroll
        for (int e = 0; e < 8; ++e) lg[e] = wave_sum(lg[e]) + b_r[e];
        int i0 = 0; float m0 = lg[0];
#pragma unroll
        for (int e = 1; e < 8; ++e) if (lg[e] > m0) { m0 = lg[e]; i0 = e; }
        int i1 = -1; float m1 = -3.0e38f;
#pragma unroll
        for (int e = 0; e < 8; ++e) if (e != i0 && lg[e] > m1) { m1 = lg[e]; i1 = e; }
        const float p1 = expf(m1 - m0), g0 = 1.f / (1.f + p1), g1 = p1 / (1.f + p1);
        if (lane == 0) {
            const unsigned q0 = atomicAdd(cnt + 64 * i0, 1u), q1 = atomicAdd(cnt + 64 * i1, 1u);
            list[(size_t)i0 * 8192 + q0] = row; list[(size_t)i1 * 8192 + q1] = row; gep[(size_t)i0 * 8192 + q0] = g0; gep[(size_t)i1 * 8192 + q1] = g1;
            slot[row * 2] = i0 * 8192 + (int)q0; slot[row * 2 + 1] = i1 * 8192 + (int)q1; }
    }
}
__device__ __forceinline__ void p_final(const int wv, const float* XR, const bf16_t* YD, const int* slot, const float* gep, const unsigned* cnt, const float* g2, const float* gn, float* out) {
    int tz = my_tid(wv);
    const int lane = tz & 63, gw = blockIdx.x * 8 + (tz >> 6), NGW = gridDim.x * 8;
    for (int row = gw; row < ML; row += NGW) {
        const float* x = XR + (size_t)row * D; const int mi = mod_index(row);
        const int s0 = slot[row * 2], s1 = slot[row * 2 + 1], e0 = s0 >> 13, e1 = s1 >> 13;
        const float ga = gep[s0], gb = gep[s1];
        int h0 = 0, h1 = 0;
#pragma unroll
        for (int e = 0; e < NE; ++e) { const int r = ((int)cnt[64 * e] + 255) >> 8; h0 += e < e0 ? r : 0; h1 += e < e1 ? r : 0; }
        const bf16_t* y0 = YD + ((size_t)h0 * 256 + (s0 & 8191)) * D; const bf16_t* y1 = YD + ((size_t)h1 * 256 + (s1 & 8191)) * D;
        f32x4 v[8]; float s = 0.f;
#pragma unroll
        for (int j = 0; j < 8; ++j) { const int cc = 4 * lane + 256 * j; const u32x2 a = *(const u32x2*)(y0 + cc), b = *(const u32x2*)(y1 + cc);
            const f32x4 ya = (f32x4){ga * bflo(a.x) + gb * bflo(b.x), ga * bfhi(a.x) + gb * bfhi(b.x), ga * bflo(a.y) + gb * bflo(b.y), ga * bfhi(a.y) + gb * bfhi(b.y)};
            v[j] = *(const f32x4*)(x + cc) + *(const f32x4*)(g2 + (size_t)mi * MODW + cc) * ya;
            s += (v[j].x * v[j].x + v[j].y * v[j].y) + (v[j].z * v[j].z + v[j].w * v[j].w); }
        const float rstd = 1.0f / sqrtf(wave_sum(s) * (1.f / D) + EPS);
#pragma unroll
        for (int j = 0; j < 8; ++j) { const int cc = 4 * lane + 256 * j; *(f32x4*)(out + (size_t)row * D + cc) = v[j] * rstd * *(const f32x4*)(gn + cc); }
    }
}

#define XB_TMO      128
#define XB_XCNT(j)  (256  + 64 * (j))
#define XB_XSUB(j)  (1280 + 64 * (j))
#define XB_XGEN(j)  (2304 + 64 * (j))
#define XB_TOP      3328
#define XB_TOPGEN   3392
#define XCD_BAR_WORDS 3456
#define XB_SPIN_CAP (1u << 18)

__device__ __forceinline__ unsigned xb_ld(unsigned* p)              { return __hip_atomic_load(p, __ATOMIC_RELAXED, __HIP_MEMORY_SCOPE_AGENT); }
__device__ __forceinline__ unsigned xb_add(unsigned* p, unsigned v) { return __hip_atomic_fetch_add(p, v, __ATOMIC_RELAXED, __HIP_MEMORY_SCOPE_AGENT); }
__device__ __forceinline__ unsigned xb_xcc_id() { return (unsigned)__builtin_amdgcn_s_getreg((3 << 11) | 20) & 0xFu; }
#define XB_SPIN(cond, bar) do { unsigned _sp = 0; while (cond) { __builtin_amdgcn_s_sleep(1); \
    if ((++_sp & 255u) == 0u) { if (xb_ld(&(bar)[XB_TMO])) break; if (_sp > XB_SPIN_CAP) { atomicAdd(&(bar)[XB_TMO], 1u); break; } } } } while (0)

struct XcdBarrier {
    unsigned* bar; unsigned x;
    volatile LAS unsigned* st;
};

__device__ __forceinline__ XcdBarrier xcd_barrier_post(unsigned* bar, volatile LAS unsigned* st) {
    XcdBarrier b; b.bar = bar; b.x = xb_xcc_id(); b.st = st;
    if (threadIdx.x == 0) (void)xb_add(&bar[XB_XCNT(b.x)], 1u);
    return b;
}
__device__ __forceinline__ void xcd_barrier_complete(unsigned* bar, unsigned x, unsigned& nloc, unsigned& nx) {
    const unsigned G = gridDim.x * gridDim.y * gridDim.z;
    unsigned sum, cnt, mine, sp = 0u;
    for (;;) {
        sum = 0u; cnt = 0u; mine = 0u;
#pragma unroll
        for (unsigned j = 0; j < 16; ++j) { const unsigned c = xb_ld(&bar[XB_XCNT(j)]); sum += c; cnt += (c > 0u) ? 1u : 0u; mine = (j == x) ? c : mine; }
        if (sum == G) break;
        __builtin_amdgcn_s_sleep(1);
        if ((++sp & 255u) == 0u) { if (xb_ld(&bar[XB_TMO])) break; if (sp > XB_SPIN_CAP) { atomicAdd(&bar[XB_TMO], 1u); break; } }
    }
    nloc = mine > 0u ? mine : 1u; nx = cnt > 0u ? cnt : 1u;
}

__device__ __forceinline__ void xcd_barrier(const XcdBarrier& b, const int wv) {
    asm volatile("s_waitcnt vmcnt(0)" ::: "memory");
    __syncthreads();
    if (my_tid(wv) == 0) {
        unsigned* bar = b.bar;
        __builtin_amdgcn_s_waitcnt(0);
        unsigned nloc = b.st[0], nx = b.st[1];
        if (nloc == 0u) { xcd_barrier_complete(bar, b.x, nloc, nx); b.st[0] = nloc; b.st[1] = nx; }
        const unsigned old = xb_add(&bar[XB_XSUB(b.x)], 1u);
        const unsigned gen = old / nloc;
        if (old + 1u == (gen + 1u) * nloc) {
            __builtin_amdgcn_fence(__ATOMIC_RELEASE, "agent");
            asm volatile("s_waitcnt vmcnt(0)" ::: "memory");
            const unsigned og = xb_add(&bar[XB_TOP], 1u);
            const unsigned tg = og / nx;
            if (og + 1u == (tg + 1u) * nx) xb_add(&bar[XB_TOPGEN], 1u);
            else XB_SPIN(xb_ld(&bar[XB_TOPGEN]) == tg, bar);
            __builtin_amdgcn_fence(__ATOMIC_ACQUIRE, "agent");
            xb_add(&bar[XB_XGEN(b.x)], 1u);
            asm volatile("s_waitcnt vmcnt(0)" ::: "memory");
        } else {
            XB_SPIN(xb_ld(&bar[XB_XGEN(b.x)]) == gen, bar);
            __builtin_amdgcn_fence(__ATOMIC_ACQUIRE, "agent");
            asm volatile("s_waitcnt vmcnt(0)" ::: "memory");
        }
    }
    __syncthreads();
}

constexpr int CW_BAR = 4096;
constexpr int LDS_BYTES = LDS_MISC + 64 + 256;
static_assert(MOE_LDS <= LDS_MISC && G1_LDS <= LDS_MISC, "LDS map");
#ifndef MK_PER_PHASE
#define MK_PER_PHASE 0
#endif
constexpr int NPHASE = 20;

#define RUN(p) (lo <= (p) && (p) < hi)
#define SEAM(p) do { if (RUN(p) && RUN((p) + 1)) xcd_barrier(bar, wv); } while (0)
#define PTR(i) ((const float*)ldptr(PT, (i)))
#define WSP ((unsigned char*)ldptr(PT, 25))
#define HELP(ph) q_help(wv, lds, PT, (ph), -1)
#define DRAINQ(n) q_help(wv, lds, PT, 0, (n))
template <int l> __device__ __forceinline__ void layer_phases(const int wv, LAS unsigned char* lds, volatile LAS unsigned long long* PT, const int lo, const int hi, const XcdBarrier& bar, const int G, const int blk) {
        const int pb = 1 + 9 * l;
        const int ctx_row0 = l == 0 ? ML : 0;
        const int nMo = (l == 0) ? MA / 256 : ML / 256;
        if (RUN(pb + 0)) { unsigned char* ws = WSP; const float* modv_l = (const float*)(ws + WS_MODV) + (size_t)l * 3 * MODW; const float* XRc = (const float*)(ws + WS_XR);
            p_ln<false>(wv, l == 0 ? PTR(0) : XRc, l == 0 ? PTR(2) : XRc, ctx_row0, PTR(6) + l * D, modv_l + 0, modv_l + D, (bf16_t*)(ws + WS_XN), MA);
            if constexpr (l == 1) DRAINQ(Q_WIN1); }
        SEAM(pb + 0);
        if (RUN(pb + 1)) { unsigned char* ws = WSP;
            pg8::TileOrder S; S.A = (const char*)(ws + WS_XN); S.Bt = (const char*)((bf16_t*)(ws + WS_WIN) + (size_t)l * INWP * D); S.a_mstep = (size_t)256 * D * 2; S.a_nstep = 0; S.b_nstep = (size_t)256 * D * 2;
            S.nM = MA / 256; S.nN = INWP / 256; S.nwg = S.nM * S.nN; S.G = G; S.c = blk;
            pg8::Gemm g; g.K = D; g.lda = D; g.ldb = D; g.pad = 0;
            EpiIn E; E.U = (bf16_t*)(ws + WS_U); E.R = (float*)(ws + WS_R);
            pg8::gemm_phase<EpiIn, pg8::TileOrder, true>(wv, lds, g, S, E);
            HELP(pb + 1);
        }
        SEAM(pb + 1);
        if (RUN(pb + 2)) { unsigned char* ws = WSP; const float* wgp = PTR(9) + (size_t)l * 2 * 16 * 512; const float* bgp = PTR(10) + (size_t)l * 2 * 512;
            for (int un = blk; un < NUN; un += G) gla_g1_unit(wv, lds, un, (const bf16_t*)(ws + WS_U), (const float*)(ws + WS_R), wgp, bgp, (bf16_t*)(ws + WS_QA), (bf16_t*)(ws + WS_BT), (bf16_t*)(ws + WS_DS), (float*)(ws + WS_DEC));
            p_pool(wv, (const bf16_t*)(ws + WS_U), (bf16_t*)(ws + WS_MIX), MA);
        }
        SEAM(pb + 2);
        if (RUN(pb + 3)) { unsigned char* ws = WSP;
            { pg8::TileOrder S; S.A = (const char*)(ws + WS_MIX); S.Bt = (const char*)((bf16_t*)(ws + WS_WPOOL) + (size_t)l * 4 * 256 * 256); S.a_mstep = (size_t)256 * 1024 * 2; S.a_nstep = (size_t)256 * 2; S.b_nstep = (size_t)256 * 256 * 2;
              S.nM = MA / 256; S.nN = 4; S.nwg = S.nM * S.nN; S.G = G; S.c = blk;
              pg8::Gemm g; g.K = 256; g.lda = 1024; g.ldb = 256; g.pad = 0;
              EpiPool E; E.Y = (bf16_t*)(ws + WS_Y); E.scale = PTR(13) + l * 1024;
              pg8::gemm_phase<EpiPool, pg8::TileOrder, true>(wv, lds, g, S, E); }
            p_gla_g2(wv, (const bf16_t*)(ws + WS_DS), (const float*)(ws + WS_DEC), (bf16_t*)(ws + WS_BT));
        }
        SEAM(pb + 3);
        if (RUN(pb + 4)) { unsigned char* ws = WSP; const float* gain = PTR(11) + l * 1024;
            for (int un = blk; un < NUN; un += G) { if (l == 1 && (un % NCH) < 4) continue; gla_g3_unit(wv, lds, un, (const bf16_t*)(ws + WS_QA), (const bf16_t*)(ws + WS_BT), (const bf16_t*)(ws + WS_U), gain, (bf16_t*)(ws + WS_Y)); }
            DRAINQ(l == 0 ? Q_WOUT0 : Q_WOUT1);
        }
        SEAM(pb + 4);
        if (RUN(pb + 5)) { unsigned char* ws = WSP; const float* modv_l = (const float*)(ws + WS_MODV) + (size_t)l * 3 * MODW; float* XR = (float*)(ws + WS_XR);
            pg8::TileOrder S; S.A = (const char*)(ws + WS_Y); S.Bt = (const char*)((bf16_t*)(ws + WS_WOUT) + (size_t)l * D * D); S.a_mstep = (size_t)256 * D * 2; S.a_nstep = 0; S.b_nstep = (size_t)256 * D * 2;
            S.nM = nMo; S.nN = D / 256; S.nwg = S.nM * S.nN; S.G = G; S.c = blk;
            pg8::Gemm g; g.K = D; g.lda = D; g.ldb = D; g.pad = 0;
            EpiResid E; E.src_lat = l == 0 ? PTR(0) : XR; E.src_ctx = l == 0 ? PTR(2) : XR; E.XR = XR; E.gate = modv_l + 2 * D; E.rowgate = nullptr; E.rg_stride = 0; E.ctx_row0 = ctx_row0;
            pg8::gemm_phase<EpiResid, pg8::TileOrder, true>(wv, lds, g, S, E);
            if constexpr (l == 0) HELP(pb + 5);
        }
        SEAM(pb + 5);
        if (RUN(pb + 6)) { unsigned char* ws = WSP; const float* modv_l = (const float*)(ws + WS_MODV) + (size_t)l * 3 * MODW; const float* XR = (const float*)(ws + WS_XR);
            if constexpr (l == 0) p_ln<false>(wv, XR, XR, 0, PTR(7) + l * D, modv_l + 3 * D, modv_l + 4 * D, (bf16_t*)(ws + WS_XN), nMo * 256);
            if constexpr (l == 0) DRAINQ(Q_F3); else DRAINQ(Q_ALL);
            if constexpr (l == 1) p_router(wv, XR, PTR(7) + l * D, modv_l + 3 * D, modv_l + 4 * D, PTR(18), PTR(19), (unsigned*)(ws + WS_CTL) + CW_CNT, (int*)(ws + WS_LIST), (float*)(ws + WS_GEP), (int*)(ws + WS_SLOT), ws + WS_XN);
        }
        SEAM(pb + 6);
        if (RUN(pb + 7)) { unsigned char* ws = WSP;
            if constexpr (l == 0) {
                pg8::TileOrder S; S.A = (const char*)(ws + WS_XN); S.Bt = (const char*)(ws + WS_W13); S.a_mstep = (size_t)256 * D * 2; S.a_nstep = 0; S.b_nstep = (size_t)256 * D * 2;
                S.nM = MA / 256; S.nN = 2 * DFF / 256; S.nwg = S.nM * S.nN; S.G = G; S.c = blk;
                pg8::Gemm g; g.K = D; g.lda = D; g.ldb = D; g.pad = 0;
                EpiSwiglu E; E.H = (bf16_t*)(ws + WS_HH); E.ldh = DFF; E.pad = 0;
                pg8::gemm_phase<EpiSwiglu, pg8::TileOrder, true>(wv, lds, g, S, E);
                HELP(pb + 7); DRAINQ(Q_F2);
            } else {
                LAS int* tab = (LAS int*)(lds + MOE_TAB); LAS int* rows = (LAS int*)(lds + MOE_ROWS);
                moe_tab_init(wv, tab, (const unsigned*)(ws + WS_CTL) + CW_CNT, 2 * DFF / 256);
                MoeOrder<true> S; S.A = (const char*)(ws + WS_XN); S.Bt = (const char*)(ws + WS_MW13); S.a_mstep = 0; S.b_estep = (size_t)2 * DFF * D; S.b_nstep = (size_t)256 * D; S.tab = tab; S.rows = rows; S.nN = 2 * DFF / 256; S.G = G; S.c = blk;
                { pg8::Unit u; const int* LIST = (const int*)(ws + WS_LIST);
                  for (int ui = 0; S.next(ui, u); ++ui) { const int n = tab[48 + u.e];
                      for (int r = my_tid(wv); r < 256; r += 512) { const int p = u.pml * 256 + r; rows[ui * 256 + r] = LIST[(size_t)u.e * 8192 + (p < n ? p : 0)]; } }
                  __syncthreads(); }
                pg8::Gemm g; g.K = D / 2; g.lda = D / 2; g.ldb = D / 2; g.pad = 0;
                EpiSwiglu8 E; E.H = ws + WS_HH; E.ldh = DFF; E.pad = 0;
                pg8::gemm_phase<EpiSwiglu8, MoeOrder<true>, true, true>(wv, lds, g, S, E);
            }
        }
        SEAM(pb + 7);
        if (RUN(pb + 8)) { unsigned char* ws = WSP;
            if constexpr (l == 0) { const float* modv_l = (const float*)(ws + WS_MODV); float* XR = (float*)(ws + WS_XR);
                pg8::TileOrder S; S.A = (const char*)(ws + WS_HH); S.Bt = (const char*)(ws + WS_W2); S.a_mstep = (size_t)256 * DFF * 2; S.a_nstep = 0; S.b_nstep = (size_t)256 * DFF * 2;
                S.nM = MA / 256; S.nN = D / 256; S.nwg = S.nM * S.nN; S.G = G; S.c = blk;
                pg8::Gemm g; g.K = DFF; g.lda = DFF; g.ldb = DFF; g.pad = 0;
                EpiResid E; E.src_lat = XR; E.src_ctx = XR; E.XR = XR; E.gate = modv_l + 5 * D; E.rowgate = nullptr; E.rg_stride = 0; E.ctx_row0 = 0;
                pg8::gemm_phase<EpiResid, pg8::TileOrder, true>(wv, lds, g, S, E);
                HELP(pb + 8);
            } else {
                LAS int* tab = (LAS int*)(lds + MOE_TAB); LAS int* rows = (LAS int*)(lds + MOE_ROWS);
                moe_tab_init(wv, tab, (const unsigned*)(ws + WS_CTL) + CW_CNT, D / 256);
                MoeOrder<false> S; S.A = (const char*)(ws + WS_HH); S.Bt = (const char*)(ws + WS_MW2); S.a_mstep = (size_t)256 * DFF; S.b_estep = (size_t)D * DFF; S.b_nstep = (size_t)256 * DFF; S.tab = tab; S.rows = rows; S.nN = D / 256; S.G = G; S.c = blk;
                pg8::Gemm g; g.K = DFF / 2; g.lda = DFF / 2; g.ldb = DFF / 2; g.pad = 0;
                EpiMoeDown E; E.YD = (bf16_t*)(ws + WS_YD);
                pg8::gemm_phase<EpiMoeDown, MoeOrder<false>, true, true>(wv, lds, g, S, E);
            }
        }
        SEAM(pb + 8);
}

struct Args { const float* in[24]; float* out; unsigned char* ws; int ph_lo, ph_hi; };
__global__ void __launch_bounds__(512, 2) mk_fwd(Args args) {
    extern __shared__ __attribute__((aligned(16))) unsigned char lds_raw[];
    LAS unsigned char* lds = (LAS unsigned char*)lds_raw;
    volatile LAS unsigned* MISC = (volatile LAS unsigned*)(lds + LDS_MISC);
    const int wv = __builtin_amdgcn_readfirstlane((int)threadIdx.x >> 6);
    if (threadIdx.x < 16) MISC[threadIdx.x] = 0u;
    __syncthreads();
    volatile LAS unsigned long long* PT = (volatile LAS unsigned long long*)(lds + LDS_MISC + 64);
    if (threadIdx.x < 24) PT[threadIdx.x] = (unsigned long long)args.in[threadIdx.x];
    if (threadIdx.x == 24) PT[24] = (unsigned long long)args.out;
    if (threadIdx.x == 25) PT[25] = (unsigned long long)args.ws;
    __syncthreads();
    const int lo = args.ph_lo, hi = args.ph_hi;
    XcdBarrier bar; bar.bar = (unsigned*)(args.ws + WS_CTL) + CW_BAR; bar.x = 0; bar.st = MISC;
    if (hi - lo > 1) bar = xcd_barrier_post((unsigned*)(args.ws + WS_CTL) + CW_BAR, MISC);
    const int G = gridDim.x, blk = blockIdx.x;

    if (RUN(0)) {
        unsigned char* ws = WSP;
        p_ada(wv, lds, PTR(1), PTR(3), PTR(4), PTR(5), (float*)(ws + WS_MODV));
        p_convert(wv, lds, PTR(8), (bf16_t*)(ws + WS_WIN), (size_t)D * INW, (size_t)INWP * D, D, INW, INWP, 1 << 30, 0, 0, 1);
        p_convert(wv, lds, PTR(12), (bf16_t*)(ws + WS_WPOOL), (size_t)256 * 256, (size_t)256 * 256, 256, 256, 256, 1 << 30, 0, 0, 8);
    }
    SEAM(0);
    layer_phases<0>(wv, lds, PT, lo, hi, bar, G, blk);
    layer_phases<1>(wv, lds, PT, lo, hi, bar, G, blk);
    if (RUN(19)) { unsigned char* ws = WSP;
        p_final(wv, (const float*)(ws + WS_XR), (const bf16_t*)(ws + WS_YD), (const int*)(ws + WS_SLOT), (const float*)(ws + WS_GEP), (const unsigned*)(ws + WS_CTL) + CW_CNT, (const float*)(ws + WS_MODV) + 3 * MODW + 5 * D, PTR(23), (float*)ldptr(PT, 24)); }
#undef RUN
#undef SEAM
#undef PTR
#undef WSP
}

extern "C" void kernel_launch(void* const* d_in, const int* in_sizes, int n_in, void* d_out, int out_size, void* d_ws, size_t ws_size, hipStream_t stream) {
    if (n_in != 24 || ws_size < WS_END || out_size != ML * D) { fprintf(stderr, "kernel_launch: unexpected sizes (n_in %d, ws %zu, out %d)\n", n_in, ws_size, out_size); return; }
    static int grid = 0;
    if (grid == 0) {
        int dev = 0, cus = 0, per_cu = 0;
        if (hipGetDevice(&dev) != hipSuccess || hipDeviceGetAttribute(&cus, hipDeviceAttributeMultiprocessorCount, dev) != hipSuccess) { grid = -1; return; }
        if (hipFuncSetAttribute((const void*)mk_fwd, hipFuncAttributeMaxDynamicSharedMemorySize, LDS_BYTES) != hipSuccess) { fprintf(stderr, "kernel_launch: hipFuncSetAttribute failed\n"); grid = -1; return; }
        if (hipOccupancyMaxActiveBlocksPerMultiprocessor(&per_cu, (const void*)mk_fwd, 512, LDS_BYTES) != hipSuccess || per_cu < 1) fprintf(stderr, "kernel_launch: occupancy query reports %d\n", per_cu);
        (void)hipGetLastError();
        grid = cus;
    }
    if (grid < 0) return;
    (void)hipMemsetAsync((char*)d_ws + WS_CTL, 0, 1 * MiB, stream);
    Args a; memset(&a, 0, sizeof a);
    for (int i = 0; i < 24; ++i) a.in[i] = (const float*)d_in[i];
    a.out = (float*)d_out; a.ws = (unsigned char*)d_ws;
#if MK_PER_PHASE
    for (int p = 0; p < NPHASE; ++p) { a.ph_lo = p; a.ph_hi = p + 1; hipLaunchKernelGGL(mk_fwd, dim3(grid), dim3(512), LDS_BYTES, stream, a); }
#else
    a.ph_lo = 0; a.ph_hi = NPHASE; hipLaunchKernelGGL(mk_fwd, dim3(grid), dim3(512), LDS_BYTES, stream, a);
#endif
#ifdef MK_PROBE_MASK
    for (int p = 0; p < NPHASE; ++p) if ((MK_PROBE_MASK >> p) & 1) { a.ph_lo = p; a.ph_hi = p + 1; hipLaunchKernelGGL(mk_fwd, dim3(grid), dim3(512), LDS_BYTES, stream, a); }
#endif
}
```

```cpp
#include <hip/hip_runtime.h>
#include <cstdio>
#include <cstdint>
#include <cstring>

#define LAS __attribute__((address_space(3)))
typedef unsigned short bf16_t;
typedef short bf16x8 __attribute__((ext_vector_type(8)));
typedef float f32x4 __attribute__((ext_vector_type(4)));
typedef float f32x2 __attribute__((ext_vector_type(2)));
typedef unsigned u32x4 __attribute__((ext_vector_type(4)));
typedef unsigned u32x2 __attribute__((ext_vector_type(2)));

constexpr int D = 2048, NBATCH = 2, SEQ = 4096, CTXL = 256;
constexpr int ML = NBATCH * SEQ;
constexpr int MC = NBATCH * CTXL;
constexpr int MA = ML + MC;
constexpr int INW = 4128, INWP = 4352;
constexpr int DFF = 5632, NE = 8;
constexpr int GH = 4, DK = 128, DV = 256;
constexpr int C_Q = 0, C_K = 512, C_V = 1024, C_G = 2048, C_P = 3072, C_R = 4096;
constexpr float EPS = 1e-6f;
constexpr int MODW = 6 * D;

constexpr size_t MiB = 1u << 20;
constexpr size_t WS_CTL = 0;
constexpr size_t WS_MODV = 1 * MiB;
constexpr size_t WS_LIST = 2 * MiB;
constexpr size_t WS_GEP = WS_LIST + 256 * 1024;
constexpr size_t WS_SLOT = WS_GEP + 256 * 1024;
constexpr size_t WS_R = 3 * MiB;
constexpr size_t WS_WPOOL = 5 * MiB;
constexpr size_t WS_WIN = 6 * MiB;
constexpr size_t WS_WOUT = 40 * MiB;
constexpr size_t WS_W13 = 56 * MiB;
constexpr size_t WS_W2 = 100 * MiB;
constexpr size_t WS_MW13 = 122 * MiB;
constexpr size_t WS_MW2 = 474 * MiB;
constexpr size_t WS_XR = 650 * MiB;
constexpr size_t WS_XN = 718 * MiB;
constexpr size_t WS_U = 752 * MiB;
constexpr size_t WS_Y = 825 * MiB;
constexpr size_t WS_MIX = 859 * MiB;
constexpr size_t WS_HH = 876 * MiB;
constexpr size_t WS_QA = 1074 * MiB;
constexpr size_t WS_BT = 1096 * MiB;
constexpr size_t WS_DS = 1182 * MiB;
constexpr size_t WS_DEC = 1318 * MiB;
constexpr size_t WS_YD = WS_QA;
constexpr size_t WS_END = 1320 * MiB;
constexpr int CW_CNT = 1024;
constexpr int LDS_MISC = 147456;
constexpr int MOE_TAB = 131072, MOE_ROWS = 131072 + 256, MOE_MAXU = 15, MOE_LDS = MOE_ROWS + MOE_MAXU * 1024;

__device__ __forceinline__ int my_tid(int wv) { int t = wv * 64 + (int)__builtin_amdgcn_mbcnt_hi(~0u, __builtin_amdgcn_mbcnt_lo(~0u, 0u)); asm volatile("" : "+v"(t)); return t; }
namespace pg8 {
constexpr int BM = 256, BK = 64, HALF = 128, HTB = HALF * BK * 2, STAGE_BYTES = 8 * HTB, NXCD = 8, WGM = 8;
__host__ __device__ __forceinline__ int lds_byte(int r, int c) { const int st = (r >> 4) * 2 + (c >> 5), rr = r & 15, cc = c & 31, ob = rr * 64 + cc * 2; return st * 1024 + (ob ^ (((ob >> 9) & 1) << 5)); }
__host__ __device__ __forceinline__ void stage_rc(int b, int& R, int& C) { const int st = b / 1024, sb = b % 1024, swz = sb ^ (((sb >> 9) & 1) << 5); R = (st >> 1) * 16 + swz / 64; C = (st & 1) * 32 + (swz % 64) / 2; }
__host__ __device__ __forceinline__ int perm32(int rho) { const int n = rho >> 4, i = rho & 15; return 8 * (i >> 2) + 4 * n + (i & 3); }

struct Unit { const char* a; const char* b; int pm, pn, e, pml; };
struct Gemm { int K, lda, ldb, pad; };

struct TileOrder {
    static constexpr bool GATHER = false;
    const char* A; const char* Bt; size_t a_mstep, a_nstep, b_nstep; int nM, nN, nwg, G, c;
    __device__ __forceinline__ bool next(int i, Unit& u) const {
        const long L = (long)i * G + c; if (L >= nwg) return false;
        int wgid = (int)L; { const int q = nwg / NXCD, r = nwg % NXCD, xcd = wgid % NXCD, off = wgid / NXCD; wgid = (xcd < r ? xcd * (q + 1) : r * (q + 1) + (xcd - r) * q) + off; }
        const int nig = WGM * nN, gid = wgid / nig, fm = gid * WGM, gsz = (nM - fm) < WGM ? (nM - fm) : WGM;
        u.pm = fm + ((wgid % nig) % gsz); u.pn = (wgid % nig) / gsz;
        u.a = A + (size_t)u.pm * a_mstep + (size_t)u.pn * a_nstep; u.b = Bt + (size_t)u.pn * b_nstep; u.e = 0; u.pml = u.pm; return true;
    }
    __device__ __forceinline__ void a_off(int, const Unit&, int tid, int lda, unsigned (&v)[4]) const {
#pragma unroll
        for (int i = 0; i < 2; ++i) { int R, C; stage_rc(tid * 16 + i * 8192, R, C); v[i] = (unsigned)(R * lda + C) * 2u; v[2 + i] = (unsigned)((R + HALF) * lda + C) * 2u; }
    }
};

typedef __bf16 bf16x2_hw __attribute__((ext_vector_type(2)));
__device__ __forceinline__ unsigned cvt_pk_bf16(float lo, float hi) { const f32x2 v = {lo, hi}; const bf16x2_hw b = __builtin_convertvector(v, bf16x2_hw); return __builtin_bit_cast(unsigned, b); }

__device__ __forceinline__ void glds16(unsigned voff, const char* sbase, unsigned lds_dst) {
    unsigned keep;
    asm volatile("s_nop 4\n\ts_mov_b32 %0, m0\n\ts_mov_b32 m0, %2\n\ts_nop 0\n\tglobal_load_lds_dwordx4 %1, %3\n\ts_mov_b32 m0, %0" : "=&s"(keep) : "v"(voff), "s"(lds_dst), "s"(sbase) : "memory");
}
__device__ __forceinline__ const char* ubase(const char* p) {
    const unsigned long long v = (unsigned long long)p;
    const unsigned lo = __builtin_amdgcn_readfirstlane((unsigned)v), hi = __builtin_amdgcn_readfirstlane((unsigned)(v >> 32));
    return (const char*)(((unsigned long long)hi << 32) | lo);
}
typedef int v4i_t __attribute__((ext_vector_type(4)));
typedef int v8i_t __attribute__((ext_vector_type(8)));
__device__ __forceinline__ v8i_t cat8(bf16x8 lo, bf16x8 hi) { const v4i_t a = __builtin_bit_cast(v4i_t, lo), b = __builtin_bit_cast(v4i_t, hi); return __builtin_shufflevector(a, b, 0, 1, 2, 3, 4, 5, 6, 7); }
template <class Epi, class Sched, bool ALIGN_EPI, bool FP8 = false>
__device__ __forceinline__ void gemm_phase(const int wv, LAS unsigned char* lds, const Gemm g, const Sched& S, const Epi& E) {
    int tid = my_tid(wv);
    const int wid = __builtin_amdgcn_readfirstlane(tid >> 6), lane = tid & 63, wr = wid >> 2, wc = wid & 3, fr = lane & 15, fq = lane >> 4;
    const int K = g.K, nt = K / BK;
    unsigned voffB[2];
#pragma unroll
    for (int i = 0; i < 2; ++i) { int R, C; stage_rc(tid * 16 + i * 8192, R, C); const int Rb = Epi::PERM ? ((R & ~31) + perm32(R & 31)) : R;
        voffB[i] = (unsigned)(Rb * g.ldb + C) * 2u; }
    const size_t kstep = (size_t)(BK * 2);
    const size_t hB = (size_t)HALF * g.ldb * 2, hA = (size_t)HALF * g.lda * 2;
    const unsigned ldsw = (unsigned)wid * 1024u;
    constexpr bool ASMDMA = FP8 && !Sched::GATHER;
    const unsigned ldsb = (unsigned)__builtin_amdgcn_readfirstlane((int)(unsigned)(unsigned long long)(lds + ldsw));
    const int scl8 = 0x7c7c7c7c;
    const int aoff = lds_byte(wr * 64 + fr, fq * 8), boff = lds_byte(wc * 32 + fr, fq * 8);
#define PG8_SA(b, h) (((b) * 2 + (h)) * HTB)
#define PG8_SB(b, h) ((4 + (b) * 2 + (h)) * HTB)
#define PG8_STAGE(bufoff, gbase, voff) do { if constexpr (ASMDMA) { const char* _gb = ubase((const char*)(gbase)); _Pragma("unroll") for (int _i = 0; _i < 2; ++_i) glds16((voff)[_i], _gb, ldsb + (unsigned)((bufoff) + _i * 8192)); } \
        else { _Pragma("unroll") for (int _i = 0; _i < 2; ++_i) __builtin_amdgcn_global_load_lds((const unsigned*)((const char*)(gbase) + (voff)[_i]), (LAS unsigned*)(lds + (bufoff) + ldsw + _i * 8192), 16, 0, 0); } } while (0)
#define PG8_STAGEA(bufoff, gbase, voff, hh) do { if constexpr (ASMDMA) { const char* _gb = ubase((const char*)(gbase) + (hh) * hA); _Pragma("unroll") for (int _i = 0; _i < 2; ++_i) glds16((voff)[_i], _gb, ldsb + (unsigned)((bufoff) + _i * 8192)); } \
        else { _Pragma("unroll") for (int _i = 0; _i < 2; ++_i) { \
        if constexpr (Sched::GATHER) __builtin_amdgcn_global_load_lds((const unsigned*)((const char*)(gbase) + (voff)[(hh) * 2 + _i]), (LAS unsigned*)(lds + (bufoff) + ldsw + _i * 8192), 16, 0, 0); \
        else __builtin_amdgcn_global_load_lds((const unsigned*)((const char*)(gbase) + (hh) * hA + (voff)[_i]), (LAS unsigned*)(lds + (bufoff) + ldsw + _i * 8192), 16, 0, 0); } } } while (0)
#define PG8_LDA(dst, b, h) do { _Pragma("unroll") for (int m = 0; m < 4; ++m) _Pragma("unroll") for (int k = 0; k < 2; ++k) dst[m][k] = *(const LAS bf16x8*)(lds + PG8_SA(b, h) + aoff + m * 2048 + k * 1024); } while (0)
#define PG8_LDB(dst, b, h) do { _Pragma("unroll") for (int n = 0; n < 2; ++n) _Pragma("unroll") for (int k = 0; k < 2; ++k) dst[n][k] = *(const LAS bf16x8*)(lds + PG8_SB(b, h) + boff + n * 2048 + k * 1024); } while (0)
#define PG8_MMA(ai, bj, At, Bt) do { __builtin_amdgcn_s_setprio(1); \
        if constexpr (FP8) { _Pragma("unroll") for (int m = 0; m < 4; ++m) _Pragma("unroll") for (int n = 0; n < 2; ++n) \
            acc[ai][bj][m][n] = __builtin_amdgcn_mfma_scale_f32_16x16x128_f8f6f4(cat8(Bt[n][0], Bt[n][1]), cat8(At[m][0], At[m][1]), acc[ai][bj][m][n], 0, 0, 0, scl8, 0, scl8); } \
        else { _Pragma("unroll") for (int m = 0; m < 4; ++m) _Pragma("unroll") for (int n = 0; n < 2; ++n) _Pragma("unroll") for (int k = 0; k < 2; ++k) \
            acc[ai][bj][m][n] = __builtin_amdgcn_mfma_f32_16x16x32_bf16(Bt[n][k], At[m][k], acc[ai][bj][m][n], 0, 0, 0); } \
        __builtin_amdgcn_s_setprio(0); } while (0)
#define PG8_WAIT_V(n) asm volatile("s_waitcnt vmcnt(" #n ")" ::: "memory")
#define PG8_WAIT_L(n) asm volatile("s_waitcnt lgkmcnt(" #n ")" ::: "memory")
#define PG8_BAR __builtin_amdgcn_s_barrier()
#define PG8_SCHED __builtin_amdgcn_sched_barrier(0)
    Unit cur, nxt; int ui = 0;
    if (!S.next(0, cur)) return;
    f32x4 acc[2][2][4][2];
#pragma unroll
    for (int a = 0; a < 2; ++a)
#pragma unroll
        for (int b = 0; b < 2; ++b)
#pragma unroll
            for (int m = 0; m < 4; ++m)
#pragma unroll
                for (int n = 0; n < 2; ++n) acc[a][b][m][n] = (f32x4){0.f, 0.f, 0.f, 0.f};
    bf16x8 At[4][2], B0[2][2], B1[2][2];
    const char* cA = cur.a; const char* cB = cur.b;
    unsigned vA[4];
    S.a_off(0, cur, tid, g.lda, vA);
    PG8_STAGE(PG8_SB(0, 0), cB, voffB); PG8_STAGE(PG8_SB(0, 1), cB + hB, voffB); PG8_STAGEA(PG8_SA(0, 0), cA, vA, 0); PG8_STAGEA(PG8_SA(0, 1), cA, vA, 1);
    if (wr == 1) PG8_BAR;
    PG8_WAIT_V(2); PG8_BAR;
    PG8_STAGE(PG8_SB(1, 0), cB + kstep, voffB); PG8_STAGEA(PG8_SA(1, 0), cA + kstep, vA, 0); PG8_STAGE(PG8_SB(1, 1), cB + hB + kstep, voffB);
    PG8_WAIT_V(6); PG8_BAR;
    for (;;) {
        const bool has_next = S.next(ui + 1, nxt);
        const char* nA = has_next ? nxt.a : cA; const char* nB = has_next ? nxt.b : cB;
        for (int t = 0; t < nt; t += 2) {
            const bool last = (t == nt - 2);
            const char* a1 = cA + (size_t)(t + 1) * kstep;
            const char* a2 = last ? nA : cA + (size_t)(t + 2) * kstep; const char* b2 = last ? nB : cB + (size_t)(t + 2) * kstep;
            const char* a3 = a2 + kstep; const char* b3 = b2 + kstep;
            PG8_LDB(B0, 0, 0); PG8_LDB(B1, 0, 1); PG8_SCHED; PG8_LDA(At, 0, 0); PG8_STAGEA(PG8_SA(1, 1), a1, vA, 1);
            if constexpr (Sched::GATHER) { if (last && has_next) S.a_off(ui + 1, nxt, my_tid(wv), g.lda, vA); }
            PG8_WAIT_V(8); PG8_WAIT_L(0); PG8_BAR; PG8_MMA(0, 0, At, B0); PG8_MMA(0, 1, At, B1); PG8_BAR; PG8_SCHED;
            PG8_LDA(At, 0, 1); PG8_STAGE(PG8_SB(0, 0), b2, voffB); PG8_STAGE(PG8_SB(0, 1), b2 + hB, voffB); PG8_STAGEA(PG8_SA(0, 0), a2, vA, 0);
            PG8_WAIT_V(8); PG8_WAIT_L(0); PG8_BAR; PG8_MMA(1, 0, At, B0); PG8_MMA(1, 1, At, B1); PG8_BAR; PG8_SCHED;
            PG8_LDB(B0, 1, 0); PG8_LDB(B1, 1, 1); PG8_SCHED; PG8_LDA(At, 1, 0); PG8_STAGEA(PG8_SA(0, 1), a2, vA, 1);
            PG8_WAIT_V(8); PG8_WAIT_L(0); PG8_BAR; PG8_MMA(0, 0, At, B0); PG8_MMA(0, 1, At, B1); PG8_BAR; PG8_SCHED;
            PG8_LDA(At, 1, 1); PG8_STAGE(PG8_SB(1, 0), b3, voffB); PG8_STAGE(PG8_SB(1, 1), b3 + hB, voffB); PG8_STAGEA(PG8_SA(1, 0), a3, vA, 0);
            PG8_WAIT_V(8); PG8_WAIT_L(0); PG8_BAR; PG8_MMA(1, 0, At, B0); PG8_MMA(1, 1, At, B1); PG8_BAR; PG8_SCHED;
        }
        if constexpr (ALIGN_EPI) { if (wr == 0) PG8_BAR; }
        { const int te = my_tid(wv), le = te & 63, we = __builtin_amdgcn_readfirstlane(te >> 6); E(acc, cur, we >> 2, we & 3, le & 15, le >> 4); }
        if (!has_next) break;
#pragma unroll
        for (int a = 0; a < 2; ++a)
#pragma unroll
            for (int b = 0; b < 2; ++b)
#pragma unroll
                for (int m = 0; m < 4; ++m)
#pragma unroll
                    for (int n = 0; n < 2; ++n) acc[a][b][m][n] = (f32x4){0.f, 0.f, 0.f, 0.f};
        cur = nxt; cA = nA; cB = nB; ++ui;
        if constexpr (ALIGN_EPI) { if (wr == 1) PG8_BAR; }
    }
    PG8_WAIT_V(0);
    if constexpr (!ALIGN_EPI) { if (wr == 0) PG8_BAR; }
    PG8_BAR;
#undef PG8_SA
#undef PG8_SB
#undef PG8_STAGE
#undef PG8_STAGEA
#undef PG8_LDA
#undef PG8_LDB
#undef PG8_MMA
#undef PG8_WAIT_V
#undef PG8_WAIT_L
#undef PG8_BAR
#undef PG8_SCHED
}
}
using pg8::cvt_pk_bf16;
typedef f32x4 Acc[2][2][4][2];

__device__ __forceinline__ float bf2f(bf16_t v) { return __uint_as_float(((unsigned)v) << 16); }
__device__ __forceinline__ float siluf(float a) { return a * __builtin_amdgcn_rcpf(1.f + __expf(-a)); }
__device__ __forceinline__ int mod_index(int row) { return row < SEQ ? 0 : (row < ML ? 1 : 2); }

struct EpiIn {
    static constexpr bool PERM = true;
    bf16_t* U; float* R;
    __device__ __forceinline__ void operator()(const Acc& acc, const pg8::Unit& u, int wr, int wc, int fr, int fq) const {
        const int row0 = u.pm * 256 + wr * 64 + fr, col0 = u.pn * 256 + wc * 32 + 8 * fq;
        const float sc = (u.pn < 2) ? 0.08838834764831845f : 1.f;
#pragma unroll
        for (int ai = 0; ai < 2; ++ai)
#pragma unroll
            for (int m = 0; m < 4; ++m) { const int row = row0 + ai * 128 + m * 16; bf16_t* rowp = U + (size_t)row * INWP + col0;
#pragma unroll
                for (int bj = 0; bj < 2; ++bj) { const f32x4 v0 = acc[ai][bj][m][0] * sc, v1 = acc[ai][bj][m][1] * sc;
                    u32x4 w; w.x = cvt_pk_bf16(v0[0], v0[1]); w.y = cvt_pk_bf16(v0[2], v0[3]); w.z = cvt_pk_bf16(v1[0], v1[1]); w.w = cvt_pk_bf16(v1[2], v1[3]);
                    *(u32x4*)(rowp + bj * 128) = w; }
                if (u.pn == 16 && wc == 0) { float* rp = R + (size_t)row * 32 + 8 * fq; *(f32x4*)rp = acc[ai][0][m][0]; *(f32x4*)(rp + 4) = acc[ai][0][m][1]; } }
    }
};
struct EpiPool {
    static constexpr bool PERM = true;
    bf16_t* Y; const float* scale;
    __device__ __forceinline__ void operator()(const Acc& acc, const pg8::Unit& u, int wr, int wc, int fr, int fq) const {
        const int row0 = u.pm * 256 + wr * 64 + fr, col0 = u.pn * 256 + wc * 32 + 8 * fq;
        f32x4 sv[2][2];
#pragma unroll
        for (int bj = 0; bj < 2; ++bj)
#pragma unroll
            for (int n = 0; n < 2; ++n) sv[bj][n] = *(const f32x4*)(scale + col0 + bj * 128 + 4 * n);
#pragma unroll
        for (int ai = 0; ai < 2; ++ai)
#pragma unroll
            for (int m = 0; m < 4; ++m) { bf16_t* rowp = Y + (size_t)(row0 + ai * 128 + m * 16) * D + 1024 + col0;
#pragma unroll
                for (int bj = 0; bj < 2; ++bj) { const f32x4 v0 = acc[ai][bj][m][0] * sv[bj][0], v1 = acc[ai][bj][m][1] * sv[bj][1];
                    u32x4 w; w.x = cvt_pk_bf16(v0[0], v0[1]); w.y = cvt_pk_bf16(v0[2], v0[3]); w.z = cvt_pk_bf16(v1[0], v1[1]); w.w = cvt_pk_bf16(v1[2], v1[3]);
                    *(u32x4*)(rowp + bj * 128) = w; } }
    }
};
struct EpiResid {
    static constexpr bool PERM = false;
    const float* src_lat; const float* src_ctx; float* XR; const float* gate; const float* rowgate; int rg_stride, ctx_row0;
    __device__ __forceinline__ void operator()(const Acc& acc, const pg8::Unit& u, int wr, int wc, int fr, int fq) const {
        const int row0 = u.pm * 256 + wr * 64 + fr, col0 = u.pn * 256 + wc * 32 + 4 * fq;
        const int mi = u.pm < 16 ? 0 : (u.pm < 32 ? 1 : 2);
        const float* src = u.pm < 32 ? src_lat : src_ctx - (size_t)ctx_row0 * D;
        f32x4 gv[2][2];
#pragma unroll
        for (int bj = 0; bj < 2; ++bj)
#pragma unroll
            for (int n = 0; n < 2; ++n) gv[bj][n] = *(const f32x4*)(gate + (size_t)mi * MODW + col0 + bj * 128 + n * 16);
#pragma unroll
        for (int ai = 0; ai < 2; ++ai)
#pragma unroll
            for (int mp = 0; mp < 2; ++mp) { f32x4 bs[2][2][2];
#pragma unroll
                for (int mm = 0; mm < 2; ++mm) { const size_t off = (size_t)(row0 + ai * 128 + (2 * mp + mm) * 16) * D + col0;
#pragma unroll
                    for (int bj = 0; bj < 2; ++bj)
#pragma unroll
                        for (int n = 0; n < 2; ++n) bs[mm][bj][n] = *(const f32x4*)(src + off + bj * 128 + n * 16); }
#pragma unroll
                for (int mm = 0; mm < 2; ++mm) { const size_t off = (size_t)(row0 + ai * 128 + (2 * mp + mm) * 16) * D + col0;
#pragma unroll
                    for (int bj = 0; bj < 2; ++bj)
#pragma unroll
                        for (int n = 0; n < 2; ++n) *(f32x4*)(XR + off + bj * 128 + n * 16) = bs[mm][bj][n] + gv[bj][n] * acc[ai][bj][2 * mp + mm][n]; } }
    }
};
struct EpiSwiglu {
    static constexpr bool PERM = true;
    bf16_t* H; int ldh, pad;
    __device__ __forceinline__ void operator()(const Acc& acc, const pg8::Unit& u, int wr, int wc, int fr, int fq) const {
        const int row0 = u.pm * 256 + wr * 64 + fr, col0 = u.pn * 128 + wc * 32 + 8 * fq;
#pragma unroll
        for (int ai = 0; ai < 2; ++ai)
#pragma unroll
            for (int m = 0; m < 4; ++m) { bf16_t* rowp = H + (size_t)(row0 + ai * 128 + m * 16) * ldh + col0;
                float h[8];
#pragma unroll
                for (int n = 0; n < 2; ++n)
#pragma unroll
                    for (int j = 0; j < 4; ++j) h[n * 4 + j] = siluf(acc[ai][0][m][n][j]) * acc[ai][1][m][n][j];
                u32x4 w; w.x = cvt_pk_bf16(h[0], h[1]); w.y = cvt_pk_bf16(h[2], h[3]); w.z = cvt_pk_bf16(h[4], h[5]); w.w = cvt_pk_bf16(h[6], h[7]);
                *(u32x4*)rowp = w; }
    }
};

struct EpiSwiglu8 {
    static constexpr bool PERM = true;
    unsigned char* H; int ldh, pad;
    __device__ __forceinline__ void operator()(const Acc& acc, const pg8::Unit& u, int wr, int wc, int fr, int fq) const {
        const int row0 = u.pm * 256 + wr * 64 + fr, col0 = u.pn * 128 + wc * 32 + 8 * fq;
#pragma unroll
        for (int ai = 0; ai < 2; ++ai)
#pragma unroll
            for (int m = 0; m < 4; ++m) { unsigned char* rowp = H + (size_t)(row0 + ai * 128 + m * 16) * ldh + col0;
                float h[8];
#pragma unroll
                for (int n = 0; n < 2; ++n)
#pragma unroll
                    for (int j = 0; j < 4; ++j) h[n * 4 + j] = siluf(acc[ai][0][m][n][j]) * acc[ai][1][m][n][j];
                int x0 = 0, x1 = 0;
                x0 = __builtin_amdgcn_cvt_pk_fp8_f32(h[0], h[1], x0, false); x0 = __builtin_amdgcn_cvt_pk_fp8_f32(h[2], h[3], x0, true);
                x1 = __builtin_amdgcn_cvt_pk_fp8_f32(h[4], h[5], x1, false); x1 = __builtin_amdgcn_cvt_pk_fp8_f32(h[6], h[7], x1, true);
                *(u32x2*)rowp = (u32x2){(unsigned)x0, (unsigned)x1}; }
    }
};
__device__ __forceinline__ void moe_tab_init(const int wv, LAS int* tab, const unsigned* cnt, int nN) {
    if (my_tid(wv) == 0) { int tb = 0, hr = 0;
        for (int e = 0; e < NE; ++e) { const int n = (int)cnt[64 * e], r = (n + 255) >> 8; tab[e] = tb; tab[16 + e] = hr; tab[32 + e] = r; tab[48 + e] = n; tb += r * nN; hr += r; }
        tab[8] = tb; tab[24] = hr; }
    __syncthreads();
}
template <bool GATHER_> struct MoeOrder {
    static constexpr bool GATHER = GATHER_; static constexpr int gather = GATHER_ ? 1 : 0;
    const char* A; const char* Bt; size_t a_mstep, b_estep, b_nstep; const LAS int* tab; const LAS int* rows; int nN, G, c;
    __device__ __forceinline__ bool next(int i, pg8::Unit& u) const {
        const int nwg = __builtin_amdgcn_readfirstlane(tab[8]); const long L = (long)i * G + c; if (L >= nwg || i >= MOE_MAXU) return false;
        int wgid = (int)L; { const int q = nwg / 8, r = nwg % 8, xcd = wgid % 8, off = wgid / 8; wgid = (xcd < r ? xcd * (q + 1) : r * (q + 1) + (xcd - r) * q) + off; }
        int e = 0;
#pragma unroll
        for (int k = 1; k < NE; ++k) e += (wgid >= tab[k]) ? 1 : 0;
        e = __builtin_amdgcn_readfirstlane(e);
        const int loc = wgid - __builtin_amdgcn_readfirstlane(tab[e]), nM = __builtin_amdgcn_readfirstlane(tab[32 + e]);
        const int nig = 8 * nN, gid = loc / nig, fm = gid * 8, gsz = (nM - fm) < 8 ? (nM - fm) : 8;
        u.pml = fm + ((loc % nig) % gsz); u.pn = (loc % nig) / gsz; u.e = e; u.pm = __builtin_amdgcn_readfirstlane(tab[16 + e]) + u.pml;
        u.a = gather ? A : A + (size_t)u.pm * a_mstep; u.b = Bt + (size_t)e * b_estep + (size_t)u.pn * b_nstep; return true;
    }
    __device__ __forceinline__ void a_off(int ui, const pg8::Unit&, int tid, int lda, unsigned (&v)[4]) const {
#pragma unroll
        for (int i = 0; i < 2; ++i) { int R, C; pg8::stage_rc(tid * 16 + i * 8192, R, C);
#pragma unroll
            for (int hh = 0; hh < 2; ++hh) { const int row = gather ? rows[ui * 256 + hh * 128 + R] : (R + hh * 128); v[hh * 2 + i] = (unsigned)(row * lda + C) * 2u; } }
    }
};
struct EpiMoeDown {
    static constexpr bool PERM = true;
    bf16_t* YD;
    __device__ __forceinline__ void operator()(const Acc& acc, const pg8::Unit& u, int wr, int wc, int fr, int fq) const {
        const int row0 = u.pm * 256 + wr * 64 + fr, col0 = u.pn * 256 + wc * 32 + 8 * fq;
#pragma unroll
        for (int ai = 0; ai < 2; ++ai)
#pragma unroll
            for (int m = 0; m < 4; ++m) { bf16_t* rowp = YD + (size_t)(row0 + ai * 128 + m * 16) * D + col0;
#pragma unroll
                for (int bj = 0; bj < 2; ++bj) { const f32x4 v0 = acc[ai][bj][m][0], v1 = acc[ai][bj][m][1];
                    u32x4 w; w.x = cvt_pk_bf16(v0[0], v0[1]); w.y = cvt_pk_bf16(v0[2], v0[3]); w.z = cvt_pk_bf16(v1[0], v1[1]); w.w = cvt_pk_bf16(v1[2], v1[3]);
                    *(u32x4*)(rowp + bj * 128) = w; } }
    }
};
__device__ __forceinline__ float wave_sum(float v) {
#pragma unroll
    for (int o = 1; o < 64; o <<= 1) v += __shfl_xor(v, o);
    return v;
}
__device__ __forceinline__ unsigned f2bf(float f) { unsigned u = __float_as_uint(f); return (u + 0x7fffu + ((u >> 16) & 1u)) >> 16; }
constexpr int NCH = 68, NUN = 8 * NCH, KQ = 320;
constexpr int G1_CUM = 0, G1_QP = 33792, G1_KI = 51200, G1_KT = 68608, G1_VT = 87040, G1_WG = 123904, G1_BG = 140288, G1_AS = G1_QP  , G1_LDS = 141312;
__device__ __forceinline__ int gla_row0(int b, int c) { return c < 4 ? ML + b * CTXL + c * 64 : b * SEQ + (c - 4) * 64; }
__device__ __forceinline__ float bflo(unsigned w) { return __uint_as_float(w << 16); }
__device__ __forceinline__ float bfhi(unsigned w) { return __uint_as_float(w & 0xffff0000u); }
__device__ __forceinline__ float wave_scan_incl(float x, int lane) {
    x += __builtin_bit_cast(float, __builtin_amdgcn_update_dpp(0, __builtin_bit_cast(int, x), 0x111, 0xf, 0xf, false));
    x += __builtin_bit_cast(float, __builtin_amdgcn_update_dpp(0, __builtin_bit_cast(int, x), 0x112, 0xf, 0xf, false));
    x += __builtin_bit_cast(float, __builtin_amdgcn_update_dpp(0, __builtin_bit_cast(int, x), 0x114, 0xf, 0xf, false));
    x += __builtin_bit_cast(float, __builtin_amdgcn_update_dpp(0, __builtin_bit_cast(int, x), 0x118, 0xf, 0xf, false));
    const float t0 = __builtin_bit_cast(float, __builtin_amdgcn_readlane(__builtin_bit_cast(int, x), 15)), t1 = __builtin_bit_cast(float, __builtin_amdgcn_readlane(__builtin_bit_cast(int, x), 31)),
                t2 = __builtin_bit_cast(float, __builtin_amdgcn_readlane(__builtin_bit_cast(int, x), 47));
    return x + (lane >= 16 ? t0 : 0.f) + (lane >= 32 ? t1 : 0.f) + (lane >= 48 ? t2 : 0.f);
}
__device__ __forceinline__ float log_sigmoid_fast(float x) { return fminf(x, 0.f) - __logf(1.f + __expf(-fabsf(x))); }

__device__ __forceinline__ void gla_g1_unit(const int wv, LAS unsigned char* lds, int un, const bf16_t* U, const float* R, const float* wg, const float* bg, bf16_t* QAF, bf16_t* BTF, bf16_t* DSF, float* DEC) {
    int tid = my_tid(wv);
    const int lane = tid & 63, wid = __builtin_amdgcn_readfirstlane(tid >> 6), fr = lane & 15, fq = lane >> 4;
    const int bh = un / NCH, c = un % NCH, b = bh >> 2, h = bh & 3;
    const int row0 = gla_row0(b, c);
    LAS float* CUM = (LAS float*)(lds + G1_CUM);
    LAS bf16_t* QP = (LAS bf16_t*)(lds + G1_QP); LAS bf16_t* KI = (LAS bf16_t*)(lds + G1_KI); LAS bf16_t* KT = (LAS bf16_t*)(lds + G1_KT);
    LAS bf16_t* VT = (LAS bf16_t*)(lds + G1_VT); LAS bf16_t* AS = (LAS bf16_t*)(lds + G1_AS);
    LAS float* WG = (LAS float*)(lds + G1_WG); LAS float* BG = (LAS float*)(lds + G1_BG);
    u32x4 qv[2], kv[2];
#pragma unroll
    for (int i = 0; i < 2; ++i) { const int dg = (tid + 512 * i) >> 6;
        qv[i] = *(const u32x4*)(U + (size_t)(row0 + lane) * INWP + C_Q + h * DK + dg * 8); kv[i] = *(const u32x4*)(U + (size_t)(row0 + lane) * INWP + C_K + h * DK + dg * 8); }
    f32x4 rq[2][4];
#pragma unroll
    for (int dr = 0; dr < 2; ++dr) { const float* rp = R + (size_t)(row0 + (dr == 0 ? lane : 63 - lane)) * 32 + dr * 16;
#pragma unroll
        for (int x = 0; x < 4; ++x) rq[dr][x] = *(const f32x4*)(rp + 4 * x); }
    { const int e0 = tid * 8, rw = e0 >> 7, d0 = e0 & 127;
      const f32x4 w0 = *(const f32x4*)(wg + (size_t)rw * 512 + h * DK + d0), w1 = *(const f32x4*)(wg + (size_t)rw * 512 + h * DK + d0 + 4);
      *(LAS f32x4*)(WG + e0) = w0; *(LAS f32x4*)(WG + e0 + 4) = w1;
      if (tid < 64) { const int b0 = tid * 4; *(LAS f32x4*)(BG + b0) = *(const f32x4*)(bg + (size_t)(b0 >> 7) * 512 + h * DK + (b0 & 127)); } }
#pragma unroll
    for (int i = 0; i < 4; ++i) { const int idx = tid + 512 * i, jg = idx >> 6, s = idx & 63;
        const u32x4 q = *(const u32x4*)(U + (size_t)(row0 + s) * INWP + C_V + h * DV + jg * 8);
        LAS bf16_t* vp = VT + (jg * 8) * 72 + s;
        vp[0] = (bf16_t)(q.x & 0xffffu); vp[72] = (bf16_t)(q.x >> 16); vp[144] = (bf16_t)(q.y & 0xffffu); vp[216] = (bf16_t)(q.y >> 16);
        vp[288] = (bf16_t)(q.z & 0xffffu); vp[360] = (bf16_t)(q.z >> 16); vp[432] = (bf16_t)(q.w & 0xffffu); vp[504] = (bf16_t)(q.w >> 16); }
    f32x4 Aacc[2]; Aacc[0] = (f32x4){0.f, 0.f, 0.f, 0.f}; Aacc[1] = (f32x4){0.f, 0.f, 0.f, 0.f};
    __syncthreads();
    for (int dir = 0; dir < 2; ++dir) {
        { const int t = dir == 0 ? lane : 63 - lane;
          const float rr[16] = {rq[dir][0].x, rq[dir][0].y, rq[dir][0].z, rq[dir][0].w, rq[dir][1].x, rq[dir][1].y, rq[dir][1].z, rq[dir][1].w, rq[dir][2].x, rq[dir][2].y, rq[dir][2].z, rq[dir][2].w, rq[dir][3].x, rq[dir][3].y, rq[dir][3].z, rq[dir][3].w};
          for (int dd = 0; dd < 16; dd += 4) { const int d = wid * 16 + dd;
              const f32x4 b4 = *(const LAS f32x4*)(BG + dir * 128 + d);
              float pre[4] = {b4.x, b4.y, b4.z, b4.w};
#pragma unroll
              for (int k = 0; k < 16; ++k) { const f32x4 w4 = *(const LAS f32x4*)(WG + (dir * 16 + k) * 128 + d); pre[0] += rr[k] * w4.x; pre[1] += rr[k] * w4.y; pre[2] += rr[k] * w4.z; pre[3] += rr[k] * w4.w; }
#pragma unroll
              for (int q = 0; q < 4; ++q) CUM[t * 132 + d + q] = wave_scan_incl(log_sigmoid_fast(pre[q]) * (1.f / 16.f), lane); } }
        __syncthreads();
        if (dir == 0) {
#pragma unroll
            for (int i = 0; i < 4; ++i) { const int idx = tid + 512 * i, j = idx >> 3, sg = idx & 7;
                *(u32x4*)(BTF + ((((size_t)un * 16 + (j >> 4)) * 10 + 8 + (sg >> 2)) * 64 + (sg & 3) * 16 + (j & 15)) * 8) = *(const LAS u32x4*)(VT + j * 72 + sg * 8); } }
        const int tl = dir == 0 ? 63 : 0;
#pragma unroll
        for (int i = 0; i < 2; ++i) { const int dg = (tid + 512 * i) >> 6, s = lane;
            const f32x4 c0 = *(const LAS f32x4*)(CUM + s * 132 + dg * 8), c1 = *(const LAS f32x4*)(CUM + s * 132 + dg * 8 + 4);
            const f32x4 l0 = *(const LAS f32x4*)(CUM + tl * 132 + dg * 8), l1 = *(const LAS f32x4*)(CUM + tl * 132 + dg * 8 + 4);
            const float qf[8] = {bflo(qv[i].x), bfhi(qv[i].x), bflo(qv[i].y), bfhi(qv[i].y), bflo(qv[i].z), bfhi(qv[i].z), bflo(qv[i].w), bfhi(qv[i].w)};
            const float kf[8] = {bflo(kv[i].x), bfhi(kv[i].x), bflo(kv[i].y), bfhi(kv[i].y), bflo(kv[i].z), bfhi(kv[i].z), bflo(kv[i].w), bfhi(kv[i].w)};
            const float cc[8] = {c0.x, c0.y, c0.z, c0.w, c1.x, c1.y, c1.z, c1.w}, cl[8] = {l0.x, l0.y, l0.z, l0.w, l1.x, l1.y, l1.z, l1.w};
            float qp[8], ki[8], ke[8];
#pragma unroll
            for (int e = 0; e < 8; ++e) { qp[e] = qf[e] * __expf(cc[e]); ki[e] = kf[e] * __expf(fminf(-cc[e], 80.f)); ke[e] = kf[e] * __expf(cl[e] - cc[e]); }
            u32x4 w; w.x = cvt_pk_bf16(qp[0], qp[1]); w.y = cvt_pk_bf16(qp[2], qp[3]); w.z = cvt_pk_bf16(qp[4], qp[5]); w.w = cvt_pk_bf16(qp[6], qp[7]);
            *(LAS u32x4*)(QP + s * 136 + dg * 8) = w;
            *(u32x4*)(QAF + ((((size_t)un * 4 + (s >> 4)) * 10 + dir * 4 + (dg >> 2)) * 64 + (dg & 3) * 16 + (s & 15)) * 8) = w;
            u32x4 w2; w2.x = cvt_pk_bf16(ki[0], ki[1]); w2.y = cvt_pk_bf16(ki[2], ki[3]); w2.z = cvt_pk_bf16(ki[4], ki[5]); w2.w = cvt_pk_bf16(ki[6], ki[7]);
            *(LAS u32x4*)(KI + s * 136 + dg * 8) = w2;
#pragma unroll
            for (int e = 0; e < 8; ++e) KT[(dg * 8 + e) * 72 + s] = (bf16_t)f2bf(ke[e]);
            if (s == tl) { float* dp = DEC + ((size_t)un * 2 + dir) * 128 + dg * 8;
                *(f32x4*)dp = (f32x4){__expf(cl[0]), __expf(cl[1]), __expf(cl[2]), __expf(cl[3])}; *(f32x4*)(dp + 4) = (f32x4){__expf(cl[4]), __expf(cl[5]), __expf(cl[6]), __expf(cl[7])}; } }
        __syncthreads();
        { const int tb = wid >> 1;
#pragma unroll
          for (int x = 0; x < 2; ++x) { const int sb = (wid & 1) * 2 + x; f32x4 a = (f32x4){0.f, 0.f, 0.f, 0.f};
#pragma unroll
              for (int ks = 0; ks < 4; ++ks) { const bf16x8 Af = *(const LAS bf16x8*)(QP + (tb * 16 + fr) * 136 + ks * 32 + fq * 8), Bf = *(const LAS bf16x8*)(KI + (sb * 16 + fr) * 136 + ks * 32 + fq * 8);
                  a = __builtin_amdgcn_mfma_f32_16x16x32_bf16(Af, Bf, a, 0, 0, 0); }
#pragma unroll
              for (int jj = 0; jj < 4; ++jj) { const int t = tb * 16 + 4 * fq + jj, sx = sb * 16 + fr; const bool keep = dir == 0 ? (sx <= t) : (sx >= t); Aacc[x][jj] += keep ? a[jj] : 0.f; } } }
#pragma unroll
        for (int jbi = 0; jbi < 2; ++jbi) { const int jb = wid * 2 + jbi;
            const bf16x8 Bf0 = *(const LAS bf16x8*)(VT + (jb * 16 + fr) * 72 + fq * 8), Bf1 = *(const LAS bf16x8*)(VT + (jb * 16 + fr) * 72 + 32 + fq * 8);
#pragma unroll
            for (int db = 0; db < 8; ++db) { const bf16x8 Af0 = *(const LAS bf16x8*)(KT + (db * 16 + fr) * 72 + fq * 8), Af1 = *(const LAS bf16x8*)(KT + (db * 16 + fr) * 72 + 32 + fq * 8);
                f32x4 a = (f32x4){0.f, 0.f, 0.f, 0.f};
                a = __builtin_amdgcn_mfma_f32_16x16x32_bf16(Af0, Bf0, a, 0, 0, 0); a = __builtin_amdgcn_mfma_f32_16x16x32_bf16(Af1, Bf1, a, 0, 0, 0);
                u32x2 w; w.x = cvt_pk_bf16(a.x, a.y); w.y = cvt_pk_bf16(a.z, a.w);
                *(u32x2*)(DSF + (((((size_t)un * 2 + dir) * 16 + jb) * 4 + (db >> 1)) * 64 + ((db & 1) * 2 + (fq >> 1)) * 16 + fr) * 8 + (fq & 1) * 4) = w; } }
        __syncthreads();
    }
    { const int tb = wid >> 1;
#pragma unroll
      for (int x = 0; x < 2; ++x) { const int sb = (wid & 1) * 2 + x;
#pragma unroll
          for (int jj = 0; jj < 4; ++jj) AS[(tb * 16 + 4 * fq + jj) * 72 + sb * 16 + fr] = (bf16_t)f2bf(Aacc[x][jj]); } }
    __syncthreads();
    { const int t = tid >> 3, sg = tid & 7;
      *(u32x4*)(QAF + ((((size_t)un * 4 + (t >> 4)) * 10 + 8 + (sg >> 2)) * 64 + (sg & 3) * 16 + (t & 15)) * 8) = *(const LAS u32x4*)(AS + t * 72 + sg * 8); }
    __syncthreads();
}
__device__ __forceinline__ void gla_g3_unit(const int wv, LAS unsigned char* lds, int un, const bf16_t* QAF, const bf16_t* BTF, const bf16_t* U, const float* gain, bf16_t* Y) {
    int tid = my_tid(wv);
    const int lane = tid & 63, wid = __builtin_amdgcn_readfirstlane(tid >> 6), fr = lane & 15, fq = lane >> 4;
    const int bh = un / NCH, c = un % NCH, b = bh >> 2, h = bh & 3, row0 = gla_row0(b, c);
    const int tb = wid & 3, jh = wid >> 2;
    const bf16_t* qa = QAF + ((size_t)un * 4 + tb) * 10 * 512 + lane * 8;
    const bf16_t* bt = BTF + ((size_t)un * 16 + jh * 8) * 10 * 512 + lane * 8;
    f32x4 acc[8];
#pragma unroll
    for (int jb = 0; jb < 8; ++jb) acc[jb] = (f32x4){0.f, 0.f, 0.f, 0.f};
    bf16x8 Bc = *(const bf16x8*)qa, Ac[8];
#pragma unroll
    for (int jb = 0; jb < 8; ++jb) Ac[jb] = *(const bf16x8*)(bt + (size_t)jb * 10 * 512);
#pragma unroll
    for (int ks = 0; ks < 10; ++ks) {
        bf16x8 Bn = Bc, An[8];
#pragma unroll
        for (int jb = 0; jb < 8; ++jb) An[jb] = Ac[jb];
        if (ks < 9) { Bn = *(const bf16x8*)(qa + (ks + 1) * 512);
#pragma unroll
            for (int jb = 0; jb < 8; ++jb) An[jb] = *(const bf16x8*)(bt + ((size_t)jb * 10 + ks + 1) * 512); }
#pragma unroll
        for (int jb = 0; jb < 8; ++jb) acc[jb] = __builtin_amdgcn_mfma_f32_16x16x32_bf16(Ac[jb], Bc, acc[jb], 0, 0, 0);
        Bc = Bn;
#pragma unroll
        for (int jb = 0; jb < 8; ++jb) Ac[jb] = An[jb];
    }
    float ss = 0.f;
#pragma unroll
    for (int jb = 0; jb < 8; ++jb) ss += (acc[jb].x * acc[jb].x + acc[jb].y * acc[jb].y) + (acc[jb].z * acc[jb].z + acc[jb].w * acc[jb].w);
    ss += __shfl_xor(ss, 16); ss += __shfl_xor(ss, 32);
    LAS float* P = (LAS float*)lds;
    if (fq == 0) P[wid * 16 + fr] = ss;
    __syncthreads();
    const float tot = P[wid * 16 + fr] + P[(wid ^ 4) * 16 + fr];
    const float rstd = 1.0f / sqrtf(tot * (1.f / DV) + EPS);
    const int row = row0 + tb * 16 + fr;
#pragma unroll
    for (int jb = 0; jb < 8; ++jb) { const int col = h * DV + jh * 128 + jb * 16 + 4 * fq;
        const f32x4 gn = *(const f32x4*)(gain + col); const u32x2 gw = *(const u32x2*)(U + (size_t)row * INWP + C_G + col);
        const f32x4 o = acc[jb] * rstd * gn;
        u32x2 w; w.x = cvt_pk_bf16(o.x * siluf(bflo(gw.x)), o.y * siluf(bfhi(gw.x))); w.y = cvt_pk_bf16(o.z * siluf(bflo(gw.y)), o.w * siluf(bfhi(gw.y)));
        *(u32x2*)(Y + (size_t)row * D + col) = w; }
    __syncthreads();
}

__device__ __forceinline__ const void* ldptr(volatile LAS unsigned long long* tab, int i) {
    const unsigned long long v = tab[i];
    const unsigned lo = __builtin_amdgcn_readfirstlane((unsigned)v), hi = __builtin_amdgcn_readfirstlane((unsigned)(v >> 32));
    return (const void*)(((unsigned long long)hi << 32) | lo);
}
constexpr int CVT_TILE_F = 128 * 33;
__device__ __forceinline__ void cvt_item(LAS float* t, int lane, const float* srcb, bf16_t* dstb, size_t sms, size_t dms, int K, int N, int nb, int rs, int off, int ktiles, int per, int it) {
    const int lr = lane >> 4, lc = (lane & 15) * 4;
    const int sr = lane >> 3, sk = (lane & 7) * 8;
    const int mat = it / per, r = it % per, nt = r / ktiles, kt = r % ktiles, k0 = kt * 64, n0 = nt * 64;
    const float* src = srcb + (size_t)mat * sms + (size_t)(k0 + lr) * N + n0 + lc;
    const bool inb = (n0 + lc) < N;
    f32x4 v[16];
#pragma unroll
    for (int i = 0; i < 16; ++i) v[i] = inb ? __builtin_nontemporal_load((const f32x4*)(src + (size_t)(4 * i) * N)) : (f32x4){0.f, 0.f, 0.f, 0.f};
#pragma unroll
    for (int i = 0; i < 16; ++i) { LAS float* tp = t + (lr + 4 * i) * 65 + lc; tp[0] = v[i].x; tp[1] = v[i].y; tp[2] = v[i].z; tp[3] = v[i].w; }
    asm volatile("s_waitcnt lgkmcnt(0)" ::: "memory");
    bf16_t* dst = dstb + (size_t)mat * dms;
#pragma unroll
    for (int p = 0; p < 8; ++p) { const int nn = sr + 8 * p, n = n0 + nn; const int drow = (n / nb) * rs + (n % nb) + off;
        const LAS float* tp = t + sk * 65 + nn;
        u32x4 w; w.x = cvt_pk_bf16(tp[0], tp[65]); w.y = cvt_pk_bf16(tp[2 * 65], tp[3 * 65]); w.z = cvt_pk_bf16(tp[4 * 65], tp[5 * 65]); w.w = cvt_pk_bf16(tp[6 * 65], tp[7 * 65]);
        __builtin_nontemporal_store(w, (u32x4*)(dst + (size_t)drow * K + k0 + sk)); }
    asm volatile("s_waitcnt lgkmcnt(0)" ::: "memory");
}
__device__ __forceinline__ void p_convert(const int wv, LAS unsigned char* lds, const float* srcb, bf16_t* dstb, size_t sms, size_t dms, int K, int N, int NP, int nb, int rs, int off, int nmat) {
    int tid = my_tid(wv);
    const int lane = tid & 63, wave = tid >> 6;
    LAS float* t = (LAS float*)lds + wave * CVT_TILE_F;
    const int ktiles = K / 64, ntiles = NP / 64, per = ktiles * ntiles, total = per * nmat;
    for (int it = blockIdx.x * 8 + wave; it < total; it += gridDim.x * 8) cvt_item(t, lane, srcb, dstb, sms, dms, K, N, nb, rs, off, ktiles, per, it);
}
__device__ __forceinline__ void cvt8_item(LAS float* t, int lane, const float* srcb, unsigned char* dstb, size_t sms, size_t dms, int K, int N, int nb, int rs, int off, int ktiles, int per, int it) {
    const int lr = lane >> 3, lc = (lane & 7) * 4;
    const int sr = lane >> 3, sk = (lane & 7) * 16;
    const int mat = it / per, r = it % per, nt = r / ktiles, kt = r % ktiles, k0 = kt * 128, n0 = nt * 32;
    const float* src = srcb + (size_t)mat * sms + (size_t)(k0 + lr) * N + n0 + lc;
    f32x4 v[16];
#pragma unroll
    for (int i = 0; i < 16; ++i) v[i] = __builtin_nontemporal_load((const f32x4*)(src + (size_t)(8 * i) * N));
#pragma unroll
    for (int i = 0; i < 16; ++i) { LAS float* tp = t + (lr + 8 * i) * 33 + lc; tp[0] = v[i].x * 64.f; tp[1] = v[i].y * 64.f; tp[2] = v[i].z * 64.f; tp[3] = v[i].w * 64.f; }
    asm volatile("s_waitcnt lgkmcnt(0)" ::: "memory");
    unsigned char* dst = dstb + (size_t)mat * dms;
#pragma unroll
    for (int p = 0; p < 4; ++p) { const int nn = sr + 8 * p, n = n0 + nn; const int drow = (n / nb) * rs + (n % nb) + off;
        const LAS float* tp = t + sk * 33 + nn;
        unsigned w[4];
#pragma unroll
        for (int q = 0; q < 4; ++q) { int x = 0; x = __builtin_amdgcn_cvt_pk_fp8_f32(tp[(4 * q) * 33], tp[(4 * q + 1) * 33], x, false); x = __builtin_amdgcn_cvt_pk_fp8_f32(tp[(4 * q + 2) * 33], tp[(4 * q + 3) * 33], x, true); w[q] = (unsigned)x; }
        __builtin_nontemporal_store((u32x4){w[0], w[1], w[2], w[3]}, (u32x4*)(dst + (size_t)drow * K + k0 + sk)); }
    asm volatile("s_waitcnt lgkmcnt(0)" ::: "memory");
}
constexpr int CW_Q = 2048, CW_DONE = 2112;
constexpr int QJ_WOUT = (D / 64) * (D / 64), QJ_F13 = (D / 64) * (DFF / 64), QJ_WIN = (D / 64) * (INWP / 64), QJ_MOE = NE * QJ_F13;
constexpr int Q_WOUT0 = QJ_WOUT, Q_F3 = Q_WOUT0 + 2 * QJ_F13, Q_F2 = Q_F3 + QJ_F13, Q_WIN1 = Q_F2 + QJ_WIN, Q_WOUT1 = Q_WIN1 + QJ_WOUT, Q_ALL = Q_WOUT1 + 3 * QJ_MOE;
__device__ __forceinline__ void q_item(LAS float* t, int lane, int item, volatile LAS unsigned long long* PT) {
    unsigned char* ws = (unsigned char*)ldptr(PT, 25);
    const float* src; bf16_t* dst; size_t sms = 0, dms = 0; int K = D, N = D, NP = D, nb = 1 << 30, rs = 0, off = 0, it = item;
    if (item < Q_WOUT0) { src = (const float*)ldptr(PT, 14); dst = (bf16_t*)(ws + WS_WOUT); }
    else if (item < Q_F3) { const int j = (item - Q_WOUT0) / QJ_F13; it = item - Q_WOUT0 - j * QJ_F13; src = (const float*)ldptr(PT, 15 + j); dst = (bf16_t*)(ws + WS_W13); N = DFF; NP = DFF; nb = 128; rs = 256; off = j * 128; }
    else if (item < Q_F2) { it = item - Q_F3; cvt8_item(t, lane, (const float*)ldptr(PT, 17), ws + WS_W2, 0, 0, DFF, D, 1 << 30, 0, 0, DFF / 128, (DFF / 128) * (D / 32), it); return; }
    else if (item < Q_WIN1) { it = item - Q_F2; src = (const float*)ldptr(PT, 8) + (size_t)D * INW; dst = (bf16_t*)(ws + WS_WIN) + (size_t)INWP * D; N = INW; NP = INWP; }
    else if (item < Q_WOUT1) { it = item - Q_WIN1; src = (const float*)ldptr(PT, 14) + (size_t)D * D; dst = (bf16_t*)(ws + WS_WOUT) + (size_t)D * D; }
    else { const int j = (item - Q_WOUT1) / QJ_MOE; it = item - Q_WOUT1 - j * QJ_MOE; src = (const float*)ldptr(PT, 20 + j); sms = (size_t)D * DFF;
        if (j < 2) { cvt8_item(t, lane, src, ws + WS_MW13, sms, (size_t)2 * DFF * D, D, DFF, 128, 256, j * 128, D / 128, (D / 128) * (DFF / 32), it); return; }
        cvt8_item(t, lane, src, ws + WS_MW2, sms, (size_t)D * DFF, DFF, D, 1 << 30, 0, 0, DFF / 128, (DFF / 128) * (D / 32), it); return; }
    cvt_item(t, lane, src, dst, sms, dms, K, N, nb, rs, off, K / 64, (K / 64) * (NP / 64), it);
}
__device__ __forceinline__ void q_help(const int wv, LAS unsigned char* lds, volatile LAS unsigned long long* PT, int phase, int LIMIT, int qoff = 0) {
    int tid = my_tid(wv);
    const int lane = tid & 63, wave = __builtin_amdgcn_readfirstlane(tid >> 6);
    LAS float* t = (LAS float*)lds + wave * CVT_TILE_F;
    volatile LAS unsigned* MISC = (volatile LAS unsigned*)(lds + LDS_MISC);
    unsigned* ctl = (unsigned*)((unsigned char*)ldptr(PT, 25) + WS_CTL);
    const unsigned G = gridDim.x;
    const unsigned per_wave = LIMIT < 0 ? 1u : 6u;
    __syncthreads();
    if (LIMIT < 0 && tid == 0) (void)__hip_atomic_fetch_add(ctl + CW_DONE + 64 * phase, 1u, __ATOMIC_RELAXED, __HIP_MEMORY_SCOPE_AGENT);
    for (;;) {
        if (tid == 0) { unsigned base = 0xffffffffu;
            const bool pull = LIMIT < 0 ? __hip_atomic_load(ctl + CW_DONE + 64 * phase, __ATOMIC_RELAXED, __HIP_MEMORY_SCOPE_AGENT) < G
                                        : __hip_atomic_load(ctl + CW_Q + qoff, __ATOMIC_RELAXED, __HIP_MEMORY_SCOPE_AGENT) < (unsigned)LIMIT;
            if (pull) base = __hip_atomic_fetch_add(ctl + CW_Q + qoff, 8u * per_wave, __ATOMIC_RELAXED, __HIP_MEMORY_SCOPE_AGENT);
            MISC[4] = base; }
        __syncthreads();
        const unsigned base = MISC[4];
        __syncthreads();
        if (base == 0xffffffffu) break;
#pragma unroll 1
        for (unsigned k = 0; k < per_wave; ++k) { const unsigned item = base + 8u * k + wave; if (item < (unsigned)Q_ALL) q_item(t, lane, (int)item, PT); }
        if (base >= (unsigned)Q_ALL) break;
    }
}
__device__ __forceinline__ void p_ada(const int wv, LAS unsigned char* lds, const float* c, const float* c_ctx, const float* w_ada, const float* b_ada, float* modv) {
    int tid = my_tid(wv);
    LAS float* scv = (LAS float*)lds; LAS float* red = scv + 3 * D;
    for (int i = tid; i < 3 * D; i += 512) { const int r = i / D, k = i % D; const float v = r < 2 ? c[r * D + k] : c_ctx[k]; scv[i] = v / (1.f + expf(-v)); }
    __syncthreads();
    for (int cb = blockIdx.x; cb < 2 * MODW / 96; cb += gridDim.x) {
        const int colg = cb * 96, l = colg / MODW, n0 = colg % MODW;
        if (tid < 504) { const int kg = tid / 24, c4 = tid % 24;
            f32x4 a0 = (f32x4){0.f, 0.f, 0.f, 0.f}, a1 = a0, a2 = a0;
            const float* w = w_ada + (size_t)l * D * MODW + n0 + c4 * 4;
#pragma unroll 7
            for (int k = kg; k < D; k += 21) { const f32x4 wv = __builtin_nontemporal_load((const f32x4*)(w + (size_t)k * MODW)); a0 += wv * scv[k]; a1 += wv * scv[D + k]; a2 += wv * scv[2 * D + k]; }
            *(LAS f32x4*)(red + kg * 288 + c4 * 4) = a0; *(LAS f32x4*)(red + kg * 288 + 96 + c4 * 4) = a1; *(LAS f32x4*)(red + kg * 288 + 192 + c4 * 4) = a2; }
        __syncthreads();
        if (tid < 288) { const int r = tid / 96, cl = tid % 96; float sacc = 0.f;
#pragma unroll
            for (int kg = 0; kg < 21; ++kg) sacc += red[kg * 288 + tid];
            modv[((size_t)l * 3 + r) * MODW + n0 + cl] = sacc + b_ada[l * MODW + n0 + cl]; }
        __syncthreads();
    }
}
template <bool OUT8> __device__ __forceinline__ void p_ln(const int wv, const float* src_lat, const float* src_ctx, int ctx_row0, const float* gn, const float* sh, const float* sc, bf16_t* XN, int nrows) {
    int tz = my_tid(wv);
    const int lane = tz & 63, gw = blockIdx.x * 8 + (tz >> 6), NGW = gridDim.x * 8;
    for (int row = gw; row < nrows; row += NGW) {
        const float* x = row < ML ? src_lat + (size_t)row * D : src_ctx + (size_t)(row - ctx_row0) * D;
        const int mi = mod_index(row);
        f32x4 v[8]; float s = 0.f;
#pragma unroll
        for (int j = 0; j < 8; ++j) { v[j] = *(const f32x4*)(x + 4 * lane + 256 * j); s += (v[j].x * v[j].x + v[j].y * v[j].y) + (v[j].z * v[j].z + v[j].w * v[j].w); }
        const float rstd = 1.0f / sqrtf(wave_sum(s) * (1.f / D) + EPS);
#pragma unroll
        for (int j = 0; j < 8; ++j) { const int cc = 4 * lane + 256 * j;
            const f32x4 g = *(const f32x4*)(gn + cc), a = *(const f32x4*)(sc + (size_t)mi * MODW + cc), b = *(const f32x4*)(sh + (size_t)mi * MODW + cc);
            const f32x4 h = v[j] * rstd * g * (a + 1.0f) + b;
            if constexpr (OUT8) { int x = 0; x = __builtin_amdgcn_cvt_pk_fp8_f32(h.x, h.y, x, false); x = __builtin_amdgcn_cvt_pk_fp8_f32(h.z, h.w, x, true); *(unsigned*)((unsigned char*)XN + (size_t)row * D + cc) = (unsigned)x; }
            else { u32x2 w; w.x = cvt_pk_bf16(h.x, h.y); w.y = cvt_pk_bf16(h.z, h.w); *(u32x2*)(XN + (size_t)row * D + cc) = w; } }
    }
}
__device__ __forceinline__ void p_gla_g2(const int wv, const bf16_t* DSF, const float* DEC, bf16_t* BTF) {
    int tz = my_tid(wv);
    for (int gi = blockIdx.x * 512 + tz; gi < 16 * 16 * 4 * 128; gi += gridDim.x * 512) {
        const int sl = gi & 127, kd = (gi >> 7) & 3, jb = (gi >> 9) & 15, chain = gi >> 13, dir = chain & 1, bh = chain >> 1;
        const int d = kd * 32 + (sl >> 5) * 8 + (sl & 1) * 4;
        f32x4 S = (f32x4){0.f, 0.f, 0.f, 0.f};
        for (int s0 = 0; s0 < NCH; s0 += 17) {
            f32x4 dec[17]; u32x2 q[17];
#pragma unroll
            for (int i = 0; i < 17; ++i) { const int step = s0 + i, c = dir == 0 ? step : (step < 4 ? 3 - step : 71 - step), un = bh * NCH + c;
                dec[i] = *(const f32x4*)(DEC + ((size_t)un * 2 + dir) * 128 + d);
                q[i] = __builtin_nontemporal_load((const u32x2*)(DSF + ((((size_t)un * 2 + dir) * 16 + jb) * 4 + kd) * 512 + sl * 4)); }
#pragma unroll
            for (int i = 0; i < 17; ++i) { const int step = s0 + i, c = dir == 0 ? step : (step < 4 ? 3 - step : 71 - step), un = bh * NCH + c;
                u32x2 w; w.x = cvt_pk_bf16(S.x, S.y); w.y = cvt_pk_bf16(S.z, S.w);
                *(u32x2*)(BTF + (((size_t)un * 16 + jb) * 10 + dir * 4 + kd) * 512 + sl * 4) = w;
                S = dec[i] * S + (f32x4){bflo(q[i].x), bfhi(q[i].x), bflo(q[i].y), bfhi(q[i].y)}; }
        }
    }
}
template <int W> __device__ __forceinline__ void pool_item(const bf16_t* U, bf16_t* MIX, int row, int ch) {
    int L, j, base;
    if (row < ML) { L = 64; j = row & 63; base = row - j; } else { L = CTXL; j = (row - ML) & (CTXL - 1); base = row - j; }
    const bf16_t* up = U + (size_t)base * INWP + C_P + ch;
    u32x4 q[W];
#pragma unroll
    for (int p = 0; p < W; ++p) { const int r = j - W / 2 + p; const bool ok = r >= 0 && r < L; q[p] = ok ? *(const u32x4*)(up + (size_t)r * INWP) : (u32x4){0u, 0u, 0u, 0u}; }
    float s[8];
#pragma unroll
    for (int i = 0; i < 8; ++i) s[i] = 0.f;
#pragma unroll
    for (int p = 0; p < W; ++p) { s[0] += bflo(q[p].x); s[1] += bfhi(q[p].x); s[2] += bflo(q[p].y); s[3] += bfhi(q[p].y); s[4] += bflo(q[p].z); s[5] += bfhi(q[p].z); s[6] += bflo(q[p].w); s[7] += bfhi(q[p].w); }
    int lo = j - W / 2, hi = lo + W; lo = lo < 0 ? 0 : lo; hi = hi > L ? L : hi;
    const u32x4 me = q[W / 2];
    const float inv = 1.f / (float)(hi - lo);
    u32x4 o; o.x = cvt_pk_bf16(s[0] * inv - bflo(me.x), s[1] * inv - bfhi(me.x)); o.y = cvt_pk_bf16(s[2] * inv - bflo(me.y), s[3] * inv - bfhi(me.y));
    o.z = cvt_pk_bf16(s[4] * inv - bflo(me.z), s[5] * inv - bfhi(me.z)); o.w = cvt_pk_bf16(s[6] * inv - bflo(me.w), s[7] * inv - bfhi(me.w));
    *(u32x4*)(MIX + (size_t)row * 1024 + ch) = o;
}
__device__ __forceinline__ void p_pool(const int wv, const bf16_t* U, bf16_t* MIX, int nrows) {
    int tz = my_tid(wv);
    const int per = nrows * 32;
    for (int gi = blockIdx.x * 512 + tz; gi < per; gi += gridDim.x * 512) { const int row = gi >> 5, cb = (gi & 31) * 8;
        pool_item<2>(U, MIX, row, cb); pool_item<4>(U, MIX, row, 256 + cb); pool_item<8>(U, MIX, row, 512 + cb); pool_item<16>(U, MIX, row, 768 + cb); }
}
__device__ __forceinline__ void p_router(const int wv, const float* XR, const float* gn, const float* sh, const float* sc, const float* w_r, const float* b_r, unsigned* cnt, int* list, float* gep, int* slot, unsigned char* XN8) {
    int tz = my_tid(wv);
    const int lane = tz & 63, gw = blockIdx.x * 8 + (tz >> 6), NGW = gridDim.x * 8;
    for (int row = gw; row < ML; row += NGW) {
        const float* x = XR + (size_t)row * D; const int mi = mod_index(row);
        float s = 0.f;
#pragma unroll
        for (int j = 0; j < 8; ++j) { const f32x4 v = *(const f32x4*)(x + 4 * lane + 256 * j); s += (v.x * v.x + v.y * v.y) + (v.z * v.z + v.w * v.w); }
        const float rstd = 1.0f / sqrtf(wave_sum(s) * (1.f / D) + EPS);
        float lg0 = 0.f, lg1 = 0.f, lg2 = 0.f, lg3 = 0.f, lg4 = 0.f, lg5 = 0.f, lg6 = 0.f, lg7 = 0.f;
#pragma unroll 1
        for (int j = 0; j < 8; ++j) { const int cc = 4 * lane + 256 * j;
            const f32x4 v = *(const f32x4*)(x + cc), g = *(const f32x4*)(gn + cc), a = *(const f32x4*)(sc + (size_t)mi * MODW + cc), b = *(const f32x4*)(sh + (size_t)mi * MODW + cc);
            const f32x4 h = v * rstd * g * (a + 1.0f) + b;
            { int x8 = 0; x8 = __builtin_amdgcn_cvt_pk_fp8_f32(h.x, h.y, x8, false); x8 = __builtin_amdgcn_cvt_pk_fp8_f32(h.z, h.w, x8, true); *(unsigned*)(XN8 + (size_t)row * D + cc) = (unsigned)x8; }
            const float* wp = w_r + (size_t)cc * 8;
#pragma unroll
            for (int i = 0; i < 4; ++i) { const f32x4 w0 = *(const f32x4*)(wp + i * 8), w1 = *(const f32x4*)(wp + i * 8 + 4);
                lg0 += h[i] * w0.x; lg1 += h[i] * w0.y; lg2 += h[i] * w0.z; lg3 += h[i] * w0.w; lg4 += h[i] * w1.x; lg5 += h[i] * w1.y; lg6 += h[i] * w1.z; lg7 += h[i] * w1.w; } }
        float lg[8] = {lg0, lg1, lg2, lg3, lg4, lg5, lg6, lg7};
#pragma unroll
        for (int e = 0; e < 8; ++e) lg[e] = wave_sum(lg[e]) + b_r[e];
        int i0 = 0; float m0 = lg[0];
#pragma unroll
        for (int e = 1; e < 8; ++e) if (lg[e] > m0) { m0 = lg[e]; i0 = e; }
        int i1 = -1; float m1 = -3.0e38f;
#pragma unroll
        for (int e = 0; e < 8; ++e) if (e != i0 && lg[e] > m1) { m1 = lg[e]; i1 = e; }
        const float p1 = expf(m1 - m0), g0 = 1.f / (1.f + p1), g1 = p1 / (1.f + p1);
        if (lane == 0) {
            const unsigned q0 = atomicAdd(cnt + 64 * i0, 1u), q1 = atomicAdd(cnt + 64 * i1, 1u);
            list[(size_t)i0 * 8192 + q0] = row; list[(size_t)i1 * 8192 + q1] = row; gep[(size_t)i0 * 8192 + q0] = g0; gep[(size_t)i1 * 8192 + q1] = g1;
            slot[row * 2] = i0 * 8192 + (int)q0; slot[row * 2 + 1] = i1 * 8192 + (int)q1; }
    }
}
__device__ __forceinline__ void p_final(const int wv, const float* XR, const bf16_t* YD, const int* slot, const float* gep, const unsigned* cnt, const float* g2, const float* gn, float* out) {
    int tz = my_tid(wv);
    const int lane = tz & 63, gw = blockIdx.x * 8 + (tz >> 6), NGW = gridDim.x * 8;
    for (int row = gw; row < ML; row += NGW) {
        const float* x = XR + (size_t)row * D; const int mi = mod_index(row);
        const int s0 = slot[row * 2], s1 = slot[row * 2 + 1], e0 = s0 >> 13, e1 = s1 >> 13;
        const float ga = gep[s0], gb = gep[s1];
        int h0 = 0, h1 = 0;
#pragma unroll
        for (int e = 0; e < NE; ++e) { const int r = ((int)cnt[64 * e] + 255) >> 8; h0 += e < e0 ? r : 0; h1 += e < e1 ? r : 0; }
        const bf16_t* y0 = YD + ((size_t)h0 * 256 + (s0 & 8191)) * D; const bf16_t* y1 = YD + ((size_t)h1 * 256 + (s1 & 8191)) * D;
        f32x4 v[8]; float s = 0.f;
#pragma unroll
        for (int j = 0; j < 8; ++j) { const int cc = 4 * lane + 256 * j; const u32x2 a = *(const u32x2*)(y0 + cc), b = *(const u32x2*)(y1 + cc);
            const f32x4 ya = (f32x4){ga * bflo(a.x) + gb * bflo(b.x), ga * bfhi(a.x) + gb * bfhi(b.x), ga * bflo(a.y) + gb * bflo(b.y), ga * bfhi(a.y) + gb * bfhi(b.y)};
            v[j] = *(const f32x4*)(x + cc) + *(const f32x4*)(g2 + (size_t)mi * MODW + cc) * ya;
            s += (v[j].x * v[j].x + v[j].y * v[j].y) + (v[j].z * v[j].z + v[j].w * v[j].w); }
        const float rstd = 1.0f / sqrtf(wave_sum(s) * (1.f / D) + EPS);
#pragma unroll
        for (int j = 0; j < 8; ++j) { const int cc = 4 * lane + 256 * j; *(f32x4*)(out + (size_t)row * D + cc) = v[j] * rstd * *(const f32x4*)(gn + cc); }
    }
}

#define XB_TMO      128
#define XB_XCNT(j)  (256  + 64 * (j))
#define XB_XSUB(j)  (1280 + 64 * (j))
#define XB_XGEN(j)  (2304 + 64 * (j))
#define XB_TOP      3328
#define XB_TOPGEN   3392
#define XCD_BAR_WORDS 3456
#define XB_SPIN_CAP (1u << 18)

__device__ __forceinline__ unsigned xb_ld(unsigned* p)              { return __hip_atomic_load(p, __ATOMIC_RELAXED, __HIP_MEMORY_SCOPE_AGENT); }
__device__ __forceinline__ unsigned xb_add(unsigned* p, unsigned v) { return __hip_atomic_fetch_add(p, v, __ATOMIC_RELAXED, __HIP_MEMORY_SCOPE_AGENT); }
__device__ __forceinline__ unsigned xb_xcc_id() { return (unsigned)__builtin_amdgcn_s_getreg((3 << 11) | 20) & 0xFu; }
#define XB_SPIN(cond, bar) do { unsigned _sp = 0; while (cond) { __builtin_amdgcn_s_sleep(1); \
    if ((++_sp & 255u) == 0u) { if (xb_ld(&(bar)[XB_TMO])) break; if (_sp > XB_SPIN_CAP) { atomicAdd(&(bar)[XB_TMO], 1u); break; } } } } while (0)

struct XcdBarrier {
    unsigned* bar; unsigned x;
    volatile LAS unsigned* st;
};

__device__ __forceinline__ XcdBarrier xcd_barrier_post(unsigned* bar, volatile LAS unsigned* st) {
    XcdBarrier b; b.bar = bar; b.x = xb_xcc_id(); b.st = st;
    if (threadIdx.x == 0) (void)xb_add(&bar[XB_XCNT(b.x)], 1u);
    return b;
}
__device__ __forceinline__ void xcd_barrier_complete(unsigned* bar, unsigned x, unsigned& nloc, unsigned& nx) {
    const unsigned G = gridDim.x * gridDim.y * gridDim.z;
    unsigned sum, cnt, mine, sp = 0u;
    for (;;) {
        sum = 0u; cnt = 0u; mine = 0u;
#pragma unroll
        for (unsigned j = 0; j < 16; ++j) { const unsigned c = xb_ld(&bar[XB_XCNT(j)]); sum += c; cnt += (c > 0u) ? 1u : 0u; mine = (j == x) ? c : mine; }
        if (sum == G) break;
        __builtin_amdgcn_s_sleep(1);
        if ((++sp & 255u) == 0u) { if (xb_ld(&bar[XB_TMO])) break; if (sp > XB_SPIN_CAP) { atomicAdd(&bar[XB_TMO], 1u); break; } }
    }
    nloc = mine > 0u ? mine : 1u; nx = cnt > 0u ? cnt : 1u;
}

__device__ __forceinline__ void xcd_barrier(const XcdBarrier& b, const int wv) {
    asm volatile("s_waitcnt vmcnt(0)" ::: "memory");
    __syncthreads();
    if (my_tid(wv) == 0) {
        unsigned* bar = b.bar;
        __builtin_amdgcn_s_waitcnt(0);
        unsigned nloc = b.st[0], nx = b.st[1];
        if (nloc == 0u) { xcd_barrier_complete(bar, b.x, nloc, nx); b.st[0] = nloc; b.st[1] = nx; }
        const unsigned old = xb_add(&bar[XB_XSUB(b.x)], 1u);
        const unsigned gen = old / nloc;
        if (old + 1u == (gen + 1u) * nloc) {
            __builtin_amdgcn_fence(__ATOMIC_RELEASE, "agent");
            asm volatile("s_waitcnt vmcnt(0)" ::: "memory");
            const unsigned og = xb_add(&bar[XB_TOP], 1u);
            const unsigned tg = og / nx;
            if (og + 1u == (tg + 1u) * nx) xb_add(&bar[XB_TOPGEN], 1u);
            else XB_SPIN(xb_ld(&bar[XB_TOPGEN]) == tg, bar);
            __builtin_amdgcn_fence(__ATOMIC_ACQUIRE, "agent");
            xb_add(&bar[XB_XGEN(b.x)], 1u);
            asm volatile("s_waitcnt vmcnt(0)" ::: "memory");
        } else {
            XB_SPIN(xb_ld(&bar[XB_XGEN(b.x)]) == gen, bar);
            __builtin_amdgcn_fence(__ATOMIC_ACQUIRE, "agent");
            asm volatile("s_waitcnt vmcnt(0)" ::: "memory");
        }
    }
    __syncthreads();
}

constexpr int CW_BAR = 4096;
constexpr int LDS_BYTES = LDS_MISC + 64 + 256;
static_assert(MOE_LDS <= LDS_MISC && G1_LDS <= LDS_MISC, "LDS map");
#ifndef MK_PER_PHASE
#define MK_PER_PHASE 0
#endif
constexpr int NPHASE = 20;

#define RUN(p) (lo <= (p) && (p) < hi)
#define SEAM(p) do { if (RUN(p) && RUN((p) + 1)) xcd_barrier(bar, wv); } while (0)
#define PTR(i) ((const float*)ldptr(PT, (i)))
#define WSP ((unsigned char*)ldptr(PT, 25))
#define HELP(ph) q_help(wv, lds, PT, (ph), -1)
#define DRAINQ(n) q_help(wv, lds, PT, 0, (n))
template <int l> __device__ __forceinline__ void layer_phases(const int wv, LAS unsigned char* lds, volatile LAS unsigned long long* PT, const int lo, const int hi, const XcdBarrier& bar, const int G, const int blk) {
        const int pb = 1 + 9 * l;
        const int ctx_row0 = l == 0 ? ML : 0;
        const int nMo = (l == 0) ? MA / 256 : ML / 256;
        if (RUN(pb + 0)) { unsigned char* ws = WSP; const float* modv_l = (const float*)(ws + WS_MODV) + (size_t)l * 3 * MODW; const float* XRc = (const float*)(ws + WS_XR);
            p_ln<false>(wv, l == 0 ? PTR(0) : XRc, l == 0 ? PTR(2) : XRc, ctx_row0, PTR(6) + l * D, modv_l + 0, modv_l + D, (bf16_t*)(ws + WS_XN), MA);
            if constexpr (l == 1) DRAINQ(Q_WIN1); }
        SEAM(pb + 0);
        if (RUN(pb + 1)) { unsigned char* ws = WSP;
            pg8::TileOrder S; S.A = (const char*)(ws + WS_XN); S.Bt = (const char*)((bf16_t*)(ws + WS_WIN) + (size_t)l * INWP * D); S.a_mstep = (size_t)256 * D * 2; S.a_nstep = 0; S.b_nstep = (size_t)256 * D * 2;
            S.nM = MA / 256; S.nN = INWP / 256; S.nwg = S.nM * S.nN; S.G = G; S.c = blk;
            pg8::Gemm g; g.K = D; g.lda = D; g.ldb = D; g.pad = 0;
            EpiIn E; E.U = (bf16_t*)(ws + WS_U); E.R = (float*)(ws + WS_R);
            pg8::gemm_phase<EpiIn, pg8::TileOrder, true>(wv, lds, g, S, E);
            HELP(pb + 1);
        }
        SEAM(pb + 1);
        if (RUN(pb + 2)) { unsigned char* ws = WSP; const float* wgp = PTR(9) + (size_t)l * 2 * 16 * 512; const float* bgp = PTR(10) + (size_t)l * 2 * 512;
            for (int un = blk; un < NUN; un += G) gla_g1_unit(wv, lds, un, (const bf16_t*)(ws + WS_U), (const float*)(ws + WS_R), wgp, bgp, (bf16_t*)(ws + WS_QA), (bf16_t*)(ws + WS_BT), (bf16_t*)(ws + WS_DS), (float*)(ws + WS_DEC));
            p_pool(wv, (const bf16_t*)(ws + WS_U), (bf16_t*)(ws + WS_MIX), MA);
        }
        SEAM(pb + 2);
        if (RUN(pb + 3)) { unsigned char* ws = WSP;
            { pg8::TileOrder S; S.A = (const char*)(ws + WS_MIX); S.Bt = (const char*)((bf16_t*)(ws + WS_WPOOL) + (size_t)l * 4 * 256 * 256); S.a_mstep = (size_t)256 * 1024 * 2; S.a_nstep = (size_t)256 * 2; S.b_nstep = (size_t)256 * 256 * 2;
              S.nM = MA / 256; S.nN = 4; S.nwg = S.nM * S.nN; S.G = G; S.c = blk;
              pg8::Gemm g; g.K = 256; g.lda = 1024; g.ldb = 256; g.pad = 0;
              EpiPool E; E.Y = (bf16_t*)(ws + WS_Y); E.scale = PTR(13) + l * 1024;
              pg8::gemm_phase<EpiPool, pg8::TileOrder, true>(wv, lds, g, S, E); }
            p_gla_g2(wv, (const bf16_t*)(ws + WS_DS), (const float*)(ws + WS_DEC), (bf16_t*)(ws + WS_BT));
        }
        SEAM(pb + 3);
        if (RUN(pb + 4)) { unsigned char* ws = WSP; const float* gain = PTR(11) + l * 1024;
            for (int un = blk; un < NUN; un += G) { if (l == 1 && (un % NCH) < 4) continue; gla_g3_unit(wv, lds, un, (const bf16_t*)(ws + WS_QA), (const bf16_t*)(ws + WS_BT), (const bf16_t*)(ws + WS_U), gain, (bf16_t*)(ws + WS_Y)); }
            DRAINQ(l == 0 ? Q_WOUT0 : Q_WOUT1);
        }
        SEAM(pb + 4);
        if (RUN(pb + 5)) { unsigned char* ws = WSP; const float* modv_l = (const float*)(ws + WS_MODV) + (size_t)l * 3 * MODW; float* XR = (float*)(ws + WS_XR);
            pg8::TileOrder S; S.A = (const char*)(ws + WS_Y); S.Bt = (const char*)((bf16_t*)(ws + WS_WOUT) + (size_t)l * D * D); S.a_mstep = (size_t)256 * D * 2; S.a_nstep = 0; S.b_nstep = (size_t)256 * D * 2;
            S.nM = nMo; S.nN = D / 256; S.nwg = S.nM * S.nN; S.G = G; S.c = blk;
            pg8::Gemm g; g.K = D; g.lda = D; g.ldb = D; g.pad = 0;
            EpiResid E; E.src_lat = l == 0 ? PTR(0) : XR; E.src_ctx = l == 0 ? PTR(2) : XR; E.XR = XR; E.gate = modv_l + 2 * D; E.rowgate = nullptr; E.rg_stride = 0; E.ctx_row0 = ctx_row0;
            pg8::gemm_phase<EpiResid, pg8::TileOrder, true>(wv, lds, g, S, E);
            if constexpr (l == 0) HELP(pb + 5);
        }
        SEAM(pb + 5);
        if (RUN(pb + 6)) { unsigned char* ws = WSP; const float* modv_l = (const float*)(ws + WS_MODV) + (size_t)l * 3 * MODW; const float* XR = (const float*)(ws + WS_XR);
            if constexpr (l == 0) p_ln<false>(wv, XR, XR, 0, PTR(7) + l * D, modv_l + 3 * D, modv_l + 4 * D, (bf16_t*)(ws + WS_XN), nMo * 256);
            if constexpr (l == 0) DRAINQ(Q_F3); else DRAINQ(Q_ALL);
            if constexpr (l == 1) p_router(wv, XR, PTR(7) + l * D, modv_l + 3 * D, modv_l + 4 * D, PTR(18), PTR(19), (unsigned*)(ws + WS_CTL) + CW_CNT, (int*)(ws + WS_LIST), (float*)(ws + WS_GEP), (int*)(ws + WS_SLOT), ws + WS_XN);
        }
        SEAM(pb + 6);
        if (RUN(pb + 7)) { unsigned char* ws = WSP;
            if constexpr (l == 0) {
                pg8::TileOrder S; S.A = (const char*)(ws + WS_XN); S.Bt = (const char*)(ws + WS_W13); S.a_mstep = (size_t)256 * D * 2; S.a_nstep = 0; S.b_nstep = (size_t)256 * D * 2;
                S.nM = MA / 256; S.nN = 2 * DFF / 256; S.nwg = S.nM * S.nN; S.G = G; S.c = blk;
                pg8::Gemm g; g.K = D; g.lda = D; g.ldb = D; g.pad = 0;
                EpiSwiglu8 E; E.H = ws + WS_HH; E.ldh = DFF; E.pad = 0;
                pg8::gemm_phase<EpiSwiglu8, pg8::TileOrder, true>(wv, lds, g, S, E);
                HELP(pb + 7); DRAINQ(Q_F2);
            } else {
                LAS int* tab = (LAS int*)(lds + MOE_TAB); LAS int* rows = (LAS int*)(lds + MOE_ROWS);
                moe_tab_init(wv, tab, (const unsigned*)(ws + WS_CTL) + CW_CNT, 2 * DFF / 256);
                MoeOrder<true> S; S.A = (const char*)(ws + WS_XN); S.Bt = (const char*)(ws + WS_MW13); S.a_mstep = 0; S.b_estep = (size_t)2 * DFF * D; S.b_nstep = (size_t)256 * D; S.tab = tab; S.rows = rows; S.nN = 2 * DFF / 256; S.G = G; S.c = blk;
                { pg8::Unit u; const int* LIST = (const int*)(ws + WS_LIST);
                  for (int ui = 0; S.next(ui, u); ++ui) { const int n = tab[48 + u.e];
                      for (int r = my_tid(wv); r < 256; r += 512) { const int p = u.pml * 256 + r; rows[ui * 256 + r] = LIST[(size_t)u.e * 8192 + (p < n ? p : 0)]; } }
                  __syncthreads(); }
                pg8::Gemm g; g.K = D / 2; g.lda = D / 2; g.ldb = D / 2; g.pad = 0;
                EpiSwiglu8 E; E.H = ws + WS_HH; E.ldh = DFF; E.pad = 0;
                pg8::gemm_phase<EpiSwiglu8, MoeOrder<true>, true, true>(wv, lds, g, S, E);
            }
        }
        SEAM(pb + 7);
        if (RUN(pb + 8)) { unsigned char* ws = WSP;
            if constexpr (l == 0) { const float* modv_l = (const float*)(ws + WS_MODV); float* XR = (float*)(ws + WS_XR);
                pg8::TileOrder S; S.A = (const char*)(ws + WS_HH); S.Bt = (const char*)(ws + WS_W2); S.a_mstep = (size_t)256 * DFF; S.a_nstep = 0; S.b_nstep = (size_t)256 * DFF;
                S.nM = MA / 256; S.nN = D / 256; S.nwg = S.nM * S.nN; S.G = G; S.c = blk;
                pg8::Gemm g; g.K = DFF / 2; g.lda = DFF / 2; g.ldb = DFF / 2; g.pad = 0;
                EpiResid E; E.src_lat = XR; E.src_ctx = XR; E.XR = XR; E.gate = modv_l + 5 * D; E.rowgate = nullptr; E.rg_stride = 0; E.ctx_row0 = 0;
                pg8::gemm_phase<EpiResid, pg8::TileOrder, true, true>(wv, lds, g, S, E);
                HELP(pb + 8);
            } else {
                LAS int* tab = (LAS int*)(lds + MOE_TAB); LAS int* rows = (LAS int*)(lds + MOE_ROWS);
                moe_tab_init(wv, tab, (const unsigned*)(ws + WS_CTL) + CW_CNT, D / 256);
                MoeOrder<false> S; S.A = (const char*)(ws + WS_HH); S.Bt = (const char*)(ws + WS_MW2); S.a_mstep = (size_t)256 * DFF; S.b_estep = (size_t)D * DFF; S.b_nstep = (size_t)256 * DFF; S.tab = tab; S.rows = rows; S.nN = D / 256; S.G = G; S.c = blk;
                pg8::Gemm g; g.K = DFF / 2; g.lda = DFF / 2; g.ldb = DFF / 2; g.pad = 0;
                EpiMoeDown E; E.YD = (bf16_t*)(ws + WS_YD);
                pg8::gemm_phase<EpiMoeDown, MoeOrder<false>, true, true>(wv, lds, g, S, E);
            }
        }
        SEAM(pb + 8);
}

struct Args { const float* in[24]; float* out; unsigned char* ws; int ph_lo, ph_hi; };
__global__ void __launch_bounds__(512, 2) mk_fwd(Args args) {
    extern __shared__ __attribute__((aligned(16))) unsigned char lds_raw[];
    LAS unsigned char* lds = (LAS unsigned char*)lds_raw;
    volatile LAS unsigned* MISC = (volatile LAS unsigned*)(lds + LDS_MISC);
    const int wv = __builtin_amdgcn_readfirstlane((int)threadIdx.x >> 6);
    if (threadIdx.x < 16) MISC[threadIdx.x] = 0u;
    __syncthreads();
    volatile LAS unsigned long long* PT = (volatile LAS unsigned long long*)(lds + LDS_MISC + 64);
    if (threadIdx.x < 24) PT[threadIdx.x] = (unsigned long long)args.in[threadIdx.x];
    if (threadIdx.x == 24) PT[24] = (unsigned long long)args.out;
    if (threadIdx.x == 25) PT[25] = (unsigned long long)args.ws;
    __syncthreads();
    const int lo = args.ph_lo, hi = args.ph_hi;
    XcdBarrier bar; bar.bar = (unsigned*)(args.ws + WS_CTL) + CW_BAR; bar.x = 0; bar.st = MISC;
    if (hi - lo > 1) bar = xcd_barrier_post((unsigned*)(args.ws + WS_CTL) + CW_BAR, MISC);
    const int G = gridDim.x, blk = blockIdx.x;

    if (RUN(0)) {
        unsigned char* ws = WSP;
        p_ada(wv, lds, PTR(1), PTR(3), PTR(4), PTR(5), (float*)(ws + WS_MODV));
        p_convert(wv, lds, PTR(8), (bf16_t*)(ws + WS_WIN), (size_t)D * INW, (size_t)INWP * D, D, INW, INWP, 1 << 30, 0, 0, 1);
        p_convert(wv, lds, PTR(12), (bf16_t*)(ws + WS_WPOOL), (size_t)256 * 256, (size_t)256 * 256, 256, 256, 256, 1 << 30, 0, 0, 8);
    }
    SEAM(0);
    layer_phases<0>(wv, lds, PT, lo, hi, bar, G, blk);
    layer_phases<1>(wv, lds, PT, lo, hi, bar, G, blk);
    if (RUN(19)) { unsigned char* ws = WSP;
        p_final(wv, (const float*)(ws + WS_XR), (const bf16_t*)(ws + WS_YD), (const int*)(ws + WS_SLOT), (const float*)(ws + WS_GEP), (const unsigned*)(ws + WS_CTL) + CW_CNT, (const float*)(ws + WS_MODV) + 3 * MODW + 5 * D, PTR(23), (float*)ldptr(PT, 24)); }
#undef RUN
#undef SEAM
#undef PTR
#undef WSP
}

extern "C" void kernel_launch(void* const* d_in, const int* in_sizes, int n_in, void* d_out, int out_size, void* d_ws, size_t ws_size, hipStream_t stream) {
    if (n_in != 24 || ws_size < WS_END || out_size != ML * D) { fprintf(stderr, "kernel_launch: unexpected sizes (n_in %d, ws %zu, out %d)\n", n_in, ws_size, out_size); return; }
    static int grid = 0;
    if (grid == 0) {
        int dev = 0, cus = 0, per_cu = 0;
        if (hipGetDevice(&dev) != hipSuccess || hipDeviceGetAttribute(&cus, hipDeviceAttributeMultiprocessorCount, dev) != hipSuccess) { grid = -1; return; }
        if (hipFuncSetAttribute((const void*)mk_fwd, hipFuncAttributeMaxDynamicSharedMemorySize, LDS_BYTES) != hipSuccess) { fprintf(stderr, "kernel_launch: hipFuncSetAttribute failed\n"); grid = -1; return; }
        if (hipOccupancyMaxActiveBlocksPerMultiprocessor(&per_cu, (const void*)mk_fwd, 512, LDS_BYTES) != hipSuccess || per_cu < 1) fprintf(stderr, "kernel_launch: occupancy query reports %d\n", per_cu);
        (void)hipGetLastError();
        grid = cus;
    }
    if (grid < 0) return;
    (void)hipMemsetAsync((char*)d_ws + WS_CTL, 0, 1 * MiB, stream);
    Args a; memset(&a, 0, sizeof a);
    for (int i = 0; i < 24; ++i) a.in[i] = (const float*)d_in[i];
    a.out = (float*)d_out; a.ws = (unsigned char*)d_ws;
#if MK_PER_PHASE
    for (int p = 0; p < NPHASE; ++p) { a.ph_lo = p; a.ph_hi = p + 1; hipLaunchKernelGGL(mk_fwd, dim3(grid), dim3(512), LDS_BYTES, stream, a); }
#else
    a.ph_lo = 0; a.ph_hi = NPHASE; hipLaunchKernelGGL(mk_fwd, dim3(grid), dim3(512), LDS_BYTES, stream, a);
#endif
#ifdef MK_PROBE_MASK
    for (int p = 0; p < NPHASE; ++p) if ((MK_PROBE_MASK >> p) & 1) { a.ph_lo = p; a.ph_hi = p + 1; hipLaunchKernelGGL(mk_fwd, dim3(grid), dim3(512), LDS_BYTES, stream, a); }
#endif
}
```

```cpp
#include <hip/hip_runtime.h>
#include <cstdio>
#include <cstdint>
#include <cstring>

#define LAS __attribute__((address_space(3)))
typedef unsigned short bf16_t;
typedef short bf16x8 __attribute__((ext_vector_type(8)));
typedef float f32x4 __attribute__((ext_vector_type(4)));
typedef float f32x2 __attribute__((ext_vector_type(2)));
typedef unsigned u32x4 __attribute__((ext_vector_type(4)));
typedef unsigned u32x2 __attribute__((ext_vector_type(2)));

constexpr int D = 2048, NBATCH = 2, SEQ = 4096, CTXL = 256;
constexpr int ML = NBATCH * SEQ;
constexpr int MC = NBATCH * CTXL;
constexpr int MA = ML + MC;
constexpr int INW = 4128, INWP = 4352;
constexpr int DFF = 5632, NE = 8;
constexpr int GH = 4, DK = 128, DV = 256;
constexpr int C_Q = 0, C_K = 512, C_V = 1024, C_G = 2048, C_P = 3072, C_R = 4096;
constexpr float EPS = 1e-6f;
constexpr int MODW = 6 * D;

constexpr size_t MiB = 1u << 20;
constexpr size_t WS_CTL = 0;
constexpr size_t WS_MODV = 1 * MiB;
constexpr size_t WS_LIST = 2 * MiB;
constexpr size_t WS_GEP = WS_LIST + 256 * 1024;
constexpr size_t WS_SLOT = WS_GEP + 256 * 1024;
constexpr size_t WS_R = 3 * MiB;
constexpr size_t WS_WPOOL = 5 * MiB;
constexpr size_t WS_WIN = 6 * MiB;
constexpr size_t WS_WOUT = 40 * MiB;
constexpr size_t WS_W13 = 56 * MiB;
constexpr size_t WS_W2 = 100 * MiB;
constexpr size_t WS_MW13 = 122 * MiB;
constexpr size_t WS_MW2 = 474 * MiB;
constexpr size_t WS_XR = 650 * MiB;
constexpr size_t WS_XN = 718 * MiB;
constexpr size_t WS_U = 752 * MiB;
constexpr size_t WS_Y = 825 * MiB;
constexpr size_t WS_MIX = 859 * MiB;
constexpr size_t WS_HH = 876 * MiB;
constexpr size_t WS_QA = 1074 * MiB;
constexpr size_t WS_BT = 1096 * MiB;
constexpr size_t WS_DS = 1182 * MiB;
constexpr size_t WS_DEC = 1318 * MiB;
constexpr size_t WS_YD = WS_QA;
constexpr size_t WS_END = 1320 * MiB;
constexpr int CW_CNT = 1024;
constexpr int LDS_MISC = 147456;
constexpr int MOE_TAB = 131072, MOE_ROWS = 131072 + 256, MOE_MAXU = 15, MOE_LDS = MOE_ROWS + MOE_MAXU * 1024;

__device__ __forceinline__ int my_tid(int wv) { int t = wv * 64 + (int)__builtin_amdgcn_mbcnt_hi(~0u, __builtin_amdgcn_mbcnt_lo(~0u, 0u)); asm volatile("" : "+v"(t)); return t; }
namespace pg8 {
constexpr int BM = 256, BK = 64, HALF = 128, HTB = HALF * BK * 2, STAGE_BYTES = 8 * HTB, NXCD = 8, WGM = 8;
__host__ __device__ __forceinline__ int lds_byte(int r, int c) { const int st = (r >> 4) * 2 + (c >> 5), rr = r & 15, cc = c & 31, ob = rr * 64 + cc * 2; return st * 1024 + (ob ^ (((ob >> 9) & 1) << 5)); }
__host__ __device__ __forceinline__ void stage_rc(int b, int& R, int& C) { const int st = b / 1024, sb = b % 1024, swz = sb ^ (((sb >> 9) & 1) << 5); R = (st >> 1) * 16 + swz / 64; C = (st & 1) * 32 + (swz % 64) / 2; }
__host__ __device__ __forceinline__ int perm32(int rho) { const int n = rho >> 4, i = rho & 15; return 8 * (i >> 2) + 4 * n + (i & 3); }

struct Unit { const char* a; const char* b; int pm, pn, e, pml; };
struct Gemm { int K, lda, ldb, pad; };

struct TileOrder {
    static constexpr bool GATHER = false;
    const char* A; const char* Bt; size_t a_mstep, a_nstep, b_nstep; int nM, nN, nwg, G, c;
    __device__ __forceinline__ bool next(int i, Unit& u) const {
        const long L = (long)i * G + c; if (L >= nwg) return false;
        int wgid = (int)L; { const int q = nwg / NXCD, r = nwg % NXCD, xcd = wgid % NXCD, off = wgid / NXCD; wgid = (xcd < r ? xcd * (q + 1) : r * (q + 1) + (xcd - r) * q) + off; }
        const int nig = WGM * nN, gid = wgid / nig, fm = gid * WGM, gsz = (nM - fm) < WGM ? (nM - fm) : WGM;
        u.pm = fm + ((wgid % nig) % gsz); u.pn = (wgid % nig) / gsz;
        u.a = A + (size_t)u.pm * a_mstep + (size_t)u.pn * a_nstep; u.b = Bt + (size_t)u.pn * b_nstep; u.e = 0; u.pml = u.pm; return true;
    }
    __device__ __forceinline__ void a_off(int, const Unit&, int tid, int lda, unsigned (&v)[4]) const {
#pragma unroll
        for (int i = 0; i < 2; ++i) { int R, C; stage_rc(tid * 16 + i * 8192, R, C); v[i] = (unsigned)(R * lda + C) * 2u; v[2 + i] = (unsigned)((R + HALF) * lda + C) * 2u; }
    }
};

typedef __bf16 bf16x2_hw __attribute__((ext_vector_type(2)));
__device__ __forceinline__ unsigned cvt_pk_bf16(float lo, float hi) { const f32x2 v = {lo, hi}; const bf16x2_hw b = __builtin_convertvector(v, bf16x2_hw); return __builtin_bit_cast(unsigned, b); }

__device__ __forceinline__ void glds16(unsigned voff, const char* sbase, unsigned lds_dst) {
    unsigned keep;
    asm volatile("s_nop 4\n\ts_mov_b32 %0, m0\n\ts_mov_b32 m0, %2\n\ts_nop 0\n\tglobal_load_lds_dwordx4 %1, %3\n\ts_mov_b32 m0, %0" : "=&s"(keep) : "v"(voff), "s"(lds_dst), "s"(sbase) : "memory");
}
__device__ __forceinline__ const char* ubase(const char* p) {
    const unsigned long long v = (unsigned long long)p;
    const unsigned lo = __builtin_amdgcn_readfirstlane((unsigned)v), hi = __builtin_amdgcn_readfirstlane((unsigned)(v >> 32));
    return (const char*)(((unsigned long long)hi << 32) | lo);
}
typedef int v4i_t __attribute__((ext_vector_type(4)));
typedef int v8i_t __attribute__((ext_vector_type(8)));
__device__ __forceinline__ v8i_t cat8(bf16x8 lo, bf16x8 hi) { const v4i_t a = __builtin_bit_cast(v4i_t, lo), b = __builtin_bit_cast(v4i_t, hi); return __builtin_shufflevector(a, b, 0, 1, 2, 3, 4, 5, 6, 7); }
template <class Epi, class Sched, bool ALIGN_EPI, bool FP8 = false>
__device__ __forceinline__ void gemm_phase(const int wv, LAS unsigned char* lds, const Gemm g, const Sched& S, const Epi& E) {
    int tid = my_tid(wv);
    const int wid = __builtin_amdgcn_readfirstlane(tid >> 6), lane = tid & 63, wr = wid >> 2, wc = wid & 3, fr = lane & 15, fq = lane >> 4;
    const int K = g.K, nt = K / BK;
    unsigned voffB[2];
#pragma unroll
    for (int i = 0; i < 2; ++i) { int R, C; stage_rc(tid * 16 + i * 8192, R, C); const int Rb = Epi::PERM ? ((R & ~31) + perm32(R & 31)) : R;
        voffB[i] = (unsigned)(Rb * g.ldb + C) * 2u; }
    const size_t kstep = (size_t)(BK * 2);
    const size_t hB = (size_t)HALF * g.ldb * 2, hA = (size_t)HALF * g.lda * 2;
    const unsigned ldsw = (unsigned)wid * 1024u;
    constexpr bool ASMDMA = FP8 && !Sched::GATHER;
    const unsigned ldsb = (unsigned)__builtin_amdgcn_readfirstlane((int)(unsigned)(unsigned long long)(lds + ldsw));
    const int scl8 = 0x7c7c7c7c;
    const int aoff = lds_byte(wr * 64 + fr, fq * 8), boff = lds_byte(wc * 32 + fr, fq * 8);
#define PG8_SA(b, h) (((b) * 2 + (h)) * HTB)
#define PG8_SB(b, h) ((4 + (b) * 2 + (h)) * HTB)
#define PG8_STAGE(bufoff, gbase, voff) do { if constexpr (ASMDMA) { const char* _gb = ubase((const char*)(gbase)); _Pragma("unroll") for (int _i = 0; _i < 2; ++_i) glds16((voff)[_i], _gb, ldsb + (unsigned)((bufoff) + _i * 8192)); } \
        else { _Pragma("unroll") for (int _i = 0; _i < 2; ++_i) __builtin_amdgcn_global_load_lds((const unsigned*)((const char*)(gbase) + (voff)[_i]), (LAS unsigned*)(lds + (bufoff) + ldsw + _i * 8192), 16, 0, 0); } } while (0)
#define PG8_STAGEA(bufoff, gbase, voff, hh) do { if constexpr (ASMDMA) { const char* _gb = ubase((const char*)(gbase) + (hh) * hA); _Pragma("unroll") for (int _i = 0; _i < 2; ++_i) glds16((voff)[_i], _gb, ldsb + (unsigned)((bufoff) + _i * 8192)); } \
        else { _Pragma("unroll") for (int _i = 0; _i < 2; ++_i) { \
        if constexpr (Sched::GATHER) __builtin_amdgcn_global_load_lds((const unsigned*)((const char*)(gbase) + (voff)[(hh) * 2 + _i]), (LAS unsigned*)(lds + (bufoff) + ldsw + _i * 8192), 16, 0, 0); \
        else __builtin_amdgcn_global_load_lds((const unsigned*)((const char*)(gbase) + (hh) * hA + (voff)[_i]), (LAS unsigned*)(lds + (bufoff) + ldsw + _i * 8192), 16, 0, 0); } } } while (0)
#define PG8_LDA(dst, b, h) do { _Pragma("unroll") for (int m = 0; m < 4; ++m) _Pragma("unroll") for (int k = 0; k < 2; ++k) dst[m][k] = *(const LAS bf16x8*)(lds + PG8_SA(b, h) + aoff + m * 2048 + k * 1024); } while (0)
#define PG8_LDB(dst, b, h) do { _Pragma("unroll") for (int n = 0; n < 2; ++n) _Pragma("unroll") for (int k = 0; k < 2; ++k) dst[n][k] = *(const LAS bf16x8*)(lds + PG8_SB(b, h) + boff + n * 2048 + k * 1024); } while (0)
#define PG8_MMA(ai, bj, At, Bt) do { __builtin_amdgcn_s_setprio(1); \
        if constexpr (FP8) { _Pragma("unroll") for (int m = 0; m < 4; ++m) _Pragma("unroll") for (int n = 0; n < 2; ++n) \
            acc[ai][bj][m][n] = __builtin_amdgcn_mfma_scale_f32_16x16x128_f8f6f4(cat8(Bt[n][0], Bt[n][1]), cat8(At[m][0], At[m][1]), acc[ai][bj][m][n], 0, 0, 0, scl8, 0, scl8); } \
        else { _Pragma("unroll") for (int m = 0; m < 4; ++m) _Pragma("unroll") for (int n = 0; n < 2; ++n) _Pragma("unroll") for (int k = 0; k < 2; ++k) \
            acc[ai][bj][m][n] = __builtin_amdgcn_mfma_f32_16x16x32_bf16(Bt[n][k], At[m][k], acc[ai][bj][m][n], 0, 0, 0); } \
        __builtin_amdgcn_s_setprio(0); } while (0)
#define PG8_WAIT_V(n) asm volatile("s_waitcnt vmcnt(" #n ")" ::: "memory")
#define PG8_WAIT_L(n) asm volatile("s_waitcnt lgkmcnt(" #n ")" ::: "memory")
#define PG8_BAR __builtin_amdgcn_s_barrier()
#define PG8_SCHED __builtin_amdgcn_sched_barrier(0)
    Unit cur, nxt; int ui = 0;
    if (!S.next(0, cur)) return;
    f32x4 acc[2][2][4][2];
#pragma unroll
    for (int a = 0; a < 2; ++a)
#pragma unroll
        for (int b = 0; b < 2; ++b)
#pragma unroll
            for (int m = 0; m < 4; ++m)
#pragma unroll
                for (int n = 0; n < 2; ++n) acc[a][b][m][n] = (f32x4){0.f, 0.f, 0.f, 0.f};
    bf16x8 At[4][2], B0[2][2], B1[2][2];
    const char* cA = cur.a; const char* cB = cur.b;
    unsigned vA[4];
    S.a_off(0, cur, tid, g.lda, vA);
    PG8_STAGE(PG8_SB(0, 0), cB, voffB); PG8_STAGE(PG8_SB(0, 1), cB + hB, voffB); PG8_STAGEA(PG8_SA(0, 0), cA, vA, 0); PG8_STAGEA(PG8_SA(0, 1), cA, vA, 1);
    if (wr == 1) PG8_BAR;
    PG8_WAIT_V(2); PG8_BAR;
    PG8_STAGE(PG8_SB(1, 0), cB + kstep, voffB); PG8_STAGEA(PG8_SA(1, 0), cA + kstep, vA, 0); PG8_STAGE(PG8_SB(1, 1), cB + hB + kstep, voffB);
    PG8_WAIT_V(6); PG8_BAR;
    for (;;) {
        const bool has_next = S.next(ui + 1, nxt);
        const char* nA = has_next ? nxt.a : cA; const char* nB = has_next ? nxt.b : cB;
        for (int t = 0; t < nt; t += 2) {
            const bool last = (t == nt - 2);
            const char* a1 = cA + (size_t)(t + 1) * kstep;
            const char* a2 = last ? nA : cA + (size_t)(t + 2) * kstep; const char* b2 = last ? nB : cB + (size_t)(t + 2) * kstep;
            const char* a3 = a2 + kstep; const char* b3 = b2 + kstep;
            PG8_LDB(B0, 0, 0); PG8_LDB(B1, 0, 1); PG8_SCHED; PG8_LDA(At, 0, 0); PG8_STAGEA(PG8_SA(1, 1), a1, vA, 1);
            if constexpr (Sched::GATHER) { if (last && has_next) S.a_off(ui + 1, nxt, my_tid(wv), g.lda, vA); }
            PG8_WAIT_V(8); PG8_WAIT_L(0); PG8_BAR; PG8_MMA(0, 0, At, B0); PG8_MMA(0, 1, At, B1); PG8_BAR; PG8_SCHED;
            PG8_LDA(At, 0, 1); PG8_STAGE(PG8_SB(0, 0), b2, voffB); PG8_STAGE(PG8_SB(0, 1), b2 + hB, voffB); PG8_STAGEA(PG8_SA(0, 0), a2, vA, 0);
            PG8_WAIT_V(8); PG8_WAIT_L(0); PG8_BAR; PG8_MMA(1, 0, At, B0); PG8_MMA(1, 1, At, B1); PG8_BAR; PG8_SCHED;
            PG8_LDB(B0, 1, 0); PG8_LDB(B1, 1, 1); PG8_SCHED; PG8_LDA(At, 1, 0); PG8_STAGEA(PG8_SA(0, 1), a2, vA, 1);
            PG8_WAIT_V(8); PG8_WAIT_L(0); PG8_BAR; PG8_MMA(0, 0, At, B0); PG8_MMA(0, 1, At, B1); PG8_BAR; PG8_SCHED;
            PG8_LDA(At, 1, 1); PG8_STAGE(PG8_SB(1, 0), b3, voffB); PG8_STAGE(PG8_SB(1, 1), b3 + hB, voffB); PG8_STAGEA(PG8_SA(1, 0), a3, vA, 0);
            PG8_WAIT_V(8); PG8_WAIT_L(0); PG8_BAR; PG8_MMA(1, 0, At, B0); PG8_MMA(1, 1, At, B1); PG8_BAR; PG8_SCHED;
        }
        if constexpr (ALIGN_EPI) { if (wr == 0) PG8_BAR; }
        { const int te = my_tid(wv), le = te & 63, we = __builtin_amdgcn_readfirstlane(te >> 6); E(acc, cur, we >> 2, we & 3, le & 15, le >> 4); }
        if (!has_next) break;
#pragma unroll
        for (int a = 0; a < 2; ++a)
#pragma unroll
            for (int b = 0; b < 2; ++b)
#pragma unroll
                for (int m = 0; m < 4; ++m)
#pragma unroll
                    for (int n = 0; n < 2; ++n) acc[a][b][m][n] = (f32x4){0.f, 0.f, 0.f, 0.f};
        cur = nxt; cA = nA; cB = nB; ++ui;
        if constexpr (ALIGN_EPI) { if (wr == 1) PG8_BAR; }
    }
    PG8_WAIT_V(0);
    if constexpr (!ALIGN_EPI) { if (wr == 0) PG8_BAR; }
    PG8_BAR;
#undef PG8_SA
#undef PG8_SB
#undef PG8_STAGE
#undef PG8_STAGEA
#undef PG8_LDA
#undef PG8_LDB
#undef PG8_MMA
#undef PG8_WAIT_V
#undef PG8_WAIT_L
#undef PG8_BAR
#undef PG8_SCHED
}
}
using pg8::cvt_pk_bf16;
typedef f32x4 Acc[2][2][4][2];

__device__ __forceinline__ float bf2f(bf16_t v) { return __uint_as_float(((unsigned)v) << 16); }
__device__ __forceinline__ float siluf(float a) { return a * __builtin_amdgcn_rcpf(1.f + __expf(-a)); }
__device__ __forceinline__ int mod_index(int row) { return row < SEQ ? 0 : (row < ML ? 1 : 2); }

struct EpiIn {
    static constexpr bool PERM = true;
    bf16_t* U; float* R;
    __device__ __forceinline__ void operator()(const Acc& acc, const pg8::Unit& u, int wr, int wc, int fr, int fq) const {
        const int row0 = u.pm * 256 + wr * 64 + fr, col0 = u.pn * 256 + wc * 32 + 8 * fq;
        const float sc = (u.pn < 2) ? 0.08838834764831845f : 1.f;
#pragma unroll
        for (int ai = 0; ai < 2; ++ai)
#pragma unroll
            for (int m = 0; m < 4; ++m) { const int row = row0 + ai * 128 + m * 16; bf16_t* rowp = U + (size_t)row * INWP + col0;
#pragma unroll
                for (int bj = 0; bj < 2; ++bj) { const f32x4 v0 = acc[ai][bj][m][0] * sc, v1 = acc[ai][bj][m][1] * sc;
                    u32x4 w; w.x = cvt_pk_bf16(v0[0], v0[1]); w.y = cvt_pk_bf16(v0[2], v0[3]); w.z = cvt_pk_bf16(v1[0], v1[1]); w.w = cvt_pk_bf16(v1[2], v1[3]);
                    *(u32x4*)(rowp + bj * 128) = w; }
                if (u.pn == 16 && wc == 0) { float* rp = R + (size_t)row * 32 + 8 * fq; *(f32x4*)rp = acc[ai][0][m][0]; *(f32x4*)(rp + 4) = acc[ai][0][m][1]; } }
    }
};
struct EpiPool {
    static constexpr bool PERM = true;
    bf16_t* Y; const float* scale;
    __device__ __forceinline__ void operator()(const Acc& acc, const pg8::Unit& u, int wr, int wc, int fr, int fq) const {
        const int row0 = u.pm * 256 + wr * 64 + fr, col0 = u.pn * 256 + wc * 32 + 8 * fq;
        f32x4 sv[2][2];
#pragma unroll
        for (int bj = 0; bj < 2; ++bj)
#pragma unroll
            for (int n = 0; n < 2; ++n) sv[bj][n] = *(const f32x4*)(scale + col0 + bj * 128 + 4 * n);
#pragma unroll
        for (int ai = 0; ai < 2; ++ai)
#pragma unroll
            for (int m = 0; m < 4; ++m) { bf16_t* rowp = Y + (size_t)(row0 + ai * 128 + m * 16) * D + 1024 + col0;
#pragma unroll
                for (int bj = 0; bj < 2; ++bj) { const f32x4 v0 = acc[ai][bj][m][0] * sv[bj][0], v1 = acc[ai][bj][m][1] * sv[bj][1];
                    u32x4 w; w.x = cvt_pk_bf16(v0[0], v0[1]); w.y = cvt_pk_bf16(v0[2], v0[3]); w.z = cvt_pk_bf16(v1[0], v1[1]); w.w = cvt_pk_bf16(v1[2], v1[3]);
                    *(u32x4*)(rowp + bj * 128) = w; } }
    }
};
struct EpiResid {
    static constexpr bool PERM = false;
    const float* src_lat; const float* src_ctx; float* XR; const float* gate; const float* rowgate; int rg_stride, ctx_row0;
    __device__ __forceinline__ void operator()(const Acc& acc, const pg8::Unit& u, int wr, int wc, int fr, int fq) const {
        const int row0 = u.pm * 256 + wr * 64 + fr, col0 = u.pn * 256 + wc * 32 + 4 * fq;
        const int mi = u.pm < 16 ? 0 : (u.pm < 32 ? 1 : 2);
        const float* src = u.pm < 32 ? src_lat : src_ctx - (size_t)ctx_row0 * D;
        f32x4 gv[2][2];
#pragma unroll
        for (int bj = 0; bj < 2; ++bj)
#pragma unroll
            for (int n = 0; n < 2; ++n) gv[bj][n] = *(const f32x4*)(gate + (size_t)mi * MODW + col0 + bj * 128 + n * 16);
#pragma unroll
        for (int ai = 0; ai < 2; ++ai)
#pragma unroll
            for (int mp = 0; mp < 2; ++mp) { f32x4 bs[2][2][2];
#pragma unroll
                for (int mm = 0; mm < 2; ++mm) { const size_t off = (size_t)(row0 + ai * 128 + (2 * mp + mm) * 16) * D + col0;
#pragma unroll
                    for (int bj = 0; bj < 2; ++bj)
#pragma unroll
                        for (int n = 0; n < 2; ++n) bs[mm][bj][n] = *(const f32x4*)(src + off + bj * 128 + n * 16); }
#pragma unroll
                for (int mm = 0; mm < 2; ++mm) { const size_t off = (size_t)(row0 + ai * 128 + (2 * mp + mm) * 16) * D + col0;
#pragma unroll
                    for (int bj = 0; bj < 2; ++bj)
#pragma unroll
                        for (int n = 0; n < 2; ++n) *(f32x4*)(XR + off + bj * 128 + n * 16) = bs[mm][bj][n] + gv[bj][n] * acc[ai][bj][2 * mp + mm][n]; } }
    }
};
struct EpiSwiglu {
    static constexpr bool PERM = true;
    bf16_t* H; int ldh, pad;
    __device__ __forceinline__ void operator()(const Acc& acc, const pg8::Unit& u, int wr, int wc, int fr, int fq) const {
        const int row0 = u.pm * 256 + wr * 64 + fr, col0 = u.pn * 128 + wc * 32 + 8 * fq;
#pragma unroll
        for (int ai = 0; ai < 2; ++ai)
#pragma unroll
            for (int m = 0; m < 4; ++m) { bf16_t* rowp = H + (size_t)(row0 + ai * 128 + m * 16) * ldh + col0;
                float h[8];
#pragma unroll
                for (int n = 0; n < 2; ++n)
#pragma unroll
                    for (int j = 0; j < 4; ++j) h[n * 4 + j] = siluf(acc[ai][0][m][n][j]) * acc[ai][1][m][n][j];
                u32x4 w; w.x = cvt_pk_bf16(h[0], h[1]); w.y = cvt_pk_bf16(h[2], h[3]); w.z = cvt_pk_bf16(h[4], h[5]); w.w = cvt_pk_bf16(h[6], h[7]);
                *(u32x4*)rowp = w; }
    }
};

struct EpiSwiglu8 {
    static constexpr bool PERM = true;
    unsigned char* H; int ldh, pad;
    __device__ __forceinline__ void operator()(const Acc& acc, const pg8::Unit& u, int wr, int wc, int fr, int fq) const {
        const int row0 = u.pm * 256 + wr * 64 + fr, col0 = u.pn * 128 + wc * 32 + 8 * fq;
#pragma unroll
        for (int ai = 0; ai < 2; ++ai)
#pragma unroll
            for (int m = 0; m < 4; ++m) { unsigned char* rowp = H + (size_t)(row0 + ai * 128 + m * 16) * ldh + col0;
                float h[8];
#pragma unroll
                for (int n = 0; n < 2; ++n)
#pragma unroll
                    for (int j = 0; j < 4; ++j) h[n * 4 + j] = siluf(acc[ai][0][m][n][j]) * acc[ai][1][m][n][j];
                int x0 = 0, x1 = 0;
                x0 = __builtin_amdgcn_cvt_pk_fp8_f32(h[0], h[1], x0, false); x0 = __builtin_amdgcn_cvt_pk_fp8_f32(h[2], h[3], x0, true);
                x1 = __builtin_amdgcn_cvt_pk_fp8_f32(h[4], h[5], x1, false); x1 = __builtin_amdgcn_cvt_pk_fp8_f32(h[6], h[7], x1, true);
                *(u32x2*)rowp = (u32x2){(unsigned)x0, (unsigned)x1}; }
    }
};
__device__ __forceinline__ void moe_tab_init(const int wv, LAS int* tab, const unsigned* cnt, int nN) {
    if (my_tid(wv) == 0) { int tb = 0, hr = 0;
        for (int e = 0; e < NE; ++e) { const int n = (int)cnt[64 * e], r = (n + 255) >> 8; tab[e] = tb; tab[16 + e] = hr; tab[32 + e] = r; tab[48 + e] = n; tb += r * nN; hr += r; }
        tab[8] = tb; tab[24] = hr; }
    __syncthreads();
}
template <bool GATHER_> struct MoeOrder {
    static constexpr bool GATHER = GATHER_; static constexpr int gather = GATHER_ ? 1 : 0;
    const char* A; const char* Bt; size_t a_mstep, b_estep, b_nstep; const LAS int* tab; const LAS int* rows; int nN, G, c;
    __device__ __forceinline__ bool next(int i, pg8::Unit& u) const {
        const int nwg = __builtin_amdgcn_readfirstlane(tab[8]); const long L = (long)i * G + c; if (L >= nwg || i >= MOE_MAXU) return false;
        int wgid = (int)L; { const int q = nwg / 8, r = nwg % 8, xcd = wgid % 8, off = wgid / 8; wgid = (xcd < r ? xcd * (q + 1) : r * (q + 1) + (xcd - r) * q) + off; }
        int e = 0;
#pragma unroll
        for (int k = 1; k < NE; ++k) e += (wgid >= tab[k]) ? 1 : 0;
        e = __builtin_amdgcn_readfirstlane(e);
        const int loc = wgid - __builtin_amdgcn_readfirstlane(tab[e]), nM = __builtin_amdgcn_readfirstlane(tab[32 + e]);
        const int nig = 8 * nN, gid = loc / nig, fm = gid * 8, gsz = (nM - fm) < 8 ? (nM - fm) : 8;
        u.pml = fm + ((loc % nig) % gsz); u.pn = (loc % nig) / gsz; u.e = e; u.pm = __builtin_amdgcn_readfirstlane(tab[16 + e]) + u.pml;
        u.a = gather ? A : A + (size_t)u.pm * a_mstep; u.b = Bt + (size_t)e * b_estep + (size_t)u.pn * b_nstep; return true;
    }
    __device__ __forceinline__ void a_off(int ui, const pg8::Unit&, int tid, int lda, unsigned (&v)[4]) const {
#pragma unroll
        for (int i = 0; i < 2; ++i) { int R, C; pg8::stage_rc(tid * 16 + i * 8192, R, C);
#pragma unroll
            for (int hh = 0; hh < 2; ++hh) { const int row = gather ? rows[ui * 256 + hh * 128 + R] : (R + hh * 128); v[hh * 2 + i] = (unsigned)(row * lda + C) * 2u; } }
    }
};
struct EpiMoeDown {
    static constexpr bool PERM = true;
    bf16_t* YD;
    __device__ __forceinline__ void operator()(const Acc& acc, const pg8::Unit& u, int wr, int wc, int fr, int fq) const {
        const int row0 = u.pm * 256 + wr * 64 + fr, col0 = u.pn * 256 + wc * 32 + 8 * fq;
#pragma unroll
        for (int ai = 0; ai < 2; ++ai)
#pragma unroll
            for (int m = 0; m < 4; ++m) { bf16_t* rowp = YD + (size_t)(row0 + ai * 128 + m * 16) * D + col0;
#pragma unroll
                for (int bj = 0; bj < 2; ++bj) { const f32x4 v0 = acc[ai][bj][m][0], v1 = acc[ai][bj][m][1];
                    u32x4 w; w.x = cvt_pk_bf16(v0[0], v0[1]); w.y = cvt_pk_bf16(v0[2], v0[3]); w.z = cvt_pk_bf16(v1[0], v1[1]); w.w = cvt_pk_bf16(v1[2], v1[3]);
                    *(u32x4*)(rowp + bj * 128) = w; } }
    }
};
__device__ __forceinline__ float wave_sum(float v) {
#pragma unroll
    for (int o = 1; o < 64; o <<= 1) v += __shfl_xor(v, o);
    return v;
}
__device__ __forceinline__ unsigned f2bf(float f) { unsigned u = __float_as_uint(f); return (u + 0x7fffu + ((u >> 16) & 1u)) >> 16; }
constexpr int NCH = 68, NUN = 8 * NCH, KQ = 320;
constexpr int G1_CUM = 0, G1_QP = 33792, G1_KI = 51200, G1_KT = 68608, G1_VT = 87040, G1_WG = 123904, G1_BG = 140288, G1_AS = G1_QP  , G1_LDS = 141312;
__device__ __forceinline__ int gla_row0(int b, int c) { return c < 4 ? ML + b * CTXL + c * 64 : b * SEQ + (c - 4) * 64; }
__device__ __forceinline__ float bflo(unsigned w) { return __uint_as_float(w << 16); }
__device__ __forceinline__ float bfhi(unsigned w) { return __uint_as_float(w & 0xffff0000u); }
__device__ __forceinline__ float wave_scan_incl(float x, int lane) {
    x += __builtin_bit_cast(float, __builtin_amdgcn_update_dpp(0, __builtin_bit_cast(int, x), 0x111, 0xf, 0xf, false));
    x += __builtin_bit_cast(float, __builtin_amdgcn_update_dpp(0, __builtin_bit_cast(int, x), 0x112, 0xf, 0xf, false));
    x += __builtin_bit_cast(float, __builtin_amdgcn_update_dpp(0, __builtin_bit_cast(int, x), 0x114, 0xf, 0xf, false));
    x += __builtin_bit_cast(float, __builtin_amdgcn_update_dpp(0, __builtin_bit_cast(int, x), 0x118, 0xf, 0xf, false));
    const float t0 = __builtin_bit_cast(float, __builtin_amdgcn_readlane(__builtin_bit_cast(int, x), 15)), t1 = __builtin_bit_cast(float, __builtin_amdgcn_readlane(__builtin_bit_cast(int, x), 31)),
                t2 = __builtin_bit_cast(float, __builtin_amdgcn_readlane(__builtin_bit_cast(int, x), 47));
    return x + (lane >= 16 ? t0 : 0.f) + (lane >= 32 ? t1 : 0.f) + (lane >= 48 ? t2 : 0.f);
}
__device__ __forceinline__ float log_sigmoid_fast(float x) { return fminf(x, 0.f) - __logf(1.f + __expf(-fabsf(x))); }

__device__ __forceinline__ void gla_g1_unit(const int wv, LAS unsigned char* lds, int un, const bf16_t* U, const float* R, const float* wg, const float* bg, bf16_t* QAF, bf16_t* BTF, bf16_t* DSF, float* DEC) {
    int tid = my_tid(wv);
    const int lane = tid & 63, wid = __builtin_amdgcn_readfirstlane(tid >> 6), fr = lane & 15, fq = lane >> 4;
    const int bh = un / NCH, c = un % NCH, b = bh >> 2, h = bh & 3;
    const int row0 = gla_row0(b, c);
    LAS float* CUM = (LAS float*)(lds + G1_CUM);
    LAS bf16_t* QP = (LAS bf16_t*)(lds + G1_QP); LAS bf16_t* KI = (LAS bf16_t*)(lds + G1_KI); LAS bf16_t* KT = (LAS bf16_t*)(lds + G1_KT);
    LAS bf16_t* VT = (LAS bf16_t*)(lds + G1_VT); LAS bf16_t* AS = (LAS bf16_t*)(lds + G1_AS);
    LAS float* WG = (LAS float*)(lds + G1_WG); LAS float* BG = (LAS float*)(lds + G1_BG);
    u32x4 qv[2], kv[2];
#pragma unroll
    for (int i = 0; i < 2; ++i) { const int dg = (tid + 512 * i) >> 6;
        qv[i] = *(const u32x4*)(U + (size_t)(row0 + lane) * INWP + C_Q + h * DK + dg * 8); kv[i] = *(const u32x4*)(U + (size_t)(row0 + lane) * INWP + C_K + h * DK + dg * 8); }
    f32x4 rq[2][4];
#pragma unroll
    for (int dr = 0; dr < 2; ++dr) { const float* rp = R + (size_t)(row0 + (dr == 0 ? lane : 63 - lane)) * 32 + dr * 16;
#pragma unroll
        for (int x = 0; x < 4; ++x) rq[dr][x] = *(const f32x4*)(rp + 4 * x); }
    { const int e0 = tid * 8, rw = e0 >> 7, d0 = e0 & 127;
      const f32x4 w0 = *(const f32x4*)(wg + (size_t)rw * 512 + h * DK + d0), w1 = *(const f32x4*)(wg + (size_t)rw * 512 + h * DK + d0 + 4);
      *(LAS f32x4*)(WG + e0) = w0; *(LAS f32x4*)(WG + e0 + 4) = w1;
      if (tid < 64) { const int b0 = tid * 4; *(LAS f32x4*)(BG + b0) = *(const f32x4*)(bg + (size_t)(b0 >> 7) * 512 + h * DK + (b0 & 127)); } }
#pragma unroll
    for (int i = 0; i < 4; ++i) { const int idx = tid + 512 * i, jg = idx >> 6, s = idx & 63;
        const u32x4 q = *(const u32x4*)(U + (size_t)(row0 + s) * INWP + C_V + h * DV + jg * 8);
        LAS bf16_t* vp = VT + (jg * 8) * 72 + s;
        vp[0] = (bf16_t)(q.x & 0xffffu); vp[72] = (bf16_t)(q.x >> 16); vp[144] = (bf16_t)(q.y & 0xffffu); vp[216] = (bf16_t)(q.y >> 16);
        vp[288] = (bf16_t)(q.z & 0xffffu); vp[360] = (bf16_t)(q.z >> 16); vp[432] = (bf16_t)(q.w & 0xffffu); vp[504] = (bf16_t)(q.w >> 16); }
    f32x4 Aacc[2]; Aacc[0] = (f32x4){0.f, 0.f, 0.f, 0.f}; Aacc[1] = (f32x4){0.f, 0.f, 0.f, 0.f};
    __syncthreads();
    for (int dir = 0; dir < 2; ++dir) {
        { const int t = dir == 0 ? lane : 63 - lane;
          const float rr[16] = {rq[dir][0].x, rq[dir][0].y, rq[dir][0].z, rq[dir][0].w, rq[dir][1].x, rq[dir][1].y, rq[dir][1].z, rq[dir][1].w, rq[dir][2].x, rq[dir][2].y, rq[dir][2].z, rq[dir][2].w, rq[dir][3].x, rq[dir][3].y, rq[dir][3].z, rq[dir][3].w};
          for (int dd = 0; dd < 16; dd += 4) { const int d = wid * 16 + dd;
              const f32x4 b4 = *(const LAS f32x4*)(BG + dir * 128 + d);
              float pre[4] = {b4.x, b4.y, b4.z, b4.w};
#pragma unroll
              for (int k = 0; k < 16; ++k) { const f32x4 w4 = *(const LAS f32x4*)(WG + (dir * 16 + k) * 128 + d); pre[0] += rr[k] * w4.x; pre[1] += rr[k] * w4.y; pre[2] += rr[k] * w4.z; pre[3] += rr[k] * w4.w; }
#pragma unroll
              for (int q = 0; q < 4; ++q) CUM[t * 132 + d + q] = wave_scan_incl(log_sigmoid_fast(pre[q]) * (1.f / 16.f), lane); } }
        __syncthreads();
        if (dir == 0) {
#pragma unroll
            for (int i = 0; i < 4; ++i) { const int idx = tid + 512 * i, j = idx >> 3, sg = idx & 7;
                *(u32x4*)(BTF + ((((size_t)un * 16 + (j >> 4)) * 10 + 8 + (sg >> 2)) * 64 + (sg & 3) * 16 + (j & 15)) * 8) = *(const LAS u32x4*)(VT + j * 72 + sg * 8); } }
        const int tl = dir == 0 ? 63 : 0;
#pragma unroll
        for (int i = 0; i < 2; ++i) { const int dg = (tid + 512 * i) >> 6, s = lane;
            const f32x4 c0 = *(const LAS f32x4*)(CUM + s * 132 + dg * 8), c1 = *(const LAS f32x4*)(CUM + s * 132 + dg * 8 + 4);
            const f32x4 l0 = *(const LAS f32x4*)(CUM + tl * 132 + dg * 8), l1 = *(const LAS f32x4*)(CUM + tl * 132 + dg * 8 + 4);
            const float qf[8] = {bflo(qv[i].x), bfhi(qv[i].x), bflo(qv[i].y), bfhi(qv[i].y), bflo(qv[i].z), bfhi(qv[i].z), bflo(qv[i].w), bfhi(qv[i].w)};
            const float kf[8] = {bflo(kv[i].x), bfhi(kv[i].x), bflo(kv[i].y), bfhi(kv[i].y), bflo(kv[i].z), bfhi(kv[i].z), bflo(kv[i].w), bfhi(kv[i].w)};
            const float cc[8] = {c0.x, c0.y, c0.z, c0.w, c1.x, c1.y, c1.z, c1.w}, cl[8] = {l0.x, l0.y, l0.z, l0.w, l1.x, l1.y, l1.z, l1.w};
            float qp[8], ki[8], ke[8];
#pragma unroll
            for (int e = 0; e < 8; ++e) { qp[e] = qf[e] * __expf(cc[e]); ki[e] = kf[e] * __expf(fminf(-cc[e], 80.f)); ke[e] = kf[e] * __expf(cl[e] - cc[e]); }
            u32x4 w; w.x = cvt_pk_bf16(qp[0], qp[1]); w.y = cvt_pk_bf16(qp[2], qp[3]); w.z = cvt_pk_bf16(qp[4], qp[5]); w.w = cvt_pk_bf16(qp[6], qp[7]);
            *(LAS u32x4*)(QP + s * 136 + dg * 8) = w;
            *(u32x4*)(QAF + ((((size_t)un * 4 + (s >> 4)) * 10 + dir * 4 + (dg >> 2)) * 64 + (dg & 3) * 16 + (s & 15)) * 8) = w;
            u32x4 w2; w2.x = cvt_pk_bf16(ki[0], ki[1]); w2.y = cvt_pk_bf16(ki[2], ki[3]); w2.z = cvt_pk_bf16(ki[4], ki[5]); w2.w = cvt_pk_bf16(ki[6], ki[7]);
            *(LAS u32x4*)(KI + s * 136 + dg * 8) = w2;
#pragma unroll
            for (int e = 0; e < 8; ++e) KT[(dg * 8 + e) * 72 + s] = (bf16_t)f2bf(ke[e]);
            if (s == tl) { float* dp = DEC + ((size_t)un * 2 + dir) * 128 + dg * 8;
                *(f32x4*)dp = (f32x4){__expf(cl[0]), __expf(cl[1]), __expf(cl[2]), __expf(cl[3])}; *(f32x4*)(dp + 4) = (f32x4){__expf(cl[4]), __expf(cl[5]), __expf(cl[6]), __expf(cl[7])}; } }
        __syncthreads();
        { const int tb = wid >> 1;
#pragma unroll
          for (int x = 0; x < 2; ++x) { const int sb = (wid & 1) * 2 + x; f32x4 a = (f32x4){0.f, 0.f, 0.f, 0.f};
#pragma unroll
              for (int ks = 0; ks < 4; ++ks) { const bf16x8 Af = *(const LAS bf16x8*)(QP + (tb * 16 + fr) * 136 + ks * 32 + fq * 8), Bf = *(const LAS bf16x8*)(KI + (sb * 16 + fr) * 136 + ks * 32 + fq * 8);
                  a = __builtin_amdgcn_mfma_f32_16x16x32_bf16(Af, Bf, a, 0, 0, 0); }
#pragma unroll
              for (int jj = 0; jj < 4; ++jj) { const int t = tb * 16 + 4 * fq + jj, sx = sb * 16 + fr; const bool keep = dir == 0 ? (sx <= t) : (sx >= t); Aacc[x][jj] += keep ? a[jj] : 0.f; } } }
#pragma unroll
        for (int jbi = 0; jbi < 2; ++jbi) { const int jb = wid * 2 + jbi;
            const bf16x8 Bf0 = *(const LAS bf16x8*)(VT + (jb * 16 + fr) * 72 + fq * 8), Bf1 = *(const LAS bf16x8*)(VT + (jb * 16 + fr) * 72 + 32 + fq * 8);
#pragma unroll
            for (int db = 0; db < 8; ++db) { const bf16x8 Af0 = *(const LAS bf16x8*)(KT + (db * 16 + fr) * 72 + fq * 8), Af1 = *(const LAS bf16x8*)(KT + (db * 16 + fr) * 72 + 32 + fq * 8);
                f32x4 a = (f32x4){0.f, 0.f, 0.f, 0.f};
                a = __builtin_amdgcn_mfma_f32_16x16x32_bf16(Af0, Bf0, a, 0, 0, 0); a = __builtin_amdgcn_mfma_f32_16x16x32_bf16(Af1, Bf1, a, 0, 0, 0);
                u32x2 w; w.x = cvt_pk_bf16(a.x, a.y); w.y = cvt_pk_bf16(a.z, a.w);
                *(u32x2*)(DSF + (((((size_t)un * 2 + dir) * 16 + jb) * 4 + (db >> 1)) * 64 + ((db & 1) * 2 + (fq >> 1)) * 16 + fr) * 8 + (fq & 1) * 4) = w; } }
        __syncthreads();
    }
    { const int tb = wid >> 1;
#pragma unroll
      for (int x = 0; x < 2; ++x) { const int sb = (wid & 1) * 2 + x;
#pragma unroll
          for (int jj = 0; jj < 4; ++jj) AS[(tb * 16 + 4 * fq + jj) * 72 + sb * 16 + fr] = (bf16_t)f2bf(Aacc[x][jj]); } }
    __syncthreads();
    { const int t = tid >> 3, sg = tid & 7;
      *(u32x4*)(QAF + ((((size_t)un * 4 + (t >> 4)) * 10 + 8 + (sg >> 2)) * 64 + (sg & 3) * 16 + (t & 15)) * 8) = *(const LAS u32x4*)(AS + t * 72 + sg * 8); }
    __syncthreads();
}
__device__ __forceinline__ void gla_g3_unit(const int wv, LAS unsigned char* lds, int un, const bf16_t* QAF, const bf16_t* BTF, const bf16_t* U, const float* gain, bf16_t* Y) {
    int tid = my_tid(wv);
    const int lane = tid & 63, wid = __builtin_amdgcn_readfirstlane(tid >> 6), fr = lane & 15, fq = lane >> 4;
    const int bh = un / NCH, c = un % NCH, b = bh >> 2, h = bh & 3, row0 = gla_row0(b, c);
    const int tb = wid & 3, jh = wid >> 2;
    const bf16_t* qa = QAF + ((size_t)un * 4 + tb) * 10 * 512 + lane * 8;
    const bf16_t* bt = BTF + ((size_t)un * 16 + jh * 8) * 10 * 512 + lane * 8;
    f32x4 acc[8];
#pragma unroll
    for (int jb = 0; jb < 8; ++jb) acc[jb] = (f32x4){0.f, 0.f, 0.f, 0.f};
    bf16x8 Bc = *(const bf16x8*)qa, Ac[8];
#pragma unroll
    for (int jb = 0; jb < 8; ++jb) Ac[jb] = *(const bf16x8*)(bt + (size_t)jb * 10 * 512);
#pragma unroll
    for (int ks = 0; ks < 10; ++ks) {
        bf16x8 Bn = Bc, An[8];
#pragma unroll
        for (int jb = 0; jb < 8; ++jb) An[jb] = Ac[jb];
        if (ks < 9) { Bn = *(const bf16x8*)(qa + (ks + 1) * 512);
#pragma unroll
            for (int jb = 0; jb < 8; ++jb) An[jb] = *(const bf16x8*)(bt + ((size_t)jb * 10 + ks + 1) * 512); }
#pragma unroll
        for (int jb = 0; jb < 8; ++jb) acc[jb] = __builtin_amdgcn_mfma_f32_16x16x32_bf16(Ac[jb], Bc, acc[jb], 0, 0, 0);
        Bc = Bn;
#pragma unroll
        for (int jb = 0; jb < 8; ++jb) Ac[jb] = An[jb];
    }
    float ss = 0.f;
#pragma unroll
    for (int jb = 0; jb < 8; ++jb) ss += (acc[jb].x * acc[jb].x + acc[jb].y * acc[jb].y) + (acc[jb].z * acc[jb].z + acc[jb].w * acc[jb].w);
    ss += __shfl_xor(ss, 16); ss += __shfl_xor(ss, 32);
    LAS float* P = (LAS float*)lds;
    if (fq == 0) P[wid * 16 + fr] = ss;
    __syncthreads();
    const float tot = P[wid * 16 + fr] + P[(wid ^ 4) * 16 + fr];
    const float rstd = 1.0f / sqrtf(tot * (1.f / DV) + EPS);
    const int row = row0 + tb * 16 + fr;
#pragma unroll
    for (int jb = 0; jb < 8; ++jb) { const int col = h * DV + jh * 128 + jb * 16 + 4 * fq;
        const f32x4 gn = *(const f32x4*)(gain + col); const u32x2 gw = *(const u32x2*)(U + (size_t)row * INWP + C_G + col);
        const f32x4 o = acc[jb] * rstd * gn;
        u32x2 w; w.x = cvt_pk_bf16(o.x * siluf(bflo(gw.x)), o.y * siluf(bfhi(gw.x))); w.y = cvt_pk_bf16(o.z * siluf(bflo(gw.y)), o.w * siluf(bfhi(gw.y)));
        *(u32x2*)(Y + (size_t)row * D + col) = w; }
    __syncthreads();
}

__device__ __forceinline__ const void* ldptr(volatile LAS unsigned long long* tab, int i) {
    const unsigned long long v = tab[i];
    const unsigned lo = __builtin_amdgcn_readfirstlane((unsigned)v), hi = __builtin_amdgcn_readfirstlane((unsigned)(v >> 32));
    return (const void*)(((unsigned long long)hi << 32) | lo);
}
constexpr int CVT_TILE_F = 128 * 33;
__device__ __forceinline__ void cvt_item(LAS float* t, int lane, const float* srcb, bf16_t* dstb, size_t sms, size_t dms, int K, int N, int nb, int rs, int off, int ktiles, int per, int it) {
    const int lr = lane >> 4, lc = (lane & 15) * 4;
    const int sr = lane >> 3, sk = (lane & 7) * 8;
    const int mat = it / per, r = it % per, nt = r / ktiles, kt = r % ktiles, k0 = kt * 64, n0 = nt * 64;
    const float* src = srcb + (size_t)mat * sms + (size_t)(k0 + lr) * N + n0 + lc;
    const bool inb = (n0 + lc) < N;
    f32x4 v[16];
#pragma unroll
    for (int i = 0; i < 16; ++i) v[i] = inb ? __builtin_nontemporal_load((const f32x4*)(src + (size_t)(4 * i) * N)) : (f32x4){0.f, 0.f, 0.f, 0.f};
#pragma unroll
    for (int i = 0; i < 16; ++i) { LAS float* tp = t + (lr + 4 * i) * 65 + lc; tp[0] = v[i].x; tp[1] = v[i].y; tp[2] = v[i].z; tp[3] = v[i].w; }
    asm volatile("s_waitcnt lgkmcnt(0)" ::: "memory");
    bf16_t* dst = dstb + (size_t)mat * dms;
#pragma unroll
    for (int p = 0; p < 8; ++p) { const int nn = sr + 8 * p, n = n0 + nn; const int drow = (n / nb) * rs + (n % nb) + off;
        const LAS float* tp = t + sk * 65 + nn;
        u32x4 w; w.x = cvt_pk_bf16(tp[0], tp[65]); w.y = cvt_pk_bf16(tp[2 * 65], tp[3 * 65]); w.z = cvt_pk_bf16(tp[4 * 65], tp[5 * 65]); w.w = cvt_pk_bf16(tp[6 * 65], tp[7 * 65]);
        __builtin_nontemporal_store(w, (u32x4*)(dst + (size_t)drow * K + k0 + sk)); }
    asm volatile("s_waitcnt lgkmcnt(0)" ::: "memory");
}
__device__ __forceinline__ void p_convert(const int wv, LAS unsigned char* lds, const float* srcb, bf16_t* dstb, size_t sms, size_t dms, int K, int N, int NP, int nb, int rs, int off, int nmat) {
    int tid = my_tid(wv);
    const int lane = tid & 63, wave = tid >> 6;
    LAS float* t = (LAS float*)lds + wave * CVT_TILE_F;
    const int ktiles = K / 64, ntiles = NP / 64, per = ktiles * ntiles, total = per * nmat;
    for (int it = blockIdx.x * 8 + wave; it < total; it += gridDim.x * 8) cvt_item(t, lane, srcb, dstb, sms, dms, K, N, nb, rs, off, ktiles, per, it);
}
__device__ __forceinline__ void cvt8_item(LAS float* t, int lane, const float* srcb, unsigned char* dstb, size_t sms, size_t dms, int K, int N, int nb, int rs, int off, int ktiles, int per, int it) {
    const int lr = lane >> 3, lc = (lane & 7) * 4;
    const int sr = lane >> 3, sk = (lane & 7) * 16;
    const int mat = it / per, r = it % per, nt = r / ktiles, kt = r % ktiles, k0 = kt * 128, n0 = nt * 32;
    const float* src = srcb + (size_t)mat * sms + (size_t)(k0 + lr) * N + n0 + lc;
    f32x4 v[16];
#pragma unroll
    for (int i = 0; i < 16; ++i) v[i] = __builtin_nontemporal_load((const f32x4*)(src + (size_t)(8 * i) * N));
#pragma unroll
    for (int i = 0; i < 16; ++i) { LAS float* tp = t + (lr + 8 * i) * 33 + lc; tp[0] = v[i].x * 64.f; tp[1] = v[i].y * 64.f; tp[2] = v[i].z * 64.f; tp[3] = v[i].w * 64.f; }
    asm volatile("s_waitcnt lgkmcnt(0)" ::: "memory");
    unsigned char* dst = dstb + (size_t)mat * dms;
#pragma unroll
    for (int p = 0; p < 4; ++p) { const int nn = sr + 8 * p, n = n0 + nn; const int drow = (n / nb) * rs + (n % nb) + off;
        const LAS float* tp = t + sk * 33 + nn;
        unsigned w[4];
#pragma unroll
        for (int q = 0; q < 4; ++q) { int x = 0; x = __builtin_amdgcn_cvt_pk_fp8_f32(tp[(4 * q) * 33], tp[(4 * q + 1) * 33], x, false); x = __builtin_amdgcn_cvt_pk_fp8_f32(tp[(4 * q + 2) * 33], tp[(4 * q + 3) * 33], x, true); w[q] = (unsigned)x; }
        __builtin_nontemporal_store((u32x4){w[0], w[1], w[2], w[3]}, (u32x4*)(dst + (size_t)drow * K + k0 + sk)); }
    asm volatile("s_waitcnt lgkmcnt(0)" ::: "memory");
}
constexpr int CW_Q = 2048, CW_DONE = 2112;
constexpr int QJ_WOUT = (D / 64) * (D / 64), QJ_F13 = (D / 64) * (DFF / 64), QJ_WIN = (D / 64) * (INWP / 64), QJ_MOE = NE * QJ_F13;
constexpr int Q_WOUT0 = QJ_WOUT, Q_F3 = Q_WOUT0 + 2 * QJ_F13, Q_F2 = Q_F3 + QJ_F13, Q_WIN1 = Q_F2 + QJ_WIN, Q_WOUT1 = Q_WIN1 + QJ_WOUT, Q_ALL = Q_WOUT1 + 3 * QJ_MOE;
__device__ __forceinline__ void q_item(LAS float* t, int lane, int item, volatile LAS unsigned long long* PT) {
    unsigned char* ws = (unsigned char*)ldptr(PT, 25);
    const float* src; bf16_t* dst; size_t sms = 0, dms = 0; int K = D, N = D, NP = D, nb = 1 << 30, rs = 0, off = 0, it = item;
    if (item < Q_WOUT0) { src = (const float*)ldptr(PT, 14); dst = (bf16_t*)(ws + WS_WOUT); }
    else if (item < Q_F3) { const int j = (item - Q_WOUT0) / QJ_F13; it = item - Q_WOUT0 - j * QJ_F13; src = (const float*)ldptr(PT, 15 + j); dst = (bf16_t*)(ws + WS_W13); N = DFF; NP = DFF; nb = 128; rs = 256; off = j * 128; }
    else if (item < Q_F2) { it = item - Q_F3; cvt8_item(t, lane, (const float*)ldptr(PT, 17), ws + WS_W2, 0, 0, DFF, D, 1 << 30, 0, 0, DFF / 128, (DFF / 128) * (D / 32), it); return; }
    else if (item < Q_WIN1) { it = item - Q_F2; src = (const float*)ldptr(PT, 8) + (size_t)D * INW; dst = (bf16_t*)(ws + WS_WIN) + (size_t)INWP * D; N = INW; NP = INWP; }
    else if (item < Q_WOUT1) { it = item - Q_WIN1; src = (const float*)ldptr(PT, 14) + (size_t)D * D; dst = (bf16_t*)(ws + WS_WOUT) + (size_t)D * D; }
    else { const int j = (item - Q_WOUT1) / QJ_MOE; it = item - Q_WOUT1 - j * QJ_MOE; src = (const float*)ldptr(PT, 20 + j); sms = (size_t)D * DFF;
        if (j < 2) { cvt8_item(t, lane, src, ws + WS_MW13, sms, (size_t)2 * DFF * D, D, DFF, 128, 256, j * 128, D / 128, (D / 128) * (DFF / 32), it); return; }
        cvt8_item(t, lane, src, ws + WS_MW2, sms, (size_t)D * DFF, DFF, D, 1 << 30, 0, 0, DFF / 128, (DFF / 128) * (D / 32), it); return; }
    cvt_item(t, lane, src, dst, sms, dms, K, N, nb, rs, off, K / 64, (K / 64) * (NP / 64), it);
}
__device__ __forceinline__ void q_help(const int wv, LAS unsigned char* lds, volatile LAS unsigned long long* PT, int phase, int LIMIT, int qoff = 0) {
    int tid = my_tid(wv);
    const int lane = tid & 63, wave = __builtin_amdgcn_readfirstlane(tid >> 6);
    LAS float* t = (LAS float*)lds + wave * CVT_TILE_F;
    volatile LAS unsigned* MISC = (volatile LAS unsigned*)(lds + LDS_MISC);
    unsigned* ctl = (unsigned*)((unsigned char*)ldptr(PT, 25) + WS_CTL);
    const unsigned G = gridDim.x;
    const unsigned per_wave = LIMIT < 0 ? 1u : 6u;
    __syncthreads();
    if (LIMIT < 0 && tid == 0) (void)__hip_atomic_fetch_add(ctl + CW_DONE + 64 * phase, 1u, __ATOMIC_RELAXED, __HIP_MEMORY_SCOPE_AGENT);
    for (;;) {
        if (tid == 0) { unsigned base = 0xffffffffu;
            const bool pull = LIMIT < 0 ? __hip_atomic_load(ctl + CW_DONE + 64 * phase, __ATOMIC_RELAXED, __HIP_MEMORY_SCOPE_AGENT) < G
                                        : __hip_atomic_load(ctl + CW_Q + qoff, __ATOMIC_RELAXED, __HIP_MEMORY_SCOPE_AGENT) < (unsigned)LIMIT;
            if (pull) base = __hip_atomic_fetch_add(ctl + CW_Q + qoff, 8u * per_wave, __ATOMIC_RELAXED, __HIP_MEMORY_SCOPE_AGENT);
            MISC[4] = base; }
        __syncthreads();
        const unsigned base = MISC[4];
        __syncthreads();
        if (base == 0xffffffffu) break;
#pragma unroll 1
        for (unsigned k = 0; k < per_wave; ++k) { const unsigned item = base + 8u * k + wave; if (item < (unsigned)Q_ALL) q_item(t, lane, (int)item, PT); }
        if (base >= (unsigned)Q_ALL) break;
    }
}
__device__ __forceinline__ void p_ada(const int wv, LAS unsigned char* lds, const float* c, const float* c_ctx, const float* w_ada, const float* b_ada, float* modv) {
    int tid = my_tid(wv);
    LAS float* scv = (LAS float*)lds; LAS float* red = scv + 3 * D;
    for (int i = tid; i < 3 * D; i += 512) { const int r = i / D, k = i % D; const float v = r < 2 ? c[r * D + k] : c_ctx[k]; scv[i] = v / (1.f + expf(-v)); }
    __syncthreads();
    for (int cb = blockIdx.x; cb < 2 * MODW / 96; cb += gridDim.x) {
        const int colg = cb * 96, l = colg / MODW, n0 = colg % MODW;
        if (tid < 504) { const int kg = tid / 24, c4 = tid % 24;
            f32x4 a0 = (f32x4){0.f, 0.f, 0.f, 0.f}, a1 = a0, a2 = a0;
            const float* w = w_ada + (size_t)l * D * MODW + n0 + c4 * 4;
            for (int i0 = 0; i0 < 98; i0 += 14) {
                f32x4 wv[14];
#pragma unroll
                for (int i = 0; i < 14; ++i) { const int k = kg + 21 * (i0 + i), kc = k < D ? k : D - 1; wv[i] = __builtin_nontemporal_load((const f32x4*)(w + (size_t)kc * MODW)); }
#pragma unroll
                for (int i = 0; i < 14; ++i) { const int k = kg + 21 * (i0 + i); const bool ok = k < D; const int kc = ok ? k : D - 1;
                    const float s0 = ok ? scv[kc] : 0.f, s1 = ok ? scv[D + kc] : 0.f, s2 = ok ? scv[2 * D + kc] : 0.f; a0 += wv[i] * s0; a1 += wv[i] * s1; a2 += wv[i] * s2; }
            }
            *(LAS f32x4*)(red + kg * 288 + c4 * 4) = a0; *(LAS f32x4*)(red + kg * 288 + 96 + c4 * 4) = a1; *(LAS f32x4*)(red + kg * 288 + 192 + c4 * 4) = a2; }
        __syncthreads();
        if (tid < 288) { const int r = tid / 96, cl = tid % 96; float sacc = 0.f;
#pragma unroll
            for (int kg = 0; kg < 21; ++kg) sacc += red[kg * 288 + tid];
            modv[((size_t)l * 3 + r) * MODW + n0 + cl] = sacc + b_ada[l * MODW + n0 + cl]; }
        __syncthreads();
    }
}
template <bool OUT8> __device__ __forceinline__ void p_ln(const int wv, const float* src_lat, const float* src_ctx, int ctx_row0, const float* gn, const float* sh, const float* sc, bf16_t* XN, int nrows) {
    int tz = my_tid(wv);
    const int lane = tz & 63, gw = blockIdx.x * 8 + (tz >> 6), NGW = gridDim.x * 8;
    for (int row = gw; row < nrows; row += NGW) {
        const float* x = row < ML ? src_lat + (size_t)row * D : src_ctx + (size_t)(row - ctx_row0) * D;
        const int mi = mod_index(row);
        f32x4 v[8]; float s = 0.f;
#pragma unroll
        for (int j = 0; j < 8; ++j) { v[j] = *(const f32x4*)(x + 4 * lane + 256 * j); s += (v[j].x * v[j].x + v[j].y * v[j].y) + (v[j].z * v[j].z + v[j].w * v[j].w); }
        const float rstd = 1.0f / sqrtf(wave_sum(s) * (1.f / D) + EPS);
#pragma unroll
        for (int j = 0; j < 8; ++j) { const int cc = 4 * lane + 256 * j;
            const f32x4 g = *(const f32x4*)(gn + cc), a = *(const f32x4*)(sc + (size_t)mi * MODW + cc), b = *(const f32x4*)(sh + (size_t)mi * MODW + cc);
            const f32x4 h = v[j] * rstd * g * (a + 1.0f) + b;
            if constexpr (OUT8) { int x = 0; x = __builtin_amdgcn_cvt_pk_fp8_f32(h.x, h.y, x, false); x = __builtin_amdgcn_cvt_pk_fp8_f32(h.z, h.w, x, true); *(unsigned*)((unsigned char*)XN + (size_t)row * D + cc) = (unsigned)x; }
            else { u32x2 w; w.x = cvt_pk_bf16(h.x, h.y); w.y = cvt_pk_bf16(h.z, h.w); *(u32x2*)(XN + (size_t)row * D + cc) = w; } }
    }
}
__device__ __forceinline__ void p_gla_g2(const int wv, const bf16_t* DSF, const float* DEC, bf16_t* BTF) {
    int tz = my_tid(wv);
    for (int gi = blockIdx.x * 512 + tz; gi < 16 * 16 * 4 * 128; gi += gridDim.x * 512) {
        const int sl = gi & 127, kd = (gi >> 7) & 3, jb = (gi >> 9) & 15, chain = gi >> 13, dir = chain & 1, bh = chain >> 1;
        const int d = kd * 32 + (sl >> 5) * 8 + (sl & 1) * 4;
        f32x4 S = (f32x4){0.f, 0.f, 0.f, 0.f};
        for (int s0 = 0; s0 < NCH; s0 += 17) {
            f32x4 dec[17]; u32x2 q[17];
#pragma unroll
            for (int i = 0; i < 17; ++i) { const int step = s0 + i, c = dir == 0 ? step : (step < 4 ? 3 - step : 71 - step), un = bh * NCH + c;
                dec[i] = *(const f32x4*)(DEC + ((size_t)un * 2 + dir) * 128 + d);
                q[i] = __builtin_nontemporal_load((const u32x2*)(DSF + ((((size_t)un * 2 + dir) * 16 + jb) * 4 + kd) * 512 + sl * 4)); }
#pragma unroll
            for (int i = 0; i < 17; ++i) { const int step = s0 + i, c = dir == 0 ? step : (step < 4 ? 3 - step : 71 - step), un = bh * NCH + c;
                u32x2 w; w.x = cvt_pk_bf16(S.x, S.y); w.y = cvt_pk_bf16(S.z, S.w);
                *(u32x2*)(BTF + (((size_t)un * 16 + jb) * 10 + dir * 4 + kd) * 512 + sl * 4) = w;
                S = dec[i] * S + (f32x4){bflo(q[i].x), bfhi(q[i].x), bflo(q[i].y), bfhi(q[i].y)}; }
        }
    }
}
template <int W> __device__ __forceinline__ void pool_item(const bf16_t* U, bf16_t* MIX, int row, int ch) {
    int L, j, base;
    if (row < ML) { L = 64; j = row & 63; base = row - j; } else { L = CTXL; j = (row - ML) & (CTXL - 1); base = row - j; }
    const bf16_t* up = U + (size_t)base * INWP + C_P + ch;
    u32x4 q[W];
#pragma unroll
    for (int p = 0; p < W; ++p) { const int r = j - W / 2 + p; const bool ok = r >= 0 && r < L; q[p] = ok ? *(const u32x4*)(up + (size_t)r * INWP) : (u32x4){0u, 0u, 0u, 0u}; }
    float s[8];
#pragma unroll
    for (int i = 0; i < 8; ++i) s[i] = 0.f;
#pragma unroll
    for (int p = 0; p < W; ++p) { s[0] += bflo(q[p].x); s[1] += bfhi(q[p].x); s[2] += bflo(q[p].y); s[3] += bfhi(q[p].y); s[4] += bflo(q[p].z); s[5] += bfhi(q[p].z); s[6] += bflo(q[p].w); s[7] += bfhi(q[p].w); }
    int lo = j - W / 2, hi = lo + W; lo = lo < 0 ? 0 : lo; hi = hi > L ? L : hi;
    const u32x4 me = q[W / 2];
    const float inv = 1.f / (float)(hi - lo);
    u32x4 o; o.x = cvt_pk_bf16(s[0] * inv - bflo(me.x), s[1] * inv - bfhi(me.x)); o.y = cvt_pk_bf16(s[2] * inv - bflo(me.y), s[3] * inv - bfhi(me.y));
    o.z = cvt_pk_bf16(s[4] * inv - bflo(me.z), s[5] * inv - bfhi(me.z)); o.w = cvt_pk_bf16(s[6] * inv - bflo(me.w), s[7] * inv - bfhi(me.w));
    *(u32x4*)(MIX + (size_t)row * 1024 + ch) = o;
}
__device__ __forceinline__ void p_pool(const int wv, const bf16_t* U, bf16_t* MIX, int nrows) {
    int tz = my_tid(wv);
    const int per = nrows * 32;
    for (int gi = blockIdx.x * 512 + tz; gi < per; gi += gridDim.x * 512) { const int row = gi >> 5, cb = (gi & 31) * 8;
        pool_item<2>(U, MIX, row, cb); pool_item<4>(U, MIX, row, 256 + cb); pool_item<8>(U, MIX, row, 512 + cb); pool_item<16>(U, MIX, row, 768 + cb); }
}
__device__ __forceinline__ void p_router(const int wv, const float* XR, const float* gn, const float* sh, const float* sc, const float* w_r, const float* b_r, unsigned* cnt, int* list, float* gep, int* slot, unsigned char* XN8) {
    int tz = my_tid(wv);
    const int lane = tz & 63, gw = blockIdx.x * 8 + (tz >> 6), NGW = gridDim.x * 8;
    for (int row = gw; row < ML; row += NGW) {
        const float* x = XR + (size_t)row * D; const int mi = mod_index(row);
        float s = 0.f;
#pragma unroll
        for (int j = 0; j < 8; ++j) { const f32x4 v = *(const f32x4*)(x + 4 * lane + 256 * j); s += (v.x * v.x + v.y * v.y) + (v.z * v.z + v.w * v.w); }
        const float rstd = 1.0f / sqrtf(wave_sum(s) * (1.f / D) + EPS);
        float lg0 = 0.f, lg1 = 0.f, lg2 = 0.f, lg3 = 0.f, lg4 = 0.f, lg5 = 0.f, lg6 = 0.f, lg7 = 0.f;
#pragma unroll 1
        for (int j = 0; j < 8; ++j) { const int cc = 4 * lane + 256 * j;
            const f32x4 v = *(const f32x4*)(x + cc), g = *(const f32x4*)(gn + cc), a = *(const f32x4*)(sc + (size_t)mi * MODW + cc), b = *(const f32x4*)(sh + (size_t)mi * MODW + cc);
            const f32x4 h = v * rstd * g * (a + 1.0f) + b;
            { int x8 = 0; x8 = __builtin_amdgcn_cvt_pk_fp8_f32(h.x, h.y, x8, false); x8 = __builtin_amdgcn_cvt_pk_fp8_f32(h.z, h.w, x8, true); *(unsigned*)(XN8 + (size_t)row * D + cc) = (unsigned)x8; }
            const float* wp = w_r + (size_t)cc * 8;
#pragma unroll
            for (int i = 0; i < 4; ++i) { const f32x4 w0 = *(const f32x4*)(wp + i * 8), w1 = *(const f32x4*)(wp + i * 8 + 4);
                lg0 += h[i] * w0.x; lg1 += h[i] * w0.y; lg2 += h[i] * w0.z; lg3 += h[i] * w0.w; lg4 += h[i] * w1.x; lg5 += h[i] * w1.y; lg6 += h[i] * w1.z; lg7 += h[i] * w1.w; } }
        float lg[8] = {lg0, lg1, lg2, lg3, lg4, lg5, lg6, lg7};
#pragma unroll
        for (int e = 0; e < 8; ++e) lg[e] = wave_sum(lg[e]) + b_r[e];
        int i0 = 0; float m0 = lg[0];
#pragma unroll
        for (int e = 1; e < 8; ++e) if (lg[e] > m0) { m0 = lg[e]; i0 = e; }
        int i1 = -1; float m1 = -3.0e38f;
#pragma unroll
        for (int e = 0; e < 8; ++e) if (e != i0 && lg[e] > m1) { m1 = lg[e]; i1 = e; }
        const float p1 = expf(m1 - m0), g0 = 1.f / (1.f + p1), g1 = p1 / (1.f + p1);
        if (lane == 0) {
            const unsigned q0 = atomicAdd(cnt + 64 * i0, 1u), q1 = atomicAdd(cnt + 64 * i1, 1u);
            list[(size_t)i0 * 8192 + q0] = row; list[(size_t)i1 * 8192 + q1] = row; gep[(size_t)i0 * 8192 + q0] = g0; gep[(size_t)i1 * 8192 + q1] = g1;
            slot[row * 2] = i0 * 8192 + (int)q0; slot[row * 2 + 1] = i1 * 8192 + (int)q1; }
    }
}
__device__ __forceinline__ void p_final(const int wv, const float* XR, const bf16_t* YD, const int* slot, const float* gep, const unsigned* cnt, const float* g2, const float* gn, float* out) {
    int tz = my_tid(wv);
    const int lane = tz & 63, gw = blockIdx.x * 8 + (tz >> 6), NGW = gridDim.x * 8;
    for (int row = gw; row < ML; row += NGW) {
        const float* x = XR + (size_t)row * D; const int mi = mod_index(row);
        const int s0 = slot[row * 2], s1 = slot[row * 2 + 1], e0 = s0 >> 13, e1 = s1 >> 13;
        const float ga = gep[s0], gb = gep[s1];
        int h0 = 0, h1 = 0;
#pragma unroll
        for (int e = 0; e < NE; ++e) { const int r = ((int)cnt[64 * e] + 255) >> 8; h0 += e < e0 ? r : 0; h1 += e < e1 ? r : 0; }
        const bf16_t* y0 = YD + ((size_t)h0 * 256 + (s0 & 8191)) * D; const bf16_t* y1 = YD + ((size_t)h1 * 256 + (s1 & 8191)) * D;
        f32x4 v[8]; float s = 0.f;
#pragma unroll
        for (int j = 0; j < 8; ++j) { const int cc = 4 * lane + 256 * j; const u32x2 a = *(const u32x2*)(y0 + cc), b = *(const u32x2*)(y1 + cc);
            const f32x4 ya = (f32x4){ga * bflo(a.x) + gb * bflo(b.x), ga * bfhi(a.x) + gb * bfhi(b.x), ga * bflo(a.y) + gb * bflo(b.y), ga * bfhi(a.y) + gb * bfhi(b.y)};
            v[j] = *(const f32x4*)(x + cc) + *(const f32x4*)(g2 + (size_t)mi * MODW + cc) * ya;
            s += (v[j].x * v[j].x + v[j].y * v[j].y) + (v[j].z * v[j].z + v[j].w * v[j].w); }
        const float rstd = 1.0f / sqrtf(wave_sum(s) * (1.f / D) + EPS);
#pragma unroll
        for (int j = 0; j < 8; ++j) { const int cc = 4 * lane + 256 * j; *(f32x4*)(out + (size_t)row * D + cc) = v[j] * rstd * *(const f32x4*)(gn + cc); }
    }
}

#define XB_TMO      128
#define XB_XCNT(j)  (256  + 64 * (j))
#define XB_XSUB(j)  (1280 + 64 * (j))
#define XB_XGEN(j)  (2304 + 64 * (j))
#define XB_TOP      3328
#define XB_TOPGEN   3392
#define XCD_BAR_WORDS 3456
#define XB_SPIN_CAP (1u << 18)

__device__ __forceinline__ unsigned xb_ld(unsigned* p)              { return __hip_atomic_load(p, __ATOMIC_RELAXED, __HIP_MEMORY_SCOPE_AGENT); }
__device__ __forceinline__ unsigned xb_add(unsigned* p, unsigned v) { return __hip_atomic_fetch_add(p, v, __ATOMIC_RELAXED, __HIP_MEMORY_SCOPE_AGENT); }
__device__ __forceinline__ unsigned xb_xcc_id() { return (unsigned)__builtin_amdgcn_s_getreg((3 << 11) | 20) & 0xFu; }
#define XB_SPIN(cond, bar) do { unsigned _sp = 0; while (cond) { __builtin_amdgcn_s_sleep(1); \
    if ((++_sp & 255u) == 0u) { if (xb_ld(&(bar)[XB_TMO])) break; if (_sp > XB_SPIN_CAP) { atomicAdd(&(bar)[XB_TMO], 1u); break; } } } } while (0)

struct XcdBarrier {
    unsigned* bar; unsigned x;
    volatile LAS unsigned* st;
};

__device__ __forceinline__ XcdBarrier xcd_barrier_post(unsigned* bar, volatile LAS unsigned* st) {
    XcdBarrier b; b.bar = bar; b.x = xb_xcc_id(); b.st = st;
    if (threadIdx.x == 0) (void)xb_add(&bar[XB_XCNT(b.x)], 1u);
    return b;
}
__device__ __forceinline__ void xcd_barrier_complete(unsigned* bar, unsigned x, unsigned& nloc, unsigned& nx) {
    const unsigned G = gridDim.x * gridDim.y * gridDim.z;
    unsigned sum, cnt, mine, sp = 0u;
    for (;;) {
        sum = 0u; cnt = 0u; mine = 0u;
#pragma unroll
        for (unsigned j = 0; j < 16; ++j) { const unsigned c = xb_ld(&bar[XB_XCNT(j)]); sum += c; cnt += (c > 0u) ? 1u : 0u; mine = (j == x) ? c : mine; }
        if (sum == G) break;
        __builtin_amdgcn_s_sleep(1);
        if ((++sp & 255u) == 0u) { if (xb_ld(&bar[XB_TMO])) break; if (sp > XB_SPIN_CAP) { atomicAdd(&bar[XB_TMO], 1u); break; } }
    }
    nloc = mine > 0u ? mine : 1u; nx = cnt > 0u ? cnt : 1u;
}

__device__ __forceinline__ void xcd_barrier(const XcdBarrier& b, const int wv) {
    asm volatile("s_waitcnt vmcnt(0)" ::: "memory");
    __syncthreads();
    if (my_tid(wv) == 0) {
        unsigned* bar = b.bar;
        __builtin_amdgcn_s_waitcnt(0);
        unsigned nloc = b.st[0], nx = b.st[1];
        if (nloc == 0u) { xcd_barrier_complete(bar, b.x, nloc, nx); b.st[0] = nloc; b.st[1] = nx; }
        const unsigned old = xb_add(&bar[XB_XSUB(b.x)], 1u);
        const unsigned gen = old / nloc;
        if (old + 1u == (gen + 1u) * nloc) {
            __builtin_amdgcn_fence(__ATOMIC_RELEASE, "agent");
            asm volatile("s_waitcnt vmcnt(0)" ::: "memory");
            const unsigned og = xb_add(&bar[XB_TOP], 1u);
            const unsigned tg = og / nx;
            if (og + 1u == (tg + 1u) * nx) xb_add(&bar[XB_TOPGEN], 1u);
            else XB_SPIN(xb_ld(&bar[XB_TOPGEN]) == tg, bar);
            __builtin_amdgcn_fence(__ATOMIC_ACQUIRE, "agent");
            xb_add(&bar[XB_XGEN(b.x)], 1u);
            asm volatile("s_waitcnt vmcnt(0)" ::: "memory");
        } else {
            XB_SPIN(xb_ld(&bar[XB_XGEN(b.x)]) == gen, bar);
            __builtin_amdgcn_fence(__ATOMIC_ACQUIRE, "agent");
            asm volatile("s_waitcnt vmcnt(0)" ::: "memory");
        }
    }
    __syncthreads();
}

constexpr int CW_BAR = 4096;
constexpr int LDS_BYTES = LDS_MISC + 64 + 256;
static_assert(MOE_LDS <= LDS_MISC && G1_LDS <= LDS_MISC, "LDS map");
#ifndef MK_PER_PHASE
#define MK_PER_PHASE 0
#endif
constexpr int NPHASE = 20;

#define RUN(p) (lo <= (p) && (p) < hi)
#define SEAM(p) do { if (RUN(p) && RUN((p) + 1)) xcd_barrier(bar, wv); } while (0)
#define PTR(i) ((const float*)ldptr(PT, (i)))
#define WSP ((unsigned char*)ldptr(PT, 25))
#define HELP(ph) q_help(wv, lds, PT, (ph), -1)
#define DRAINQ(n) q_help(wv, lds, PT, 0, (n))
template <int l> __device__ __forceinline__ void layer_phases(const int wv, LAS unsigned char* lds, volatile LAS unsigned long long* PT, const int lo, const int hi, const XcdBarrier& bar, const int G, const int blk) {
        const int pb = 1 + 9 * l;
        const int ctx_row0 = l == 0 ? ML : 0;
        const int nMo = (l == 0) ? MA / 256 : ML / 256;
        if (RUN(pb + 0)) { unsigned char* ws = WSP; const float* modv_l = (const float*)(ws + WS_MODV) + (size_t)l * 3 * MODW; const float* XRc = (const float*)(ws + WS_XR);
            p_ln<false>(wv, l == 0 ? PTR(0) : XRc, l == 0 ? PTR(2) : XRc, ctx_row0, PTR(6) + l * D, modv_l + 0, modv_l + D, (bf16_t*)(ws + WS_XN), MA);
            if constexpr (l == 1) DRAINQ(Q_WIN1); }
        SEAM(pb + 0);
        if (RUN(pb + 1)) { unsigned char* ws = WSP;
            pg8::TileOrder S; S.A = (const char*)(ws + WS_XN); S.Bt = (const char*)((bf16_t*)(ws + WS_WIN) + (size_t)l * INWP * D); S.a_mstep = (size_t)256 * D * 2; S.a_nstep = 0; S.b_nstep = (size_t)256 * D * 2;
            S.nM = MA / 256; S.nN = INWP / 256; S.nwg = S.nM * S.nN; S.G = G; S.c = blk;
            pg8::Gemm g; g.K = D; g.lda = D; g.ldb = D; g.pad = 0;
            EpiIn E; E.U = (bf16_t*)(ws + WS_U); E.R = (float*)(ws + WS_R);
            pg8::gemm_phase<EpiIn, pg8::TileOrder, true>(wv, lds, g, S, E);
            HELP(pb + 1);
        }
        SEAM(pb + 1);
        if (RUN(pb + 2)) { unsigned char* ws = WSP; const float* wgp = PTR(9) + (size_t)l * 2 * 16 * 512; const float* bgp = PTR(10) + (size_t)l * 2 * 512;
            for (int un = blk; un < NUN; un += G) gla_g1_unit(wv, lds, un, (const bf16_t*)(ws + WS_U), (const float*)(ws + WS_R), wgp, bgp, (bf16_t*)(ws + WS_QA), (bf16_t*)(ws + WS_BT), (bf16_t*)(ws + WS_DS), (float*)(ws + WS_DEC));
            p_pool(wv, (const bf16_t*)(ws + WS_U), (bf16_t*)(ws + WS_MIX), MA);
        }
        SEAM(pb + 2);
        if (RUN(pb + 3)) { unsigned char* ws = WSP;
            p_gla_g2(wv, (const bf16_t*)(ws + WS_DS), (const float*)(ws + WS_DEC), (bf16_t*)(ws + WS_BT));
        }
        SEAM(pb + 3);
        if (RUN(pb + 4)) { unsigned char* ws = WSP; const float* gain = PTR(11) + l * 1024;
            if (blk >= G - 136) { pg8::TileOrder S; S.A = (const char*)(ws + WS_MIX); S.Bt = (const char*)((bf16_t*)(ws + WS_WPOOL) + (size_t)l * 4 * 256 * 256); S.a_mstep = (size_t)256 * 1024 * 2; S.a_nstep = (size_t)256 * 2; S.b_nstep = (size_t)256 * 256 * 2;
              S.nM = MA / 256; S.nN = 4; S.nwg = S.nM * S.nN; S.G = 136; S.c = blk - (G - 136);
              pg8::Gemm g; g.K = 256; g.lda = 1024; g.ldb = 256; g.pad = 0;
              EpiPool E; E.Y = (bf16_t*)(ws + WS_Y); E.scale = PTR(13) + l * 1024;
              pg8::gemm_phase<EpiPool, pg8::TileOrder, true>(wv, lds, g, S, E); }
            for (int un = blk; un < NUN; un += G) { if (l == 1 && (un % NCH) < 4) continue; gla_g3_unit(wv, lds, un, (const bf16_t*)(ws + WS_QA), (const bf16_t*)(ws + WS_BT), (const bf16_t*)(ws + WS_U), gain, (bf16_t*)(ws + WS_Y)); }
            DRAINQ(l == 0 ? Q_WOUT0 : Q_WOUT1);
        }
        SEAM(pb + 4);
        if (RUN(pb + 5)) { unsigned char* ws = WSP; const float* modv_l = (const float*)(ws + WS_MODV) + (size_t)l * 3 * MODW; float* XR = (float*)(ws + WS_XR);
            pg8::TileOrder S; S.A = (const char*)(ws + WS_Y); S.Bt = (const char*)((bf16_t*)(ws + WS_WOUT) + (size_t)l * D * D); S.a_mstep = (size_t)256 * D * 2; S.a_nstep = 0; S.b_nstep = (size_t)256 * D * 2;
            S.nM = nMo; S.nN = D / 256; S.nwg = S.nM * S.nN; S.G = G; S.c = blk;
            pg8::Gemm g; g.K = D; g.lda = D; g.ldb = D; g.pad = 0;
            EpiResid E; E.src_lat = l == 0 ? PTR(0) : XR; E.src_ctx = l == 0 ? PTR(2) : XR; E.XR = XR; E.gate = modv_l + 2 * D; E.rowgate = nullptr; E.rg_stride = 0; E.ctx_row0 = ctx_row0;
            pg8::gemm_phase<EpiResid, pg8::TileOrder, true>(wv, lds, g, S, E);
            if constexpr (l == 0) HELP(pb + 5);
        }
        SEAM(pb + 5);
        if (RUN(pb + 6)) { unsigned char* ws = WSP; const float* modv_l = (const float*)(ws + WS_MODV) + (size_t)l * 3 * MODW; const float* XR = (const float*)(ws + WS_XR);
            if constexpr (l == 0) p_ln<false>(wv, XR, XR, 0, PTR(7) + l * D, modv_l + 3 * D, modv_l + 4 * D, (bf16_t*)(ws + WS_XN), nMo * 256);
            if constexpr (l == 0) DRAINQ(Q_F3); else DRAINQ(Q_ALL);
            if constexpr (l == 1) p_router(wv, XR, PTR(7) + l * D, modv_l + 3 * D, modv_l + 4 * D, PTR(18), PTR(19), (unsigned*)(ws + WS_CTL) + CW_CNT, (int*)(ws + WS_LIST), (float*)(ws + WS_GEP), (int*)(ws + WS_SLOT), ws + WS_XN);
        }
        SEAM(pb + 6);
        if (RUN(pb + 7)) { unsigned char* ws = WSP;
            if constexpr (l == 0) {
                pg8::TileOrder S; S.A = (const char*)(ws + WS_XN); S.Bt = (const char*)(ws + WS_W13); S.a_mstep = (size_t)256 * D * 2; S.a_nstep = 0; S.b_nstep = (size_t)256 * D * 2;
                S.nM = MA / 256; S.nN = 2 * DFF / 256; S.nwg = S.nM * S.nN; S.G = G; S.c = blk;
                pg8::Gemm g; g.K = D; g.lda = D; g.ldb = D; g.pad = 0;
                EpiSwiglu8 E; E.H = ws + WS_HH; E.ldh = DFF; E.pad = 0;
                pg8::gemm_phase<EpiSwiglu8, pg8::TileOrder, true>(wv, lds, g, S, E);
                HELP(pb + 7); DRAINQ(Q_F2);
            } else {
                LAS int* tab = (LAS int*)(lds + MOE_TAB); LAS int* rows = (LAS int*)(lds + MOE_ROWS);
                moe_tab_init(wv, tab, (const unsigned*)(ws + WS_CTL) + CW_CNT, 2 * DFF / 256);
                MoeOrder<true> S; S.A = (const char*)(ws + WS_XN); S.Bt = (const char*)(ws + WS_MW13); S.a_mstep = 0; S.b_estep = (size_t)2 * DFF * D; S.b_nstep = (size_t)256 * D; S.tab = tab; S.rows = rows; S.nN = 2 * DFF / 256; S.G = G; S.c = blk;
                { pg8::Unit u; const int* LIST = (const int*)(ws + WS_LIST);
                  for (int ui = 0; S.next(ui, u); ++ui) { const int n = tab[48 + u.e];
                      for (int r = my_tid(wv); r < 256; r += 512) { const int p = u.pml * 256 + r; rows[ui * 256 + r] = LIST[(size_t)u.e * 8192 + (p < n ? p : 0)]; } }
                  __syncthreads(); }
                pg8::Gemm g; g.K = D / 2; g.lda = D / 2; g.ldb = D / 2; g.pad = 0;
                EpiSwiglu8 E; E.H = ws + WS_HH; E.ldh = DFF; E.pad = 0;
                pg8::gemm_phase<EpiSwiglu8, MoeOrder<true>, true, true>(wv, lds, g, S, E);
            }
        }
        SEAM(pb + 7);
        if (RUN(pb + 8)) { unsigned char* ws = WSP;
            if constexpr (l == 0) { const float* modv_l = (const float*)(ws + WS_MODV); float* XR = (float*)(ws + WS_XR);
                pg8::TileOrder S; S.A = (const char*)(ws + WS_HH); S.Bt = (const char*)(ws + WS_W2); S.a_mstep = (size_t)256 * DFF; S.a_nstep = 0; S.b_nstep = (size_t)256 * DFF;
                S.nM = MA / 256; S.nN = D / 256; S.nwg = S.nM * S.nN; S.G = G; S.c = blk;
                pg8::Gemm g; g.K = DFF / 2; g.lda = DFF / 2; g.ldb = DFF / 2; g.pad = 0;
                EpiResid E; E.src_lat = XR; E.src_ctx = XR; E.XR = XR; E.gate = modv_l + 5 * D; E.rowgate = nullptr; E.rg_stride = 0; E.ctx_row0 = 0;
                pg8::gemm_phase<EpiResid, pg8::TileOrder, true, true>(wv, lds, g, S, E);
                HELP(pb + 8);
            } else {
                LAS int* tab = (LAS int*)(lds + MOE_TAB); LAS int* rows = (LAS int*)(lds + MOE_ROWS);
                moe_tab_init(wv, tab, (const unsigned*)(ws + WS_CTL) + CW_CNT, D / 256);
                MoeOrder<false> S; S.A = (const char*)(ws + WS_HH); S.Bt = (const char*)(ws + WS_MW2); S.a_mstep = (size_t)256 * DFF; S.b_estep = (size_t)D * DFF; S.b_nstep = (size_t)256 * DFF; S.tab = tab; S.rows = rows; S.nN = D / 256; S.G = G; S.c = blk;
                pg8::Gemm g; g.K = DFF / 2; g.lda = DFF / 2; g.ldb = DFF / 2; g.pad = 0;
                EpiMoeDown E; E.YD = (bf16_t*)(ws + WS_YD);
                pg8::gemm_phase<EpiMoeDown, MoeOrder<false>, true, true>(wv, lds, g, S, E);
            }
        }
        SEAM(pb + 8);
}

struct Args { const float* in[24]; float* out; unsigned char* ws; int ph_lo, ph_hi; };
__global__ void __launch_bounds__(512, 2) mk_fwd(Args args) {
    extern __shared__ __attribute__((aligned(16))) unsigned char lds_raw[];
    LAS unsigned char* lds = (LAS unsigned char*)lds_raw;
    volatile LAS unsigned* MISC = (volatile LAS unsigned*)(lds + LDS_MISC);
    const int wv = __builtin_amdgcn_readfirstlane((int)threadIdx.x >> 6);
    if (threadIdx.x < 16) MISC[threadIdx.x] = 0u;
    __syncthreads();
    volatile LAS unsigned long long* PT = (volatile LAS unsigned long long*)(lds + LDS_MISC + 64);
    if (threadIdx.x < 24) PT[threadIdx.x] = (unsigned long long)args.in[threadIdx.x];
    if (threadIdx.x == 24) PT[24] = (unsigned long long)args.out;
    if (threadIdx.x == 25) PT[25] = (unsigned long long)args.ws;
    __syncthreads();
    const int lo = args.ph_lo, hi = args.ph_hi;
    XcdBarrier bar; bar.bar = (unsigned*)(args.ws + WS_CTL) + CW_BAR; bar.x = 0; bar.st = MISC;
    if (hi - lo > 1) bar = xcd_barrier_post((unsigned*)(args.ws + WS_CTL) + CW_BAR, MISC);
    const int G = gridDim.x, blk = blockIdx.x;

    if (RUN(0)) {
        unsigned char* ws = WSP;
        p_ada(wv, lds, PTR(1), PTR(3), PTR(4), PTR(5), (float*)(ws + WS_MODV));
        p_convert(wv, lds, PTR(8), (bf16_t*)(ws + WS_WIN), (size_t)D * INW, (size_t)INWP * D, D, INW, INWP, 1 << 30, 0, 0, 1);
        p_convert(wv, lds, PTR(12), (bf16_t*)(ws + WS_WPOOL), (size_t)256 * 256, (size_t)256 * 256, 256, 256, 256, 1 << 30, 0, 0, 8);
    }
    SEAM(0);
    layer_phases<0>(wv, lds, PT, lo, hi, bar, G, blk);
    layer_phases<1>(wv, lds, PT, lo, hi, bar, G, blk);
    if (RUN(19)) { unsigned char* ws = WSP;
        p_final(wv, (const float*)(ws + WS_XR), (const bf16_t*)(ws + WS_YD), (const int*)(ws + WS_SLOT), (const float*)(ws + WS_GEP), (const unsigned*)(ws + WS_CTL) + CW_CNT, (const float*)(ws + WS_MODV) + 3 * MODW + 5 * D, PTR(23), (float*)ldptr(PT, 24)); }
#undef RUN
#undef SEAM
#undef PTR
#undef WSP
}

extern "C" void kernel_launch(void* const* d_in, const int* in_sizes, int n_in, void* d_out, int out_size, void* d_ws, size_t ws_size, hipStream_t stream) {
    if (n_in != 24 || ws_size < WS_END || out_size != ML * D) { fprintf(stderr, "kernel_launch: unexpected sizes (n_in %d, ws %zu, out %d)\n", n_in, ws_size, out_size); return; }
    static int grid = 0;
    if (grid == 0) {
        int dev = 0, cus = 0, per_cu = 0;
        if (hipGetDevice(&dev) != hipSuccess || hipDeviceGetAttribute(&cus, hipDeviceAttributeMultiprocessorCount, dev) != hipSuccess) { grid = -1; return; }
        if (hipFuncSetAttribute((const void*)mk_fwd, hipFuncAttributeMaxDynamicSharedMemorySize, LDS_BYTES) != hipSuccess) { fprintf(stderr, "kernel_launch: hipFuncSetAttribute failed\n"); grid = -1; return; }
        if (hipOccupancyMaxActiveBlocksPerMultiprocessor(&per_cu, (const void*)mk_fwd, 512, LDS_BYTES) != hipSuccess || per_cu < 1) fprintf(stderr, "kernel_launch: occupancy query reports %d\n", per_cu);
        (void)hipGetLastError();
        grid = cus;
    }
    if (grid < 0) return;
    (void)hipMemsetAsync((char*)d_ws + WS_CTL, 0, 1 * MiB, stream);
    Args a; memset(&a, 0, sizeof a);
    for (int i = 0; i < 24; ++i) a.in[i] = (const float*)d_in[i];
    a.out = (float*)d_out; a.ws = (unsigned char*)d_ws;
#if MK_PER_PHASE
    for (int p = 0; p < NPHASE; ++p) { a.ph_lo = p; a.ph_hi = p + 1; hipLaunchKernelGGL(mk_fwd, dim3(grid), dim3(512), LDS_BYTES, stream, a); }
#else
    a.ph_lo = 0; a.ph_hi = NPHASE; hipLaunchKernelGGL(mk_fwd, dim3(grid), dim3(512), LDS_BYTES, stream, a);
#endif
#ifdef MK_PROBE_MASK
    for (int p = 0; p < NPHASE; ++p) if ((MK_PROBE_MASK >> p) & 1) { a.ph_lo = p; a.ph_hi = p + 1; hipLaunchKernelGGL(mk_fwd, dim3(grid), dim3(512), LDS_BYTES, stream, a); }
#endif
}
```

```cpp
#include <hip/hip_runtime.h>
#include <cstdio>
#include <cstdint>
#include <cstring>

#define LAS __attribute__((address_space(3)))
typedef unsigned short bf16_t;
typedef short bf16x8 __attribute__((ext_vector_type(8)));
typedef float f32x4 __attribute__((ext_vector_type(4)));
typedef float f32x2 __attribute__((ext_vector_type(2)));
typedef unsigned u32x4 __attribute__((ext_vector_type(4)));
typedef unsigned u32x2 __attribute__((ext_vector_type(2)));

constexpr int D = 2048, NBATCH = 2, SEQ = 4096, CTXL = 256;
constexpr int ML = NBATCH * SEQ;
constexpr int MC = NBATCH * CTXL;
constexpr int MA = ML + MC;
constexpr int INW = 4128, INWP = 4352;
constexpr int DFF = 5632, NE = 8;
constexpr int GH = 4, DK = 128, DV = 256;
constexpr int C_Q = 0, C_K = 512, C_V = 1024, C_G = 2048, C_P = 3072, C_R = 4096;
constexpr float EPS = 1e-6f;
constexpr int MODW = 6 * D;

constexpr size_t MiB = 1u << 20;
constexpr size_t WS_CTL = 0;
constexpr size_t WS_MODV = 1 * MiB;
constexpr size_t WS_LIST = 2 * MiB;
constexpr size_t WS_GEP = WS_LIST + 256 * 1024;
constexpr size_t WS_SLOT = WS_GEP + 256 * 1024;
constexpr size_t WS_R = 3 * MiB;
constexpr size_t WS_WPOOL = 5 * MiB;
constexpr size_t WS_WIN = 6 * MiB;
constexpr size_t WS_WOUT = 40 * MiB;
constexpr size_t WS_W13 = 56 * MiB;
constexpr size_t WS_W2 = 100 * MiB;
constexpr size_t WS_MW13 = 122 * MiB;
constexpr size_t WS_MW2 = 474 * MiB;
constexpr size_t WS_XR = 650 * MiB;
constexpr size_t WS_XN = 718 * MiB;
constexpr size_t WS_U = 752 * MiB;
constexpr size_t WS_Y = 825 * MiB;
constexpr size_t WS_MIX = 859 * MiB;
constexpr size_t WS_HH = 876 * MiB;
constexpr size_t WS_QA = 1074 * MiB;
constexpr size_t WS_BT = 1096 * MiB;
constexpr size_t WS_DS = 1182 * MiB;
constexpr size_t WS_DEC = 1318 * MiB;
constexpr size_t WS_YD = WS_QA;
constexpr size_t WS_END = 1320 * MiB;
constexpr int CW_CNT = 1024;
constexpr int LDS_MISC = 147456;
constexpr int MOE_TAB = 131072, MOE_ROWS = 131072 + 256, MOE_MAXU = 15, MOE_LDS = MOE_ROWS + MOE_MAXU * 1024;

__device__ __forceinline__ int my_tid(int wv) { int t = wv * 64 + (int)__builtin_amdgcn_mbcnt_hi(~0u, __builtin_amdgcn_mbcnt_lo(~0u, 0u)); asm volatile("" : "+v"(t)); return t; }
namespace pg8 {
constexpr int BM = 256, BK = 64, HALF = 128, HTB = HALF * BK * 2, STAGE_BYTES = 8 * HTB, NXCD = 8, WGM = 8;
__host__ __device__ __forceinline__ int lds_byte(int r, int c) { const int st = (r >> 4) * 2 + (c >> 5), rr = r & 15, cc = c & 31, ob = rr * 64 + cc * 2; return st * 1024 + (ob ^ (((ob >> 9) & 1) << 5)); }
__host__ __device__ __forceinline__ void stage_rc(int b, int& R, int& C) { const int st = b / 1024, sb = b % 1024, swz = sb ^ (((sb >> 9) & 1) << 5); R = (st >> 1) * 16 + swz / 64; C = (st & 1) * 32 + (swz % 64) / 2; }
__host__ __device__ __forceinline__ int perm32(int rho) { const int n = rho >> 4, i = rho & 15; return 8 * (i >> 2) + 4 * n + (i & 3); }

struct Unit { const char* a; const char* b; int pm, pn, e, pml; };
struct Gemm { int K, lda, ldb, pad; };

struct TileOrder {
    static constexpr bool GATHER = false;
    const char* A; const char* Bt; size_t a_mstep, a_nstep, b_nstep; int nM, nN, nwg, G, c;
    __device__ __forceinline__ bool next(int i, Unit& u) const {
        const long L = (long)i * G + c; if (L >= nwg) return false;
        int wgid = (int)L; { const int q = nwg / NXCD, r = nwg % NXCD, xcd = wgid % NXCD, off = wgid / NXCD; wgid = (xcd < r ? xcd * (q + 1) : r * (q + 1) + (xcd - r) * q) + off; }
        const int nig = WGM * nN, gid = wgid / nig, fm = gid * WGM, gsz = (nM - fm) < WGM ? (nM - fm) : WGM;
        u.pm = fm + ((wgid % nig) % gsz); u.pn = (wgid % nig) / gsz;
        u.a = A + (size_t)u.pm * a_mstep + (size_t)u.pn * a_nstep; u.b = Bt + (size_t)u.pn * b_nstep; u.e = 0; u.pml = u.pm; return true;
    }
    __device__ __forceinline__ void a_off(int, const Unit&, int tid, int lda, unsigned (&v)[4]) const {
#pragma unroll
        for (int i = 0; i < 2; ++i) { int R, C; stage_rc(tid * 16 + i * 8192, R, C); v[i] = (unsigned)(R * lda + C) * 2u; v[2 + i] = (unsigned)((R + HALF) * lda + C) * 2u; }
    }
};

typedef __bf16 bf16x2_hw __attribute__((ext_vector_type(2)));
__device__ __forceinline__ unsigned cvt_pk_bf16(float lo, float hi) { const f32x2 v = {lo, hi}; const bf16x2_hw b = __builtin_convertvector(v, bf16x2_hw); return __builtin_bit_cast(unsigned, b); }

__device__ __forceinline__ void glds16(unsigned voff, const char* sbase, unsigned lds_dst) {
    unsigned keep;
    asm volatile("s_nop 4\n\ts_mov_b32 %0, m0\n\ts_mov_b32 m0, %2\n\ts_nop 0\n\tglobal_load_lds_dwordx4 %1, %3\n\ts_mov_b32 m0, %0" : "=&s"(keep) : "v"(voff), "s"(lds_dst), "s"(sbase) : "memory");
}
__device__ __forceinline__ const char* ubase(const char* p) {
    const unsigned long long v = (unsigned long long)p;
    const unsigned lo = __builtin_amdgcn_readfirstlane((unsigned)v), hi = __builtin_amdgcn_readfirstlane((unsigned)(v >> 32));
    return (const char*)(((unsigned long long)hi << 32) | lo);
}
typedef int v4i_t __attribute__((ext_vector_type(4)));
typedef int v8i_t __attribute__((ext_vector_type(8)));
__device__ __forceinline__ v8i_t cat8(bf16x8 lo, bf16x8 hi) { const v4i_t a = __builtin_bit_cast(v4i_t, lo), b = __builtin_bit_cast(v4i_t, hi); return __builtin_shufflevector(a, b, 0, 1, 2, 3, 4, 5, 6, 7); }
template <class Epi, class Sched, bool ALIGN_EPI, bool FP8 = false>
__device__ __forceinline__ void gemm_phase(const int wv, LAS unsigned char* lds, const Gemm g, const Sched& S, const Epi& E) {
    int tid = my_tid(wv);
    const int wid = __builtin_amdgcn_readfirstlane(tid >> 6), lane = tid & 63, wr = wid >> 2, wc = wid & 3, fr = lane & 15, fq = lane >> 4;
    const int K = g.K, nt = K / BK;
    unsigned voffB[2];
#pragma unroll
    for (int i = 0; i < 2; ++i) { int R, C; stage_rc(tid * 16 + i * 8192, R, C); const int Rb = Epi::PERM ? ((R & ~31) + perm32(R & 31)) : R;
        voffB[i] = (unsigned)(Rb * g.ldb + C) * 2u; }
    const size_t kstep = (size_t)(BK * 2);
    const size_t hB = (size_t)HALF * g.ldb * 2, hA = (size_t)HALF * g.lda * 2;
    const unsigned ldsw = (unsigned)wid * 1024u;
    constexpr bool ASMDMA = FP8 && !Sched::GATHER;
    const unsigned ldsb = (unsigned)__builtin_amdgcn_readfirstlane((int)(unsigned)(unsigned long long)(lds + ldsw));
    const int scl8 = 0x7c7c7c7c;
    const int aoff = lds_byte(wr * 64 + fr, fq * 8), boff = lds_byte(wc * 32 + fr, fq * 8);
#define PG8_SA(b, h) (((b) * 2 + (h)) * HTB)
#define PG8_SB(b, h) ((4 + (b) * 2 + (h)) * HTB)
#define PG8_STAGE(bufoff, gbase, voff) do { if constexpr (ASMDMA) { const char* _gb = ubase((const char*)(gbase)); _Pragma("unroll") for (int _i = 0; _i < 2; ++_i) glds16((voff)[_i], _gb, ldsb + (unsigned)((bufoff) + _i * 8192)); } \
        else { _Pragma("unroll") for (int _i = 0; _i < 2; ++_i) __builtin_amdgcn_global_load_lds((const unsigned*)((const char*)(gbase) + (voff)[_i]), (LAS unsigned*)(lds + (bufoff) + ldsw + _i * 8192), 16, 0, 0); } } while (0)
#define PG8_STAGEA(bufoff, gbase, voff, hh) do { if constexpr (ASMDMA) { const char* _gb = ubase((const char*)(gbase) + (hh) * hA); _Pragma("unroll") for (int _i = 0; _i < 2; ++_i) glds16((voff)[_i], _gb, ldsb + (unsigned)((bufoff) + _i * 8192)); } \
        else { _Pragma("unroll") for (int _i = 0; _i < 2; ++_i) { \
        if constexpr (Sched::GATHER) __builtin_amdgcn_global_load_lds((const unsigned*)((const char*)(gbase) + (voff)[(hh) * 2 + _i]), (LAS unsigned*)(lds + (bufoff) + ldsw + _i * 8192), 16, 0, 0); \
        else __builtin_amdgcn_global_load_lds((const unsigned*)((const char*)(gbase) + (hh) * hA + (voff)[_i]), (LAS unsigned*)(lds + (bufoff) + ldsw + _i * 8192), 16, 0, 0); } } } while (0)
#define PG8_LDA(dst, b, h) do { _Pragma("unroll") for (int m = 0; m < 4; ++m) _Pragma("unroll") for (int k = 0; k < 2; ++k) dst[m][k] = *(const LAS bf16x8*)(lds + PG8_SA(b, h) + aoff + m * 2048 + k * 1024); } while (0)
#define PG8_LDB(dst, b, h) do { _Pragma("unroll") for (int n = 0; n < 2; ++n) _Pragma("unroll") for (int k = 0; k < 2; ++k) dst[n][k] = *(const LAS bf16x8*)(lds + PG8_SB(b, h) + boff + n * 2048 + k * 1024); } while (0)
#define PG8_MMA(ai, bj, At, Bt) do { __builtin_amdgcn_s_setprio(1); \
        if constexpr (FP8) { _Pragma("unroll") for (int m = 0; m < 4; ++m) _Pragma("unroll") for (int n = 0; n < 2; ++n) \
            acc[ai][bj][m][n] = __builtin_amdgcn_mfma_scale_f32_16x16x128_f8f6f4(cat8(Bt[n][0], Bt[n][1]), cat8(At[m][0], At[m][1]), acc[ai][bj][m][n], 0, 0, 0, scl8, 0, scl8); } \
        else { _Pragma("unroll") for (int m = 0; m < 4; ++m) _Pragma("unroll") for (int n = 0; n < 2; ++n) _Pragma("unroll") for (int k = 0; k < 2; ++k) \
            acc[ai][bj][m][n] = __builtin_amdgcn_mfma_f32_16x16x32_bf16(Bt[n][k], At[m][k], acc[ai][bj][m][n], 0, 0, 0); } \
        __builtin_amdgcn_s_setprio(0); } while (0)
#define PG8_WAIT_V(n) asm volatile("s_waitcnt vmcnt(" #n ")" ::: "memory")
#define PG8_WAIT_L(n) asm volatile("s_waitcnt lgkmcnt(" #n ")" ::: "memory")
#define PG8_BAR __builtin_amdgcn_s_barrier()
#define PG8_SCHED __builtin_amdgcn_sched_barrier(0)
    Unit cur, nxt; int ui = 0;
    if (!S.next(0, cur)) return;
    f32x4 acc[2][2][4][2];
#pragma unroll
    for (int a = 0; a < 2; ++a)
#pragma unroll
        for (int b = 0; b < 2; ++b)
#pragma unroll
            for (int m = 0; m < 4; ++m)
#pragma unroll
                for (int n = 0; n < 2; ++n) acc[a][b][m][n] = (f32x4){0.f, 0.f, 0.f, 0.f};
    bf16x8 At[4][2], B0[2][2], B1[2][2];
    const char* cA = cur.a; const char* cB = cur.b;
    unsigned vA[4];
    S.a_off(0, cur, tid, g.lda, vA);
    PG8_STAGE(PG8_SB(0, 0), cB, voffB); PG8_STAGE(PG8_SB(0, 1), cB + hB, voffB); PG8_STAGEA(PG8_SA(0, 0), cA, vA, 0); PG8_STAGEA(PG8_SA(0, 1), cA, vA, 1);
    if (wr == 1) PG8_BAR;
    PG8_WAIT_V(2); PG8_BAR;
    PG8_STAGE(PG8_SB(1, 0), cB + kstep, voffB); PG8_STAGEA(PG8_SA(1, 0), cA + kstep, vA, 0); PG8_STAGE(PG8_SB(1, 1), cB + hB + kstep, voffB);
    PG8_WAIT_V(6); PG8_BAR;
    for (;;) {
        const bool has_next = S.next(ui + 1, nxt);
        const char* nA = has_next ? nxt.a : cA; const char* nB = has_next ? nxt.b : cB;
        for (int t = 0; t < nt; t += 2) {
            const bool last = (t == nt - 2);
            const char* a1 = cA + (size_t)(t + 1) * kstep;
            const char* a2 = last ? nA : cA + (size_t)(t + 2) * kstep; const char* b2 = last ? nB : cB + (size_t)(t + 2) * kstep;
            const char* a3 = a2 + kstep; const char* b3 = b2 + kstep;
            PG8_LDB(B0, 0, 0); PG8_LDB(B1, 0, 1); PG8_SCHED; PG8_LDA(At, 0, 0); PG8_STAGEA(PG8_SA(1, 1), a1, vA, 1);
            if constexpr (Sched::GATHER) { if (last && has_next) S.a_off(ui + 1, nxt, my_tid(wv), g.lda, vA); }
            PG8_WAIT_V(8); PG8_WAIT_L(0); PG8_BAR; PG8_MMA(0, 0, At, B0); PG8_MMA(0, 1, At, B1); PG8_BAR; PG8_SCHED;
            PG8_LDA(At, 0, 1); PG8_STAGE(PG8_SB(0, 0), b2, voffB); PG8_STAGE(PG8_SB(0, 1), b2 + hB, voffB); PG8_STAGEA(PG8_SA(0, 0), a2, vA, 0);
            PG8_WAIT_V(8); PG8_WAIT_L(0); PG8_BAR; PG8_MMA(1, 0, At, B0); PG8_MMA(1, 1, At, B1); PG8_BAR; PG8_SCHED;
            PG8_LDB(B0, 1, 0); PG8_LDB(B1, 1, 1); PG8_SCHED; PG8_LDA(At, 1, 0); PG8_STAGEA(PG8_SA(0, 1), a2, vA, 1);
            PG8_WAIT_V(8); PG8_WAIT_L(0); PG8_BAR; PG8_MMA(0, 0, At, B0); PG8_MMA(0, 1, At, B1); PG8_BAR; PG8_SCHED;
            PG8_LDA(At, 1, 1); PG8_STAGE(PG8_SB(1, 0), b3, voffB); PG8_STAGE(PG8_SB(1, 1), b3 + hB, voffB); PG8_STAGEA(PG8_SA(1, 0), a3, vA, 0);
            PG8_WAIT_V(8); PG8_WAIT_L(0); PG8_BAR; PG8_MMA(1, 0, At, B0); PG8_MMA(1, 1, At, B1); PG8_BAR; PG8_SCHED;
        }
        if constexpr (ALIGN_EPI) { if (wr == 0) PG8_BAR; }
        { const int te = my_tid(wv), le = te & 63, we = __builtin_amdgcn_readfirstlane(te >> 6); E(acc, cur, we >> 2, we & 3, le & 15, le >> 4); }
        if (!has_next) break;
#pragma unroll
        for (int a = 0; a < 2; ++a)
#pragma unroll
            for (int b = 0; b < 2; ++b)
#pragma unroll
                for (int m = 0; m < 4; ++m)
#pragma unroll
                    for (int n = 0; n < 2; ++n) acc[a][b][m][n] = (f32x4){0.f, 0.f, 0.f, 0.f};
        cur = nxt; cA = nA; cB = nB; ++ui;
        if constexpr (ALIGN_EPI) { if (wr == 1) PG8_BAR; }
    }
    PG8_WAIT_V(0);
    if constexpr (!ALIGN_EPI) { if (wr == 0) PG8_BAR; }
    PG8_BAR;
#undef PG8_SA
#undef PG8_SB
#undef PG8_STAGE
#undef PG8_STAGEA
#undef PG8_LDA
#undef PG8_LDB
#undef PG8_MMA
#undef PG8_WAIT_V
#undef PG8_WAIT_L
#undef PG8_BAR
#undef PG8_SCHED
}
}
using pg8::cvt_pk_bf16;
typedef f32x4 Acc[2][2][4][2];

__device__ __forceinline__ float bf2f(bf16_t v) { return __uint_as_float(((unsigned)v) << 16); }
__device__ __forceinline__ float siluf(float a) { return a * __builtin_amdgcn_rcpf(1.f + __expf(-a)); }
__device__ __forceinline__ int mod_index(int row) { return row < SEQ ? 0 : (row < ML ? 1 : 2); }

struct EpiIn {
    static constexpr bool PERM = true;
    bf16_t* U; float* R;
    __device__ __forceinline__ void operator()(const Acc& acc, const pg8::Unit& u, int wr, int wc, int fr, int fq) const {
        const int row0 = u.pm * 256 + wr * 64 + fr, col0 = u.pn * 256 + wc * 32 + 8 * fq;
        const float sc = (u.pn < 2) ? 0.08838834764831845f : 1.f;
#pragma unroll
        for (int ai = 0; ai < 2; ++ai)
#pragma unroll
            for (int m = 0; m < 4; ++m) { const int row = row0 + ai * 128 + m * 16; bf16_t* rowp = U + (size_t)row * INWP + col0;
#pragma unroll
                for (int bj = 0; bj < 2; ++bj) { const f32x4 v0 = acc[ai][bj][m][0] * sc, v1 = acc[ai][bj][m][1] * sc;
                    u32x4 w; w.x = cvt_pk_bf16(v0[0], v0[1]); w.y = cvt_pk_bf16(v0[2], v0[3]); w.z = cvt_pk_bf16(v1[0], v1[1]); w.w = cvt_pk_bf16(v1[2], v1[3]);
                    *(u32x4*)(rowp + bj * 128) = w; }
                if (u.pn == 16 && wc == 0) { float* rp = R + (size_t)row * 32 + 8 * fq; *(f32x4*)rp = acc[ai][0][m][0]; *(f32x4*)(rp + 4) = acc[ai][0][m][1]; } }
    }
};
struct EpiPool {
    static constexpr bool PERM = true;
    bf16_t* Y; const float* scale;
    __device__ __forceinline__ void operator()(const Acc& acc, const pg8::Unit& u, int wr, int wc, int fr, int fq) const {
        const int row0 = u.pm * 256 + wr * 64 + fr, col0 = u.pn * 256 + wc * 32 + 8 * fq;
        f32x4 sv[2][2];
#pragma unroll
        for (int bj = 0; bj < 2; ++bj)
#pragma unroll
            for (int n = 0; n < 2; ++n) sv[bj][n] = *(const f32x4*)(scale + col0 + bj * 128 + 4 * n);
#pragma unroll
        for (int ai = 0; ai < 2; ++ai)
#pragma unroll
            for (int m = 0; m < 4; ++m) { bf16_t* rowp = Y + (size_t)(row0 + ai * 128 + m * 16) * D + 1024 + col0;
#pragma unroll
                for (int bj = 0; bj < 2; ++bj) { const f32x4 v0 = acc[ai][bj][m][0] * sv[bj][0], v1 = acc[ai][bj][m][1] * sv[bj][1];
                    u32x4 w; w.x = cvt_pk_bf16(v0[0], v0[1]); w.y = cvt_pk_bf16(v0[2], v0[3]); w.z = cvt_pk_bf16(v1[0], v1[1]); w.w = cvt_pk_bf16(v1[2], v1[3]);
                    *(u32x4*)(rowp + bj * 128) = w; } }
    }
};
struct EpiResid {
    static constexpr bool PERM = false;
    const float* src_lat; const float* src_ctx; float* XR; const float* gate; const float* rowgate; int rg_stride, ctx_row0;
    __device__ __forceinline__ void operator()(const Acc& acc, const pg8::Unit& u, int wr, int wc, int fr, int fq) const {
        const int row0 = u.pm * 256 + wr * 64 + fr, col0 = u.pn * 256 + wc * 32 + 4 * fq;
        const int mi = u.pm < 16 ? 0 : (u.pm < 32 ? 1 : 2);
        const float* src = u.pm < 32 ? src_lat : src_ctx - (size_t)ctx_row0 * D;
        f32x4 gv[2][2];
#pragma unroll
        for (int bj = 0; bj < 2; ++bj)
#pragma unroll
            for (int n = 0; n < 2; ++n) gv[bj][n] = *(const f32x4*)(gate + (size_t)mi * MODW + col0 + bj * 128 + n * 16);
#pragma unroll
        for (int ai = 0; ai < 2; ++ai)
#pragma unroll
            for (int mp = 0; mp < 2; ++mp) { f32x4 bs[2][2][2];
#pragma unroll
                for (int mm = 0; mm < 2; ++mm) { const size_t off = (size_t)(row0 + ai * 128 + (2 * mp + mm) * 16) * D + col0;
#pragma unroll
                    for (int bj = 0; bj < 2; ++bj)
#pragma unroll
                        for (int n = 0; n < 2; ++n) bs[mm][bj][n] = *(const f32x4*)(src + off + bj * 128 + n * 16); }
#pragma unroll
                for (int mm = 0; mm < 2; ++mm) { const size_t off = (size_t)(row0 + ai * 128 + (2 * mp + mm) * 16) * D + col0;
#pragma unroll
                    for (int bj = 0; bj < 2; ++bj)
#pragma unroll
                        for (int n = 0; n < 2; ++n) *(f32x4*)(XR + off + bj * 128 + n * 16) = bs[mm][bj][n] + gv[bj][n] * acc[ai][bj][2 * mp + mm][n]; } }
    }
};
struct EpiSwiglu {
    static constexpr bool PERM = true;
    bf16_t* H; int ldh, pad;
    __device__ __forceinline__ void operator()(const Acc& acc, const pg8::Unit& u, int wr, int wc, int fr, int fq) const {
        const int row0 = u.pm * 256 + wr * 64 + fr, col0 = u.pn * 128 + wc * 32 + 8 * fq;
#pragma unroll
        for (int ai = 0; ai < 2; ++ai)
#pragma unroll
            for (int m = 0; m < 4; ++m) { bf16_t* rowp = H + (size_t)(row0 + ai * 128 + m * 16) * ldh + col0;
                float h[8];
#pragma unroll
                for (int n = 0; n < 2; ++n)
#pragma unroll
                    for (int j = 0; j < 4; ++j) h[n * 4 + j] = siluf(acc[ai][0][m][n][j]) * acc[ai][1][m][n][j];
                u32x4 w; w.x = cvt_pk_bf16(h[0], h[1]); w.y = cvt_pk_bf16(h[2], h[3]); w.z = cvt_pk_bf16(h[4], h[5]); w.w = cvt_pk_bf16(h[6], h[7]);
                *(u32x4*)rowp = w; }
    }
};

struct EpiSwiglu8 {
    static constexpr bool PERM = true;
    unsigned char* H; int ldh, pad;
    __device__ __forceinline__ void operator()(const Acc& acc, const pg8::Unit& u, int wr, int wc, int fr, int fq) const {
        const int row0 = u.pm * 256 + wr * 64 + fr, col0 = u.pn * 128 + wc * 32 + 8 * fq;
#pragma unroll
        for (int ai = 0; ai < 2; ++ai)
#pragma unroll
            for (int m = 0; m < 4; ++m) { unsigned char* rowp = H + (size_t)(row0 + ai * 128 + m * 16) * ldh + col0;
                float h[8];
#pragma unroll
                for (int n = 0; n < 2; ++n)
#pragma unroll
                    for (int j = 0; j < 4; ++j) h[n * 4 + j] = siluf(acc[ai][0][m][n][j]) * acc[ai][1][m][n][j];
                int x0 = 0, x1 = 0;
                x0 = __builtin_amdgcn_cvt_pk_fp8_f32(h[0], h[1], x0, false); x0 = __builtin_amdgcn_cvt_pk_fp8_f32(h[2], h[3], x0, true);
                x1 = __builtin_amdgcn_cvt_pk_fp8_f32(h[4], h[5], x1, false); x1 = __builtin_amdgcn_cvt_pk_fp8_f32(h[6], h[7], x1, true);
                *(u32x2*)rowp = (u32x2){(unsigned)x0, (unsigned)x1}; }
    }
};
__device__ __forceinline__ void moe_tab_init(const int wv, LAS int* tab, const unsigned* cnt, int nN) {
    if (my_tid(wv) == 0) { int tb = 0, hr = 0;
        for (int e = 0; e < NE; ++e) { const int n = (int)cnt[64 * e], r = (n + 255) >> 8; tab[e] = tb; tab[16 + e] = hr; tab[32 + e] = r; tab[48 + e] = n; tb += r * nN; hr += r; }
        tab[8] = tb; tab[24] = hr; }
    __syncthreads();
}
template <bool GATHER_> struct MoeOrder {
    static constexpr bool GATHER = GATHER_; static constexpr int gather = GATHER_ ? 1 : 0;
    const char* A; const char* Bt; size_t a_mstep, b_estep, b_nstep; const LAS int* tab; const LAS int* rows; int nN, G, c;
    __device__ __forceinline__ bool next(int i, pg8::Unit& u) const {
        const int nwg = __builtin_amdgcn_readfirstlane(tab[8]); const long L = (long)i * G + c; if (L >= nwg || i >= MOE_MAXU) return false;
        int wgid = (int)L; { const int q = nwg / 8, r = nwg % 8, xcd = wgid % 8, off = wgid / 8; wgid = (xcd < r ? xcd * (q + 1) : r * (q + 1) + (xcd - r) * q) + off; }
        int e = 0;
#pragma unroll
        for (int k = 1; k < NE; ++k) e += (wgid >= tab[k]) ? 1 : 0;
        e = __builtin_amdgcn_readfirstlane(e);
        const int loc = wgid - __builtin_amdgcn_readfirstlane(tab[e]), nM = __builtin_amdgcn_readfirstlane(tab[32 + e]);
        const int nig = 8 * nN, gid = loc / nig, fm = gid * 8, gsz = (nM - fm) < 8 ? (nM - fm) : 8;
        u.pml = fm + ((loc % nig) % gsz); u.pn = (loc % nig) / gsz; u.e = e; u.pm = __builtin_amdgcn_readfirstlane(tab[16 + e]) + u.pml;
        u.a = gather ? A : A + (size_t)u.pm * a_mstep; u.b = Bt + (size_t)e * b_estep + (size_t)u.pn * b_nstep; return true;
    }
    __device__ __forceinline__ void a_off(int ui, const pg8::Unit&, int tid, int lda, unsigned (&v)[4]) const {
#pragma unroll
        for (int i = 0; i < 2; ++i) { int R, C; pg8::stage_rc(tid * 16 + i * 8192, R, C);
#pragma unroll
            for (int hh = 0; hh < 2; ++hh) { const int row = gather ? rows[ui * 256 + hh * 128 + R] : (R + hh * 128); v[hh * 2 + i] = (unsigned)(row * lda + C) * 2u; } }
    }
};
struct EpiMoeDown {
    static constexpr bool PERM = true;
    bf16_t* YD;
    __device__ __forceinline__ void operator()(const Acc& acc, const pg8::Unit& u, int wr, int wc, int fr, int fq) const {
        const int row0 = u.pm * 256 + wr * 64 + fr, col0 = u.pn * 256 + wc * 32 + 8 * fq;
#pragma unroll
        for (int ai = 0; ai < 2; ++ai)
#pragma unroll
            for (int m = 0; m < 4; ++m) { bf16_t* rowp = YD + (size_t)(row0 + ai * 128 + m * 16) * D + col0;
#pragma unroll
                for (int bj = 0; bj < 2; ++bj) { const f32x4 v0 = acc[ai][bj][m][0], v1 = acc[ai][bj][m][1];
                    u32x4 w; w.x = cvt_pk_bf16(v0[0], v0[1]); w.y = cvt_pk_bf16(v0[2], v0[3]); w.z = cvt_pk_bf16(v1[0], v1[1]); w.w = cvt_pk_bf16(v1[2], v1[3]);
                    *(u32x4*)(rowp + bj * 128) = w; } }
    }
};
__device__ __forceinline__ float wave_sum(float v) {
#pragma unroll
    for (int o = 1; o < 64; o <<= 1) v += __shfl_xor(v, o);
    return v;
}
__device__ __forceinline__ unsigned f2bf(float f) { unsigned u = __float_as_uint(f); return (u + 0x7fffu + ((u >> 16) & 1u)) >> 16; }
constexpr int NCH = 68, NUN = 8 * NCH, KQ = 320;
constexpr int G1_CUM = 0, G1_QP = 33792, G1_KI = 51200, G1_KT = 68608, G1_VT = 87040, G1_WG = 123904, G1_BG = 140288, G1_AS = G1_QP  , G1_LDS = 141312;
__device__ __forceinline__ int gla_row0(int b, int c) { return c < 4 ? ML + b * CTXL + c * 64 : b * SEQ + (c - 4) * 64; }
__device__ __forceinline__ float bflo(unsigned w) { return __uint_as_float(w << 16); }
__device__ __forceinline__ float bfhi(unsigned w) { return __uint_as_float(w & 0xffff0000u); }
__device__ __forceinline__ float wave_scan_incl(float x, int lane) {
    x += __builtin_bit_cast(float, __builtin_amdgcn_update_dpp(0, __builtin_bit_cast(int, x), 0x111, 0xf, 0xf, false));
    x += __builtin_bit_cast(float, __builtin_amdgcn_update_dpp(0, __builtin_bit_cast(int, x), 0x112, 0xf, 0xf, false));
    x += __builtin_bit_cast(float, __builtin_amdgcn_update_dpp(0, __builtin_bit_cast(int, x), 0x114, 0xf, 0xf, false));
    x += __builtin_bit_cast(float, __builtin_amdgcn_update_dpp(0, __builtin_bit_cast(int, x), 0x118, 0xf, 0xf, false));
    const float t0 = __builtin_bit_cast(float, __builtin_amdgcn_readlane(__builtin_bit_cast(int, x), 15)), t1 = __builtin_bit_cast(float, __builtin_amdgcn_readlane(__builtin_bit_cast(int, x), 31)),
                t2 = __builtin_bit_cast(float, __builtin_amdgcn_readlane(__builtin_bit_cast(int, x), 47));
    return x + (lane >= 16 ? t0 : 0.f) + (lane >= 32 ? t1 : 0.f) + (lane >= 48 ? t2 : 0.f);
}
__device__ __forceinline__ float log_sigmoid_fast(float x) { return fminf(x, 0.f) - __logf(1.f + __expf(-fabsf(x))); }

__device__ __forceinline__ void gla_g1_unit(const int wv, LAS unsigned char* lds, int un, const bf16_t* U, const float* R, const float* wg, const float* bg, bf16_t* QAF, bf16_t* BTF, bf16_t* DSF, float* DEC) {
    int tid = my_tid(wv);
    const int lane = tid & 63, wid = __builtin_amdgcn_readfirstlane(tid >> 6), fr = lane & 15, fq = lane >> 4;
    const int bh = un / NCH, c = un % NCH, b = bh >> 2, h = bh & 3;
    const int row0 = gla_row0(b, c);
    LAS float* CUM = (LAS float*)(lds + G1_CUM);
    LAS bf16_t* QP = (LAS bf16_t*)(lds + G1_QP); LAS bf16_t* KI = (LAS bf16_t*)(lds + G1_KI); LAS bf16_t* KT = (LAS bf16_t*)(lds + G1_KT);
    LAS bf16_t* VT = (LAS bf16_t*)(lds + G1_VT); LAS bf16_t* AS = (LAS bf16_t*)(lds + G1_AS);
    LAS float* WG = (LAS float*)(lds + G1_WG); LAS float* BG = (LAS float*)(lds + G1_BG);
    u32x4 qv[2], kv[2];
#pragma unroll
    for (int i = 0; i < 2; ++i) { const int dg = (tid + 512 * i) >> 6;
        qv[i] = *(const u32x4*)(U + (size_t)(row0 + lane) * INWP + C_Q + h * DK + dg * 8); kv[i] = *(const u32x4*)(U + (size_t)(row0 + lane) * INWP + C_K + h * DK + dg * 8); }
    f32x4 rq[2][4];
#pragma unroll
    for (int dr = 0; dr < 2; ++dr) { const float* rp = R + (size_t)(row0 + (dr == 0 ? lane : 63 - lane)) * 32 + dr * 16;
#pragma unroll
        for (int x = 0; x < 4; ++x) rq[dr][x] = *(const f32x4*)(rp + 4 * x); }
    { const int e0 = tid * 8, rw = e0 >> 7, d0 = e0 & 127;
      const f32x4 w0 = *(const f32x4*)(wg + (size_t)rw * 512 + h * DK + d0), w1 = *(const f32x4*)(wg + (size_t)rw * 512 + h * DK + d0 + 4);
      *(LAS f32x4*)(WG + e0) = w0; *(LAS f32x4*)(WG + e0 + 4) = w1;
      if (tid < 64) { const int b0 = tid * 4; *(LAS f32x4*)(BG + b0) = *(const f32x4*)(bg + (size_t)(b0 >> 7) * 512 + h * DK + (b0 & 127)); } }
#pragma unroll
    for (int i = 0; i < 4; ++i) { const int idx = tid + 512 * i, jg = idx >> 6, s = idx & 63;
        const u32x4 q = *(const u32x4*)(U + (size_t)(row0 + s) * INWP + C_V + h * DV + jg * 8);
        LAS bf16_t* vp = VT + (jg * 8) * 72 + s;
        vp[0] = (bf16_t)(q.x & 0xffffu); vp[72] = (bf16_t)(q.x >> 16); vp[144] = (bf16_t)(q.y & 0xffffu); vp[216] = (bf16_t)(q.y >> 16);
        vp[288] = (bf16_t)(q.z & 0xffffu); vp[360] = (bf16_t)(q.z >> 16); vp[432] = (bf16_t)(q.w & 0xffffu); vp[504] = (bf16_t)(q.w >> 16); }
    f32x4 Aacc[2]; Aacc[0] = (f32x4){0.f, 0.f, 0.f, 0.f}; Aacc[1] = (f32x4){0.f, 0.f, 0.f, 0.f};
    __syncthreads();
    for (int dir = 0; dir < 2; ++dir) {
        { const int t = dir == 0 ? lane : 63 - lane;
          const float rr[16] = {rq[dir][0].x, rq[dir][0].y, rq[dir][0].z, rq[dir][0].w, rq[dir][1].x, rq[dir][1].y, rq[dir][1].z, rq[dir][1].w, rq[dir][2].x, rq[dir][2].y, rq[dir][2].z, rq[dir][2].w, rq[dir][3].x, rq[dir][3].y, rq[dir][3].z, rq[dir][3].w};
          for (int dd = 0; dd < 16; dd += 4) { const int d = wid * 16 + dd;
              const f32x4 b4 = *(const LAS f32x4*)(BG + dir * 128 + d);
              float pre[4] = {b4.x, b4.y, b4.z, b4.w};
#pragma unroll
              for (int k = 0; k < 16; ++k) { const f32x4 w4 = *(const LAS f32x4*)(WG + (dir * 16 + k) * 128 + d); pre[0] += rr[k] * w4.x; pre[1] += rr[k] * w4.y; pre[2] += rr[k] * w4.z; pre[3] += rr[k] * w4.w; }
#pragma unroll
              for (int q = 0; q < 4; ++q) CUM[t * 132 + d + q] = wave_scan_incl(log_sigmoid_fast(pre[q]) * (1.f / 16.f), lane); } }
        __syncthreads();
        if (dir == 0) {
#pragma unroll
            for (int i = 0; i < 4; ++i) { const int idx = tid + 512 * i, j = idx >> 3, sg = idx & 7;
                *(u32x4*)(BTF + ((((size_t)un * 16 + (j >> 4)) * 10 + 8 + (sg >> 2)) * 64 + (sg & 3) * 16 + (j & 15)) * 8) = *(const LAS u32x4*)(VT + j * 72 + sg * 8); } }
        const int tl = dir == 0 ? 63 : 0;
#pragma unroll
        for (int i = 0; i < 2; ++i) { const int dg = (tid + 512 * i) >> 6, s = lane;
            const f32x4 c0 = *(const LAS f32x4*)(CUM + s * 132 + dg * 8), c1 = *(const LAS f32x4*)(CUM + s * 132 + dg * 8 + 4);
            const f32x4 l0 = *(const LAS f32x4*)(CUM + tl * 132 + dg * 8), l1 = *(const LAS f32x4*)(CUM + tl * 132 + dg * 8 + 4);
            const float qf[8] = {bflo(qv[i].x), bfhi(qv[i].x), bflo(qv[i].y), bfhi(qv[i].y), bflo(qv[i].z), bfhi(qv[i].z), bflo(qv[i].w), bfhi(qv[i].w)};
            const float kf[8] = {bflo(kv[i].x), bfhi(kv[i].x), bflo(kv[i].y), bfhi(kv[i].y), bflo(kv[i].z), bfhi(kv[i].z), bflo(kv[i].w), bfhi(kv[i].w)};
            const float cc[8] = {c0.x, c0.y, c0.z, c0.w, c1.x, c1.y, c1.z, c1.w}, cl[8] = {l0.x, l0.y, l0.z, l0.w, l1.x, l1.y, l1.z, l1.w};
            float qp[8], ki[8], ke[8];
#pragma unroll
            for (int e = 0; e < 8; ++e) { qp[e] = qf[e] * __expf(cc[e]); ki[e] = kf[e] * __expf(fminf(-cc[e], 80.f)); ke[e] = kf[e] * __expf(cl[e] - cc[e]); }
            u32x4 w; w.x = cvt_pk_bf16(qp[0], qp[1]); w.y = cvt_pk_bf16(qp[2], qp[3]); w.z = cvt_pk_bf16(qp[4], qp[5]); w.w = cvt_pk_bf16(qp[6], qp[7]);
            *(LAS u32x4*)(QP + s * 136 + dg * 8) = w;
            *(u32x4*)(QAF + ((((size_t)un * 4 + (s >> 4)) * 10 + dir * 4 + (dg >> 2)) * 64 + (dg & 3) * 16 + (s & 15)) * 8) = w;
            u32x4 w2; w2.x = cvt_pk_bf16(ki[0], ki[1]); w2.y = cvt_pk_bf16(ki[2], ki[3]); w2.z = cvt_pk_bf16(ki[4], ki[5]); w2.w = cvt_pk_bf16(ki[6], ki[7]);
            *(LAS u32x4*)(KI + s * 136 + dg * 8) = w2;
#pragma unroll
            for (int e = 0; e < 8; ++e) KT[(dg * 8 + e) * 72 + s] = (bf16_t)f2bf(ke[e]);
            if (s == tl) { float* dp = DEC + ((size_t)un * 2 + dir) * 128 + dg * 8;
                *(f32x4*)dp = (f32x4){__expf(cl[0]), __expf(cl[1]), __expf(cl[2]), __expf(cl[3])}; *(f32x4*)(dp + 4) = (f32x4){__expf(cl[4]), __expf(cl[5]), __expf(cl[6]), __expf(cl[7])}; } }
        __syncthreads();
        { const int tb = wid >> 1;
#pragma unroll
          for (int x = 0; x < 2; ++x) { const int sb = (wid & 1) * 2 + x; f32x4 a = (f32x4){0.f, 0.f, 0.f, 0.f};
#pragma unroll
              for (int ks = 0; ks < 4; ++ks) { const bf16x8 Af = *(const LAS bf16x8*)(QP + (tb * 16 + fr) * 136 + ks * 32 + fq * 8), Bf = *(const LAS bf16x8*)(KI + (sb * 16 + fr) * 136 + ks * 32 + fq * 8);
                  a = __builtin_amdgcn_mfma_f32_16x16x32_bf16(Af, Bf, a, 0, 0, 0); }
#pragma unroll
              for (int jj = 0; jj < 4; ++jj) { const int t = tb * 16 + 4 * fq + jj, sx = sb * 16 + fr; const bool keep = dir == 0 ? (sx <= t) : (sx >= t); Aacc[x][jj] += keep ? a[jj] : 0.f; } } }
#pragma unroll
        for (int jbi = 0; jbi < 2; ++jbi) { const int jb = wid * 2 + jbi;
            const bf16x8 Bf0 = *(const LAS bf16x8*)(VT + (jb * 16 + fr) * 72 + fq * 8), Bf1 = *(const LAS bf16x8*)(VT + (jb * 16 + fr) * 72 + 32 + fq * 8);
#pragma unroll
            for (int db = 0; db < 8; ++db) { const bf16x8 Af0 = *(const LAS bf16x8*)(KT + (db * 16 + fr) * 72 + fq * 8), Af1 = *(const LAS bf16x8*)(KT + (db * 16 + fr) * 72 + 32 + fq * 8);
                f32x4 a = (f32x4){0.f, 0.f, 0.f, 0.f};
                a = __builtin_amdgcn_mfma_f32_16x16x32_bf16(Af0, Bf0, a, 0, 0, 0); a = __builtin_amdgcn_mfma_f32_16x16x32_bf16(Af1, Bf1, a, 0, 0, 0);
                u32x2 w; w.x = cvt_pk_bf16(a.x, a.y); w.y = cvt_pk_bf16(a.z, a.w);
                *(u32x2*)(DSF + (((((size_t)un * 2 + dir) * 16 + jb) * 4 + (db >> 1)) * 64 + ((db & 1) * 2 + (fq >> 1)) * 16 + fr) * 8 + (fq & 1) * 4) = w; } }
        __syncthreads();
    }
    { const int tb = wid >> 1;
#pragma unroll
      for (int x = 0; x < 2; ++x) { const int sb = (wid & 1) * 2 + x;
#pragma unroll
          for (int jj = 0; jj < 4; ++jj) AS[(tb * 16 + 4 * fq + jj) * 72 + sb * 16 + fr] = (bf16_t)f2bf(Aacc[x][jj]); } }
    __syncthreads();
    { const int t = tid >> 3, sg = tid & 7;
      *(u32x4*)(QAF + ((((size_t)un * 4 + (t >> 4)) * 10 + 8 + (sg >> 2)) * 64 + (sg & 3) * 16 + (t & 15)) * 8) = *(const LAS u32x4*)(AS + t * 72 + sg * 8); }
    __syncthreads();
}
__device__ __forceinline__ void gla_g3_unit(const int wv, LAS unsigned char* lds, int un, const bf16_t* QAF, const bf16_t* BTF, const bf16_t* U, const float* gain, bf16_t* Y) {
    int tid = my_tid(wv);
    const int lane = tid & 63, wid = __builtin_amdgcn_readfirstlane(tid >> 6), fr = lane & 15, fq = lane >> 4;
    const int bh = un / NCH, c = un % NCH, b = bh >> 2, h = bh & 3, row0 = gla_row0(b, c);
    const int tb = wid & 3, jh = wid >> 2;
    const bf16_t* qa = QAF + ((size_t)un * 4 + tb) * 10 * 512 + lane * 8;
    const bf16_t* bt = BTF + ((size_t)un * 16 + jh * 8) * 10 * 512 + lane * 8;
    f32x4 acc[8];
#pragma unroll
    for (int jb = 0; jb < 8; ++jb) acc[jb] = (f32x4){0.f, 0.f, 0.f, 0.f};
    bf16x8 Bc = *(const bf16x8*)qa, Ac[8];
#pragma unroll
    for (int jb = 0; jb < 8; ++jb) Ac[jb] = *(const bf16x8*)(bt + (size_t)jb * 10 * 512);
#pragma unroll
    for (int ks = 0; ks < 10; ++ks) {
        bf16x8 Bn = Bc, An[8];
#pragma unroll
        for (int jb = 0; jb < 8; ++jb) An[jb] = Ac[jb];
        if (ks < 9) { Bn = *(const bf16x8*)(qa + (ks + 1) * 512);
#pragma unroll
            for (int jb = 0; jb < 8; ++jb) An[jb] = *(const bf16x8*)(bt + ((size_t)jb * 10 + ks + 1) * 512); }
#pragma unroll
        for (int jb = 0; jb < 8; ++jb) acc[jb] = __builtin_amdgcn_mfma_f32_16x16x32_bf16(Ac[jb], Bc, acc[jb], 0, 0, 0);
        Bc = Bn;
#pragma unroll
        for (int jb = 0; jb < 8; ++jb) Ac[jb] = An[jb];
    }
    float ss = 0.f;
#pragma unroll
    for (int jb = 0; jb < 8; ++jb) ss += (acc[jb].x * acc[jb].x + acc[jb].y * acc[jb].y) + (acc[jb].z * acc[jb].z + acc[jb].w * acc[jb].w);
    ss += __shfl_xor(ss, 16); ss += __shfl_xor(ss, 32);
    LAS float* P = (LAS float*)lds;
    if (fq == 0) P[wid * 16 + fr] = ss;
    __syncthreads();
    const float tot = P[wid * 16 + fr] + P[(wid ^ 4) * 16 + fr];
    const float rstd = 1.0f / sqrtf(tot * (1.f / DV) + EPS);
    const int row = row0 + tb * 16 + fr;
#pragma unroll
    for (int jb = 0; jb < 8; ++jb) { const int col = h * DV + jh * 128 + jb * 16 + 4 * fq;
        const f32x4 gn = *(const f32x4*)(gain + col); const u32x2 gw = *(const u32x2*)(U + (size_t)row * INWP + C_G + col);
        const f32x4 o = acc[jb] * rstd * gn;
        u32x2 w; w.x = cvt_pk_bf16(o.x * siluf(bflo(gw.x)), o.y * siluf(bfhi(gw.x))); w.y = cvt_pk_bf16(o.z * siluf(bflo(gw.y)), o.w * siluf(bfhi(gw.y)));
        *(u32x2*)(Y + (size_t)row * D + col) = w; }
    __syncthreads();
}

__device__ __forceinline__ const void* ldptr(volatile LAS unsigned long long* tab, int i) {
    const unsigned long long v = tab[i];
    const unsigned lo = __builtin_amdgcn_readfirstlane((unsigned)v), hi = __builtin_amdgcn_readfirstlane((unsigned)(v >> 32));
    return (const void*)(((unsigned long long)hi << 32) | lo);
}
constexpr int CVT_TILE_F = 128 * 33;
__device__ __forceinline__ void cvt_item(LAS float* t, int lane, const float* srcb, bf16_t* dstb, size_t sms, size_t dms, int K, int N, int nb, int rs, int off, int ktiles, int per, int it) {
    const int lr = lane >> 4, lc = (lane & 15) * 4;
    const int sr = lane >> 3, sk = (lane & 7) * 8;
    const int mat = it / per, r = it % per, nt = r / ktiles, kt = r % ktiles, k0 = kt * 64, n0 = nt * 64;
    const float* src = srcb + (size_t)mat * sms + (size_t)(k0 + lr) * N + n0 + lc;
    const bool inb = (n0 + lc) < N;
    f32x4 v[16];
#pragma unroll
    for (int i = 0; i < 16; ++i) v[i] = inb ? __builtin_nontemporal_load((const f32x4*)(src + (size_t)(4 * i) * N)) : (f32x4){0.f, 0.f, 0.f, 0.f};
#pragma unroll
    for (int i = 0; i < 16; ++i) { LAS float* tp = t + (lr + 4 * i) * 65 + lc; tp[0] = v[i].x; tp[1] = v[i].y; tp[2] = v[i].z; tp[3] = v[i].w; }
    asm volatile("s_waitcnt lgkmcnt(0)" ::: "memory");
    bf16_t* dst = dstb + (size_t)mat * dms;
#pragma unroll
    for (int p = 0; p < 8; ++p) { const int nn = sr + 8 * p, n = n0 + nn; const int drow = (n / nb) * rs + (n % nb) + off;
        const LAS float* tp = t + sk * 65 + nn;
        u32x4 w; w.x = cvt_pk_bf16(tp[0], tp[65]); w.y = cvt_pk_bf16(tp[2 * 65], tp[3 * 65]); w.z = cvt_pk_bf16(tp[4 * 65], tp[5 * 65]); w.w = cvt_pk_bf16(tp[6 * 65], tp[7 * 65]);
        __builtin_nontemporal_store(w, (u32x4*)(dst + (size_t)drow * K + k0 + sk)); }
    asm volatile("s_waitcnt lgkmcnt(0)" ::: "memory");
}
__device__ __forceinline__ void p_convert(const int wv, LAS unsigned char* lds, const float* srcb, bf16_t* dstb, size_t sms, size_t dms, int K, int N, int NP, int nb, int rs, int off, int nmat) {
    int tid = my_tid(wv);
    const int lane = tid & 63, wave = tid >> 6;
    LAS float* t = (LAS float*)lds + wave * CVT_TILE_F;
    const int ktiles = K / 64, ntiles = NP / 64, per = ktiles * ntiles, total = per * nmat;
    for (int it = blockIdx.x * 8 + wave; it < total; it += gridDim.x * 8) cvt_item(t, lane, srcb, dstb, sms, dms, K, N, nb, rs, off, ktiles, per, it);
}
__device__ __forceinline__ void cvt8_item(LAS float* t, int lane, const float* srcb, unsigned char* dstb, size_t sms, size_t dms, int K, int N, int nb, int rs, int off, int ktiles, int per, int it) {
    const int lr = lane >> 3, lc = (lane & 7) * 4;
    const int sr = lane >> 3, sk = (lane & 7) * 16;
    const int mat = it / per, r = it % per, nt = r / ktiles, kt = r % ktiles, k0 = kt * 128, n0 = nt * 32;
    const float* src = srcb + (size_t)mat * sms + (size_t)(k0 + lr) * N + n0 + lc;
    f32x4 v[16];
#pragma unroll
    for (int i = 0; i < 16; ++i) v[i] = __builtin_nontemporal_load((const f32x4*)(src + (size_t)(8 * i) * N));
#pragma unroll
    for (int i = 0; i < 16; ++i) { LAS float* tp = t + (lr + 8 * i) * 33 + lc; tp[0] = v[i].x * 64.f; tp[1] = v[i].y * 64.f; tp[2] = v[i].z * 64.f; tp[3] = v[i].w * 64.f; }
    asm volatile("s_waitcnt lgkmcnt(0)" ::: "memory");
    unsigned char* dst = dstb + (size_t)mat * dms;
#pragma unroll
    for (int p = 0; p < 4; ++p) { const int nn = sr + 8 * p, n = n0 + nn; const int drow = (n / nb) * rs + (n % nb) + off;
        const LAS float* tp = t + sk * 33 + nn;
        unsigned w[4];
#pragma unroll
        for (int q = 0; q < 4; ++q) { int x = 0; x = __builtin_amdgcn_cvt_pk_fp8_f32(tp[(4 * q) * 33], tp[(4 * q + 1) * 33], x, false); x = __builtin_amdgcn_cvt_pk_fp8_f32(tp[(4 * q + 2) * 33], tp[(4 * q + 3) * 33], x, true); w[q] = (unsigned)x; }
        __builtin_nontemporal_store((u32x4){w[0], w[1], w[2], w[3]}, (u32x4*)(dst + (size_t)drow * K + k0 + sk)); }
    asm volatile("s_waitcnt lgkmcnt(0)" ::: "memory");
}
constexpr int CW_Q = 2048, CW_DONE = 2112;
constexpr int QJ_WOUT = (D / 64) * (D / 64), QJ_F13 = (D / 64) * (DFF / 64), QJ_WIN = (D / 64) * (INWP / 64), QJ_MOE = NE * QJ_F13;
constexpr int Q_WOUT0 = QJ_WOUT, Q_F3 = Q_WOUT0 + 2 * QJ_F13, Q_F2 = Q_F3 + QJ_F13, Q_WIN1 = Q_F2 + QJ_WIN, Q_WOUT1 = Q_WIN1 + QJ_WOUT, Q_ALL = Q_WOUT1 + 3 * QJ_MOE;
__device__ __forceinline__ void q_item(LAS float* t, int lane, int item, volatile LAS unsigned long long* PT) {
    unsigned char* ws = (unsigned char*)ldptr(PT, 25);
    const float* src; bf16_t* dst; size_t sms = 0, dms = 0; int K = D, N = D, NP = D, nb = 1 << 30, rs = 0, off = 0, it = item;
    if (item < Q_WOUT0) { src = (const float*)ldptr(PT, 14); dst = (bf16_t*)(ws + WS_WOUT); }
    else if (item < Q_F3) { const int j = (item - Q_WOUT0) / QJ_F13; it = item - Q_WOUT0 - j * QJ_F13; src = (const float*)ldptr(PT, 15 + j); dst = (bf16_t*)(ws + WS_W13); N = DFF; NP = DFF; nb = 128; rs = 256; off = j * 128; }
    else if (item < Q_F2) { it = item - Q_F3; cvt8_item(t, lane, (const float*)ldptr(PT, 17), ws + WS_W2, 0, 0, DFF, D, 1 << 30, 0, 0, DFF / 128, (DFF / 128) * (D / 32), it); return; }
    else if (item < Q_WIN1) { it = item - Q_F2; src = (const float*)ldptr(PT, 8) + (size_t)D * INW; dst = (bf16_t*)(ws + WS_WIN) + (size_t)INWP * D; N = INW; NP = INWP; }
    else if (item < Q_WOUT1) { it = item - Q_WIN1; src = (const float*)ldptr(PT, 14) + (size_t)D * D; dst = (bf16_t*)(ws + WS_WOUT) + (size_t)D * D; }
    else { const int j = (item - Q_WOUT1) / QJ_MOE; it = item - Q_WOUT1 - j * QJ_MOE; src = (const float*)ldptr(PT, 20 + j); sms = (size_t)D * DFF;
        if (j < 2) { cvt8_item(t, lane, src, ws + WS_MW13, sms, (size_t)2 * DFF * D, D, DFF, 128, 256, j * 128, D / 128, (D / 128) * (DFF / 32), it); return; }
        cvt8_item(t, lane, src, ws + WS_MW2, sms, (size_t)D * DFF, DFF, D, 1 << 30, 0, 0, DFF / 128, (DFF / 128) * (D / 32), it); return; }
    cvt_item(t, lane, src, dst, sms, dms, K, N, nb, rs, off, K / 64, (K / 64) * (NP / 64), it);
}
__device__ __forceinline__ void q_help(const int wv, LAS unsigned char* lds, volatile LAS unsigned long long* PT, int phase, int LIMIT, int qoff = 0) {
    int tid = my_tid(wv);
    const int lane = tid & 63, wave = __builtin_amdgcn_readfirstlane(tid >> 6);
    LAS float* t = (LAS float*)lds + wave * CVT_TILE_F;
    volatile LAS unsigned* MISC = (volatile LAS unsigned*)(lds + LDS_MISC);
    unsigned* ctl = (unsigned*)((unsigned char*)ldptr(PT, 25) + WS_CTL);
    const unsigned G = gridDim.x;
    const unsigned per_wave = LIMIT < 0 ? 1u : 6u;
    __syncthreads();
    if (LIMIT < 0 && tid == 0) (void)__hip_atomic_fetch_add(ctl + CW_DONE + 64 * phase, 1u, __ATOMIC_RELAXED, __HIP_MEMORY_SCOPE_AGENT);
    for (;;) {
        if (tid == 0) { unsigned base = 0xffffffffu;
            const bool pull = LIMIT < 0 ? __hip_atomic_load(ctl + CW_DONE + 64 * phase, __ATOMIC_RELAXED, __HIP_MEMORY_SCOPE_AGENT) < G
                                        : __hip_atomic_load(ctl + CW_Q + qoff, __ATOMIC_RELAXED, __HIP_MEMORY_SCOPE_AGENT) < (unsigned)LIMIT;
            if (pull) base = __hip_atomic_fetch_add(ctl + CW_Q + qoff, 8u * per_wave, __ATOMIC_RELAXED, __HIP_MEMORY_SCOPE_AGENT);
            MISC[4] = base; }
        __syncthreads();
        const unsigned base = MISC[4];
        __syncthreads();
        if (base == 0xffffffffu) break;
#pragma unroll 1
        for (unsigned k = 0; k < per_wave; ++k) { const unsigned item = base + 8u * k + wave; if (item < (unsigned)Q_ALL) q_item(t, lane, (int)item, PT); }
        if (base >= (unsigned)Q_ALL) break;
    }
}
__device__ __forceinline__ void p_ada(const int wv, LAS unsigned char* lds, const float* c, const float* c_ctx, const float* w_ada, const float* b_ada, float* modv) {
    int tid = my_tid(wv);
    LAS float* scv = (LAS float*)lds; LAS float* red = scv + 3 * D;
    for (int i = tid; i < 3 * D; i += 512) { const int r = i / D, k = i % D; const float v = r < 2 ? c[r * D + k] : c_ctx[k]; scv[i] = v / (1.f + expf(-v)); }
    __syncthreads();
    for (int cb = blockIdx.x; cb < 2 * MODW / 96; cb += gridDim.x) {
        const int colg = cb * 96, l = colg / MODW, n0 = colg % MODW;
        if (tid < 504) { const int kg = tid / 24, c4 = tid % 24;
            f32x4 a0 = (f32x4){0.f, 0.f, 0.f, 0.f}, a1 = a0, a2 = a0;
            const float* w = w_ada + (size_t)l * D * MODW + n0 + c4 * 4;
            for (int i0 = 0; i0 < 98; i0 += 14) {
                f32x4 wv[14];
#pragma unroll
                for (int i = 0; i < 14; ++i) { const int k = kg + 21 * (i0 + i), kc = k < D ? k : D - 1; wv[i] = __builtin_nontemporal_load((const f32x4*)(w + (size_t)kc * MODW)); }
#pragma unroll
                for (int i = 0; i < 14; ++i) { const int k = kg + 21 * (i0 + i); const bool ok = k < D; const int kc = ok ? k : D - 1;
                    const float s0 = ok ? scv[kc] : 0.f, s1 = ok ? scv[D + kc] : 0.f, s2 = ok ? scv[2 * D + kc] : 0.f; a0 += wv[i] * s0; a1 += wv[i] * s1; a2 += wv[i] * s2; }
            }
            *(LAS f32x4*)(red + kg * 288 + c4 * 4) = a0; *(LAS f32x4*)(red + kg * 288 + 96 + c4 * 4) = a1; *(LAS f32x4*)(red + kg * 288 + 192 + c4 * 4) = a2; }
        __syncthreads();
        if (tid < 288) { const int r = tid / 96, cl = tid % 96; float sacc = 0.f;
#pragma unroll
            for (int kg = 0; kg < 21; ++kg) sacc += red[kg * 288 + tid];
            modv[((size_t)l * 3 + r) * MODW + n0 + cl] = sacc + b_ada[l * MODW + n0 + cl]; }
        __syncthreads();
    }
}
template <bool OUT8> __device__ __forceinline__ void p_ln(const int wv, LAS unsigned char* lds, const float* src_lat, const float* src_ctx, int ctx_row0, const float* gn, const float* sh, const float* sc, bf16_t* XN, int nrows) {
    int tz = my_tid(wv);
    const int lane = tz & 63, gw = blockIdx.x * 8 + (tz >> 6), NGW = gridDim.x * 8;
    LAS f32x4* SA = (LAS f32x4*)lds; LAS f32x4* SB = SA + 3 * (D / 4);
    __syncthreads();
    for (int q = tz; q < 3 * (D / 4); q += 512) { const int mi = q / (D / 4), c4 = q % (D / 4);
        const f32x4 g = *(const f32x4*)(gn + 4 * c4), a = *(const f32x4*)(sc + (size_t)mi * MODW + 4 * c4);
        SA[q] = g * (a + 1.0f); SB[q] = *(const f32x4*)(sh + (size_t)mi * MODW + 4 * c4); }
    __syncthreads();
    for (int row = gw; row < nrows; row += NGW) {
        const float* x = row < ML ? src_lat + (size_t)row * D : src_ctx + (size_t)(row - ctx_row0) * D;
        const int mi = mod_index(row);
        f32x4 v[8]; float s = 0.f;
#pragma unroll
        for (int j = 0; j < 8; ++j) { v[j] = *(const f32x4*)(x + 4 * lane + 256 * j); s += (v[j].x * v[j].x + v[j].y * v[j].y) + (v[j].z * v[j].z + v[j].w * v[j].w); }
        const float rstd = 1.0f / sqrtf(wave_sum(s) * (1.f / D) + EPS);
#pragma unroll
        for (int j = 0; j < 8; ++j) { const int cc = 4 * lane + 256 * j;
            const f32x4 h = v[j] * rstd * SA[mi * (D / 4) + lane + 64 * j] + SB[mi * (D / 4) + lane + 64 * j];
            if constexpr (OUT8) { int x8 = 0; x8 = __builtin_amdgcn_cvt_pk_fp8_f32(h.x, h.y, x8, false); x8 = __builtin_amdgcn_cvt_pk_fp8_f32(h.z, h.w, x8, true); *(unsigned*)((unsigned char*)XN + (size_t)row * D + cc) = (unsigned)x8; }
            else { u32x2 w; w.x = cvt_pk_bf16(h.x, h.y); w.y = cvt_pk_bf16(h.z, h.w); *(u32x2*)(XN + (size_t)row * D + cc) = w; } }
    }
}
__device__ __forceinline__ void p_gla_g2(const int wv, const bf16_t* DSF, const float* DEC, bf16_t* BTF) {
    int tz = my_tid(wv);
    for (int gi = blockIdx.x * 512 + tz; gi < 16 * 16 * 4 * 128; gi += gridDim.x * 512) {
        const int sl = gi & 127, kd = (gi >> 7) & 3, jb = (gi >> 9) & 15, chain = gi >> 13, dir = chain & 1, bh = chain >> 1;
        const int d = kd * 32 + (sl >> 5) * 8 + (sl & 1) * 4;
        f32x4 S = (f32x4){0.f, 0.f, 0.f, 0.f};
        for (int s0 = 0; s0 < NCH; s0 += 17) {
            f32x4 dec[17]; u32x2 q[17];
#pragma unroll
            for (int i = 0; i < 17; ++i) { const int step = s0 + i, c = dir == 0 ? step : (step < 4 ? 3 - step : 71 - step), un = bh * NCH + c;
                dec[i] = *(const f32x4*)(DEC + ((size_t)un * 2 + dir) * 128 + d);
                q[i] = __builtin_nontemporal_load((const u32x2*)(DSF + ((((size_t)un * 2 + dir) * 16 + jb) * 4 + kd) * 512 + sl * 4)); }
#pragma unroll
            for (int i = 0; i < 17; ++i) { const int step = s0 + i, c = dir == 0 ? step : (step < 4 ? 3 - step : 71 - step), un = bh * NCH + c;
                u32x2 w; w.x = cvt_pk_bf16(S.x, S.y); w.y = cvt_pk_bf16(S.z, S.w);
                *(u32x2*)(BTF + (((size_t)un * 16 + jb) * 10 + dir * 4 + kd) * 512 + sl * 4) = w;
                S = dec[i] * S + (f32x4){bflo(q[i].x), bfhi(q[i].x), bflo(q[i].y), bfhi(q[i].y)}; }
        }
    }
}
template <int W> __device__ __forceinline__ void pool_item(const bf16_t* U, bf16_t* MIX, int row, int ch) {
    int L, j, base;
    if (row < ML) { L = 64; j = row & 63; base = row - j; } else { L = CTXL; j = (row - ML) & (CTXL - 1); base = row - j; }
    const bf16_t* up = U + (size_t)base * INWP + C_P + ch;
    u32x4 q[W];
#pragma unroll
    for (int p = 0; p < W; ++p) { const int r = j - W / 2 + p; const bool ok = r >= 0 && r < L; q[p] = ok ? *(const u32x4*)(up + (size_t)r * INWP) : (u32x4){0u, 0u, 0u, 0u}; }
    float s[8];
#pragma unroll
    for (int i = 0; i < 8; ++i) s[i] = 0.f;
#pragma unroll
    for (int p = 0; p < W; ++p) { s[0] += bflo(q[p].x); s[1] += bfhi(q[p].x); s[2] += bflo(q[p].y); s[3] += bfhi(q[p].y); s[4] += bflo(q[p].z); s[5] += bfhi(q[p].z); s[6] += bflo(q[p].w); s[7] += bfhi(q[p].w); }
    int lo = j - W / 2, hi = lo + W; lo = lo < 0 ? 0 : lo; hi = hi > L ? L : hi;
    const u32x4 me = q[W / 2];
    const float inv = 1.f / (float)(hi - lo);
    u32x4 o; o.x = cvt_pk_bf16(s[0] * inv - bflo(me.x), s[1] * inv - bfhi(me.x)); o.y = cvt_pk_bf16(s[2] * inv - bflo(me.y), s[3] * inv - bfhi(me.y));
    o.z = cvt_pk_bf16(s[4] * inv - bflo(me.z), s[5] * inv - bfhi(me.z)); o.w = cvt_pk_bf16(s[6] * inv - bflo(me.w), s[7] * inv - bfhi(me.w));
    *(u32x4*)(MIX + (size_t)row * 1024 + ch) = o;
}
__device__ __forceinline__ void p_pool(const int wv, const bf16_t* U, bf16_t* MIX, int nrows) {
    int tz = my_tid(wv);
    const int per = nrows * 32;
    for (int gi = blockIdx.x * 512 + tz; gi < per; gi += gridDim.x * 512) { const int row = gi >> 5, cb = (gi & 31) * 8;
        pool_item<2>(U, MIX, row, cb); pool_item<4>(U, MIX, row, 256 + cb); pool_item<8>(U, MIX, row, 512 + cb); pool_item<16>(U, MIX, row, 768 + cb); }
}
__device__ __forceinline__ void p_router(const int wv, LAS unsigned char* lds, const float* XR, const float* gn, const float* sh, const float* sc, const float* w_r, const float* b_r, unsigned* cnt, int* list, float* gep, int* slot, unsigned char* XN8) {
    int tz = my_tid(wv);
    const int lane = tz & 63, gw = blockIdx.x * 8 + (tz >> 6), NGW = gridDim.x * 8;
    LAS f32x4* WR = (LAS f32x4*)lds;
    __syncthreads();
    for (int q = tz; q < 4096; q += 512) { const int ln = q & 63, j = (q >> 6) & 7, hf = (q >> 9) & 1, i = q >> 10;
        WR[q] = *(const f32x4*)(w_r + (size_t)(4 * ln + 256 * j + i) * 8 + 4 * hf); }
    LAS f32x4* SA = WR + 4096; LAS f32x4* SB = SA + 2 * (D / 4);
    for (int q = tz; q < 2 * (D / 4); q += 512) { const int mi = q / (D / 4), c4 = q % (D / 4);
        SA[q] = *(const f32x4*)(gn + 4 * c4) * (*(const f32x4*)(sc + (size_t)mi * MODW + 4 * c4) + 1.0f); SB[q] = *(const f32x4*)(sh + (size_t)mi * MODW + 4 * c4); }
    __syncthreads();
    for (int row = gw; row < ML; row += NGW) {
        const float* x = XR + (size_t)row * D; const int mi = mod_index(row);
        float s = 0.f;
#pragma unroll
        for (int j = 0; j < 8; ++j) { const f32x4 v = *(const f32x4*)(x + 4 * lane + 256 * j); s += (v.x * v.x + v.y * v.y) + (v.z * v.z + v.w * v.w); }
        const float rstd = 1.0f / sqrtf(wave_sum(s) * (1.f / D) + EPS);
        float lg0 = 0.f, lg1 = 0.f, lg2 = 0.f, lg3 = 0.f, lg4 = 0.f, lg5 = 0.f, lg6 = 0.f, lg7 = 0.f;
#pragma unroll 1
        for (int j = 0; j < 8; ++j) { const int cc = 4 * lane + 256 * j;
            const f32x4 v = *(const f32x4*)(x + cc);
            const f32x4 h = v * rstd * SA[mi * (D / 4) + lane + 64 * j] + SB[mi * (D / 4) + lane + 64 * j];
            { int x8 = 0; x8 = __builtin_amdgcn_cvt_pk_fp8_f32(h.x, h.y, x8, false); x8 = __builtin_amdgcn_cvt_pk_fp8_f32(h.z, h.w, x8, true); *(unsigned*)(XN8 + (size_t)row * D + cc) = (unsigned)x8; }
#pragma unroll
            for (int i = 0; i < 4; ++i) { const f32x4 w0 = WR[((i * 2 + 0) * 8 + j) * 64 + lane], w1 = WR[((i * 2 + 1) * 8 + j) * 64 + lane];
                lg0 += h[i] * w0.x; lg1 += h[i] * w0.y; lg2 += h[i] * w0.z; lg3 += h[i] * w0.w; lg4 += h[i] * w1.x; lg5 += h[i] * w1.y; lg6 += h[i] * w1.z; lg7 += h[i] * w1.w; } }
        float lg[8] = {lg0, lg1, lg2, lg3, lg4, lg5, lg6, lg7};
#pragma unroll
        for (int e = 0; e < 8; ++e) lg[e] = wave_sum(lg[e]) + b_r[e];
        int i0 = 0; float m0 = lg[0];
#pragma unroll
        for (int e = 1; e < 8; ++e) if (lg[e] > m0) { m0 = lg[e]; i0 = e; }
        int i1 = -1; float m1 = -3.0e38f;
#pragma unroll
        for (int e = 0; e < 8; ++e) if (e != i0 && lg[e] > m1) { m1 = lg[e]; i1 = e; }
        const float p1 = expf(m1 - m0), g0 = 1.f / (1.f + p1), g1 = p1 / (1.f + p1);
        if (lane == 0) {
            const unsigned q0 = atomicAdd(cnt + 64 * i0, 1u), q1 = atomicAdd(cnt + 64 * i1, 1u);
            list[(size_t)i0 * 8192 + q0] = row; list[(size_t)i1 * 8192 + q1] = row; gep[(size_t)i0 * 8192 + q0] = g0; gep[(size_t)i1 * 8192 + q1] = g1;
            slot[row * 2] = i0 * 8192 + (int)q0; slot[row * 2 + 1] = i1 * 8192 + (int)q1; }
    }
}
__device__ __forceinline__ void p_final(const int wv, LAS unsigned char* lds, const float* XR, const bf16_t* YD, const int* slot, const float* gep, const unsigned* cnt, const float* g2, const float* gn, float* out) {
    int tz = my_tid(wv);
    const int lane = tz & 63, gw = blockIdx.x * 8 + (tz >> 6), NGW = gridDim.x * 8;
    LAS f32x4* G2 = (LAS f32x4*)lds; LAS f32x4* FG = G2 + 2 * (D / 4);
    __syncthreads();
    for (int q = tz; q < 3 * (D / 4); q += 512) { const int mi = q / (D / 4), c4 = q % (D / 4); G2[q] = mi < 2 ? *(const f32x4*)(g2 + (size_t)mi * MODW + 4 * c4) : *(const f32x4*)(gn + 4 * c4); }
    __syncthreads();
    for (int row = gw; row < ML; row += NGW) {
        const float* x = XR + (size_t)row * D; const int mi = mod_index(row);
        const int s0 = slot[row * 2], s1 = slot[row * 2 + 1], e0 = s0 >> 13, e1 = s1 >> 13;
        const float ga = gep[s0], gb = gep[s1];
        int h0 = 0, h1 = 0;
#pragma unroll
        for (int e = 0; e < NE; ++e) { const int r = ((int)cnt[64 * e] + 255) >> 8; h0 += e < e0 ? r : 0; h1 += e < e1 ? r : 0; }
        const bf16_t* y0 = YD + ((size_t)h0 * 256 + (s0 & 8191)) * D; const bf16_t* y1 = YD + ((size_t)h1 * 256 + (s1 & 8191)) * D;
        f32x4 v[8]; float s = 0.f;
#pragma unroll
        for (int j = 0; j < 8; ++j) { const int cc = 4 * lane + 256 * j; const u32x2 a = *(const u32x2*)(y0 + cc), b = *(const u32x2*)(y1 + cc);
            const f32x4 ya = (f32x4){ga * bflo(a.x) + gb * bflo(b.x), ga * bfhi(a.x) + gb * bfhi(b.x), ga * bflo(a.y) + gb * bflo(b.y), ga * bfhi(a.y) + gb * bfhi(b.y)};
            v[j] = *(const f32x4*)(x + cc) + G2[mi * (D / 4) + lane + 64 * j] * ya;
            s += (v[j].x * v[j].x + v[j].y * v[j].y) + (v[j].z * v[j].z + v[j].w * v[j].w); }
        const float rstd = 1.0f / sqrtf(wave_sum(s) * (1.f / D) + EPS);
#pragma unroll
        for (int j = 0; j < 8; ++j) { const int cc = 4 * lane + 256 * j; *(f32x4*)(out + (size_t)row * D + cc) = v[j] * rstd * FG[lane + 64 * j]; }
    }
}

#define XB_TMO      128
#define XB_XCNT(j)  (256  + 64 * (j))
#define XB_XSUB(j)  (1280 + 64 * (j))
#define XB_XGEN(j)  (2304 + 64 * (j))
#define XB_TOP      3328
#define XB_TOPGEN   3392
#define XCD_BAR_WORDS 3456
#define XB_SPIN_CAP (1u << 18)

__device__ __forceinline__ unsigned xb_ld(unsigned* p)              { return __hip_atomic_load(p, __ATOMIC_RELAXED, __HIP_MEMORY_SCOPE_AGENT); }
__device__ __forceinline__ unsigned xb_add(unsigned* p, unsigned v) { return __hip_atomic_fetch_add(p, v, __ATOMIC_RELAXED, __HIP_MEMORY_SCOPE_AGENT); }
__device__ __forceinline__ unsigned xb_xcc_id() { return (unsigned)__builtin_amdgcn_s_getreg((3 << 11) | 20) & 0xFu; }
#define XB_SPIN(cond, bar) do { unsigned _sp = 0; while (cond) { __builtin_amdgcn_s_sleep(1); \
    if ((++_sp & 255u) == 0u) { if (xb_ld(&(bar)[XB_TMO])) break; if (_sp > XB_SPIN_CAP) { atomicAdd(&(bar)[XB_TMO], 1u); break; } } } } while (0)

struct XcdBarrier {
    unsigned* bar; unsigned x;
    volatile LAS unsigned* st;
};

__device__ __forceinline__ XcdBarrier xcd_barrier_post(unsigned* bar, volatile LAS unsigned* st) {
    XcdBarrier b; b.bar = bar; b.x = xb_xcc_id(); b.st = st;
    if (threadIdx.x == 0) (void)xb_add(&bar[XB_XCNT(b.x)], 1u);
    return b;
}
__device__ __forceinline__ void xcd_barrier_complete(unsigned* bar, unsigned x, unsigned& nloc, unsigned& nx) {
    const unsigned G = gridDim.x * gridDim.y * gridDim.z;
    unsigned sum, cnt, mine, sp = 0u;
    for (;;) {
        sum = 0u; cnt = 0u; mine = 0u;
#pragma unroll
        for (unsigned j = 0; j < 16; ++j) { const unsigned c = xb_ld(&bar[XB_XCNT(j)]); sum += c; cnt += (c > 0u) ? 1u : 0u; mine = (j == x) ? c : mine; }
        if (sum == G) break;
        __builtin_amdgcn_s_sleep(1);
        if ((++sp & 255u) == 0u) { if (xb_ld(&bar[XB_TMO])) break; if (sp > XB_SPIN_CAP) { atomicAdd(&bar[XB_TMO], 1u); break; } }
    }
    nloc = mine > 0u ? mine : 1u; nx = cnt > 0u ? cnt : 1u;
}

__device__ __forceinline__ void xcd_barrier(const XcdBarrier& b, const int wv) {
    asm volatile("s_waitcnt vmcnt(0)" ::: "memory");
    __syncthreads();
    if (my_tid(wv) == 0) {
        unsigned* bar = b.bar;
        __builtin_amdgcn_s_waitcnt(0);
        unsigned nloc = b.st[0], nx = b.st[1];
        if (nloc == 0u) { xcd_barrier_complete(bar, b.x, nloc, nx); b.st[0] = nloc; b.st[1] = nx; }
        const unsigned old = xb_add(&bar[XB_XSUB(b.x)], 1u);
        const unsigned gen = old / nloc;
        if (old + 1u == (gen + 1u) * nloc) {
            __builtin_amdgcn_fence(__ATOMIC_RELEASE, "agent");
            asm volatile("s_waitcnt vmcnt(0)" ::: "memory");
            const unsigned og = xb_add(&bar[XB_TOP], 1u);
            const unsigned tg = og / nx;
            if (og + 1u == (tg + 1u) * nx) xb_add(&bar[XB_TOPGEN], 1u);
            else XB_SPIN(xb_ld(&bar[XB_TOPGEN]) == tg, bar);
            __builtin_amdgcn_fence(__ATOMIC_ACQUIRE, "agent");
            xb_add(&bar[XB_XGEN(b.x)], 1u);
            asm volatile("s_waitcnt vmcnt(0)" ::: "memory");
        } else {
            XB_SPIN(xb_ld(&bar[XB_XGEN(b.x)]) == gen, bar);
            __builtin_amdgcn_fence(__ATOMIC_ACQUIRE, "agent");
            asm volatile("s_waitcnt vmcnt(0)" ::: "memory");
        }
    }
    __syncthreads();
}

constexpr int CW_BAR = 4096;
constexpr int LDS_BYTES = LDS_MISC + 64 + 256;
static_assert(MOE_LDS <= LDS_MISC && G1_LDS <= LDS_MISC, "LDS map");
#ifndef MK_PER_PHASE
#define MK_PER_PHASE 0
#endif
constexpr int NPHASE = 20;

#define RUN(p) (lo <= (p) && (p) < hi)
#define SEAM(p) do { if (RUN(p) && RUN((p) + 1)) xcd_barrier(bar, wv); } while (0)
#define PTR(i) ((const float*)ldptr(PT, (i)))
#define WSP ((unsigned char*)ldptr(PT, 25))
#define HELP(ph) q_help(wv, lds, PT, (ph), -1)
#define DRAINQ(n) q_help(wv, lds, PT, 0, (n))
template <int l> __device__ __forceinline__ void layer_phases(const int wv, LAS unsigned char* lds, volatile LAS unsigned long long* PT, const int lo, const int hi, const XcdBarrier& bar, const int G, const int blk) {
        const int pb = 1 + 9 * l;
        const int ctx_row0 = l == 0 ? ML : 0;
        const int nMo = (l == 0) ? MA / 256 : ML / 256;
        if (RUN(pb + 0)) { unsigned char* ws = WSP; const float* modv_l = (const float*)(ws + WS_MODV) + (size_t)l * 3 * MODW; const float* XRc = (const float*)(ws + WS_XR);
            p_ln<false>(wv, lds, l == 0 ? PTR(0) : XRc, l == 0 ? PTR(2) : XRc, ctx_row0, PTR(6) + l * D, modv_l + 0, modv_l + D, (bf16_t*)(ws + WS_XN), MA);
            if constexpr (l == 1) DRAINQ(Q_WIN1); }
        SEAM(pb + 0);
        if (RUN(pb + 1)) { unsigned char* ws = WSP;
            pg8::TileOrder S; S.A = (const char*)(ws + WS_XN); S.Bt = (const char*)((bf16_t*)(ws + WS_WIN) + (size_t)l * INWP * D); S.a_mstep = (size_t)256 * D * 2; S.a_nstep = 0; S.b_nstep = (size_t)256 * D * 2;
            S.nM = MA / 256; S.nN = INWP / 256; S.nwg = S.nM * S.nN; S.G = G; S.c = blk;
            pg8::Gemm g; g.K = D; g.lda = D; g.ldb = D; g.pad = 0;
            EpiIn E; E.U = (bf16_t*)(ws + WS_U); E.R = (float*)(ws + WS_R);
            pg8::gemm_phase<EpiIn, pg8::TileOrder, true>(wv, lds, g, S, E);
            HELP(pb + 1);
        }
        SEAM(pb + 1);
        if (RUN(pb + 2)) { unsigned char* ws = WSP; const float* wgp = PTR(9) + (size_t)l * 2 * 16 * 512; const float* bgp = PTR(10) + (size_t)l * 2 * 512;
            for (int un = blk; un < NUN; un += G) gla_g1_unit(wv, lds, un, (const bf16_t*)(ws + WS_U), (const float*)(ws + WS_R), wgp, bgp, (bf16_t*)(ws + WS_QA), (bf16_t*)(ws + WS_BT), (bf16_t*)(ws + WS_DS), (float*)(ws + WS_DEC));
            p_pool(wv, (const bf16_t*)(ws + WS_U), (bf16_t*)(ws + WS_MIX), MA);
        }
        SEAM(pb + 2);
        if (RUN(pb + 3)) { unsigned char* ws = WSP;
            p_gla_g2(wv, (const bf16_t*)(ws + WS_DS), (const float*)(ws + WS_DEC), (bf16_t*)(ws + WS_BT));
        }
        SEAM(pb + 3);
        if (RUN(pb + 4)) { unsigned char* ws = WSP; const float* gain = PTR(11) + l * 1024;
            if (blk >= G - 136) { pg8::TileOrder S; S.A = (const char*)(ws + WS_MIX); S.Bt = (const char*)((bf16_t*)(ws + WS_WPOOL) + (size_t)l * 4 * 256 * 256); S.a_mstep = (size_t)256 * 1024 * 2; S.a_nstep = (size_t)256 * 2; S.b_nstep = (size_t)256 * 256 * 2;
              S.nM = MA / 256; S.nN = 4; S.nwg = S.nM * S.nN; S.G = 136; S.c = blk - (G - 136);
              pg8::Gemm g; g.K = 256; g.lda = 1024; g.ldb = 256; g.pad = 0;
              EpiPool E; E.Y = (bf16_t*)(ws + WS_Y); E.scale = PTR(13) + l * 1024;
              pg8::gemm_phase<EpiPool, pg8::TileOrder, true>(wv, lds, g, S, E); }
            for (int un = blk; un < NUN; un += G) { if (l == 1 && (un % NCH) < 4) continue; gla_g3_unit(wv, lds, un, (const bf16_t*)(ws + WS_QA), (const bf16_t*)(ws + WS_BT), (const bf16_t*)(ws + WS_U), gain, (bf16_t*)(ws + WS_Y)); }
            DRAINQ(l == 0 ? Q_WOUT0 : Q_WOUT1);
        }
        SEAM(pb + 4);
        if (RUN(pb + 5)) { unsigned char* ws = WSP; const float* modv_l = (const float*)(ws + WS_MODV) + (size_t)l * 3 * MODW; float* XR = (float*)(ws + WS_XR);
            pg8::TileOrder S; S.A = (const char*)(ws + WS_Y); S.Bt = (const char*)((bf16_t*)(ws + WS_WOUT) + (size_t)l * D * D); S.a_mstep = (size_t)256 * D * 2; S.a_nstep = 0; S.b_nstep = (size_t)256 * D * 2;
            S.nM = nMo; S.nN = D / 256; S.nwg = S.nM * S.nN; S.G = G; S.c = blk;
            pg8::Gemm g; g.K = D; g.lda = D; g.ldb = D; g.pad = 0;
            EpiResid E; E.src_lat = l == 0 ? PTR(0) : XR; E.src_ctx = l == 0 ? PTR(2) : XR; E.XR = XR; E.gate = modv_l + 2 * D; E.rowgate = nullptr; E.rg_stride = 0; E.ctx_row0 = ctx_row0;
            pg8::gemm_phase<EpiResid, pg8::TileOrder, true>(wv, lds, g, S, E);
            if constexpr (l == 0) HELP(pb + 5);
        }
        SEAM(pb + 5);
        if (RUN(pb + 6)) { unsigned char* ws = WSP; const float* modv_l = (const float*)(ws + WS_MODV) + (size_t)l * 3 * MODW; const float* XR = (const float*)(ws + WS_XR);
            if constexpr (l == 0) p_ln<false>(wv, lds, XR, XR, 0, PTR(7) + l * D, modv_l + 3 * D, modv_l + 4 * D, (bf16_t*)(ws + WS_XN), nMo * 256);
            if constexpr (l == 0) DRAINQ(Q_F3); else DRAINQ(Q_ALL);
            if constexpr (l == 1) p_router(wv, lds, XR, PTR(7) + l * D, modv_l + 3 * D, modv_l + 4 * D, PTR(18), PTR(19), (unsigned*)(ws + WS_CTL) + CW_CNT, (int*)(ws + WS_LIST), (float*)(ws + WS_GEP), (int*)(ws + WS_SLOT), ws + WS_XN);
        }
        SEAM(pb + 6);
        if (RUN(pb + 7)) { unsigned char* ws = WSP;
            if constexpr (l == 0) {
                pg8::TileOrder S; S.A = (const char*)(ws + WS_XN); S.Bt = (const char*)(ws + WS_W13); S.a_mstep = (size_t)256 * D * 2; S.a_nstep = 0; S.b_nstep = (size_t)256 * D * 2;
                S.nM = MA / 256; S.nN = 2 * DFF / 256; S.nwg = S.nM * S.nN; S.G = G; S.c = blk;
                pg8::Gemm g; g.K = D; g.lda = D; g.ldb = D; g.pad = 0;
                EpiSwiglu8 E; E.H = ws + WS_HH; E.ldh = DFF; E.pad = 0;
                pg8::gemm_phase<EpiSwiglu8, pg8::TileOrder, true>(wv, lds, g, S, E);
                HELP(pb + 7); DRAINQ(Q_F2);
            } else {
                LAS int* tab = (LAS int*)(lds + MOE_TAB); LAS int* rows = (LAS int*)(lds + MOE_ROWS);
                moe_tab_init(wv, tab, (const unsigned*)(ws + WS_CTL) + CW_CNT, 2 * DFF / 256);
                MoeOrder<true> S; S.A = (const char*)(ws + WS_XN); S.Bt = (const char*)(ws + WS_MW13); S.a_mstep = 0; S.b_estep = (size_t)2 * DFF * D; S.b_nstep = (size_t)256 * D; S.tab = tab; S.rows = rows; S.nN = 2 * DFF / 256; S.G = G; S.c = blk;
                { pg8::Unit u; const int* LIST = (const int*)(ws + WS_LIST);
                  for (int ui = 0; S.next(ui, u); ++ui) { const int n = tab[48 + u.e];
                      for (int r = my_tid(wv); r < 256; r += 512) { const int p = u.pml * 256 + r; rows[ui * 256 + r] = LIST[(size_t)u.e * 8192 + (p < n ? p : 0)]; } }
                  __syncthreads(); }
                pg8::Gemm g; g.K = D / 2; g.lda = D / 2; g.ldb = D / 2; g.pad = 0;
                EpiSwiglu8 E; E.H = ws + WS_HH; E.ldh = DFF; E.pad = 0;
                pg8::gemm_phase<EpiSwiglu8, MoeOrder<true>, true, true>(wv, lds, g, S, E);
            }
        }
        SEAM(pb + 7);
        if (RUN(pb + 8)) { unsigned char* ws = WSP;
            if constexpr (l == 0) { const float* modv_l = (const float*)(ws + WS_MODV); float* XR = (float*)(ws + WS_XR);
                pg8::TileOrder S; S.A = (const char*)(ws + WS_HH); S.Bt = (const char*)(ws + WS_W2); S.a_mstep = (size_t)256 * DFF; S.a_nstep = 0; S.b_nstep = (size_t)256 * DFF;
                S.nM = MA / 256; S.nN = D / 256; S.nwg = S.nM * S.nN; S.G = G; S.c = blk;
                pg8::Gemm g; g.K = DFF / 2; g.lda = DFF / 2; g.ldb = DFF / 2; g.pad = 0;
                EpiResid E; E.src_lat = XR; E.src_ctx = XR; E.XR = XR; E.gate = modv_l + 5 * D; E.rowgate = nullptr; E.rg_stride = 0; E.ctx_row0 = 0;
                pg8::gemm_phase<EpiResid, pg8::TileOrder, true, true>(wv, lds, g, S, E);
                HELP(pb + 8);
            } else {
                LAS int* tab = (LAS int*)(lds + MOE_TAB); LAS int* rows = (LAS int*)(lds + MOE_ROWS);
                moe_tab_init(wv, tab, (const unsigned*)(ws + WS_CTL) + CW_CNT, D / 256);
                MoeOrder<false> S; S.A = (const char*)(ws + WS_HH); S.Bt = (const char*)(ws + WS_MW2); S.a_mstep = (size_t)256 * DFF; S.b_estep = (size_t)D * DFF; S.b_nstep = (size_t)256 * DFF; S.tab = tab; S.rows = rows; S.nN = D / 256; S.G = G; S.c = blk;
                pg8::Gemm g; g.K = DFF / 2; g.lda = DFF / 2; g.ldb = DFF / 2; g.pad = 0;
                EpiMoeDown E; E.YD = (bf16_t*)(ws + WS_YD);
                pg8::gemm_phase<EpiMoeDown, MoeOrder<false>, true, true>(wv, lds, g, S, E);
            }
        }
        SEAM(pb + 8);
}

struct Args { const float* in[24]; float* out; unsigned char* ws; int ph_lo, ph_hi; };
__global__ void __launch_bounds__(512, 2) mk_fwd(Args args) {
    extern __shared__ __attribute__((aligned(16))) unsigned char lds_raw[];
    LAS unsigned char* lds = (LAS unsigned char*)lds_raw;
    volatile LAS unsigned* MISC = (volatile LAS unsigned*)(lds + LDS_MISC);
    const int wv = __builtin_amdgcn_readfirstlane((int)threadIdx.x >> 6);
    if (threadIdx.x < 16) MISC[threadIdx.x] = 0u;
    __syncthreads();
    volatile LAS unsigned long long* PT = (volatile LAS unsigned long long*)(lds + LDS_MISC + 64);
    if (threadIdx.x < 24) PT[threadIdx.x] = (unsigned long long)args.in[threadIdx.x];
    if (threadIdx.x == 24) PT[24] = (unsigned long long)args.out;
    if (threadIdx.x == 25) PT[25] = (unsigned long long)args.ws;
    __syncthreads();
    const int lo = args.ph_lo, hi = args.ph_hi;
    XcdBarrier bar; bar.bar = (unsigned*)(args.ws + WS_CTL) + CW_BAR; bar.x = 0; bar.st = MISC;
    if (hi - lo > 1) bar = xcd_barrier_post((unsigned*)(args.ws + WS_CTL) + CW_BAR, MISC);
    const int G = gridDim.x, blk = blockIdx.x;

    if (RUN(0)) {
        unsigned char* ws = WSP;
        p_ada(wv, lds, PTR(1), PTR(3), PTR(4), PTR(5), (float*)(ws + WS_MODV));
        p_convert(wv, lds, PTR(8), (bf16_t*)(ws + WS_WIN), (size_t)D * INW, (size_t)INWP * D, D, INW, INWP, 1 << 30, 0, 0, 1);
        p_convert(wv, lds, PTR(12), (bf16_t*)(ws + WS_WPOOL), (size_t)256 * 256, (size_t)256 * 256, 256, 256, 256, 1 << 30, 0, 0, 8);
    }
    SEAM(0);
    layer_phases<0>(wv, lds, PT, lo, hi, bar, G, blk);
    layer_phases<1>(wv, lds, PT, lo, hi, bar, G, blk);
    if (RUN(19)) { unsigned char* ws = WSP;
        p_final(wv, lds, (const float*)(ws + WS_XR), (const bf16_t*)(ws + WS_YD), (const int*)(ws + WS_SLOT), (const float*)(ws + WS_GEP), (const unsigned*)(ws + WS_CTL) + CW_CNT, (const float*)(ws + WS_MODV) + 3 * MODW + 5 * D, PTR(23), (float*)ldptr(PT, 24)); }
#undef RUN
#undef SEAM
#undef PTR
#undef WSP
}

extern "C" void kernel_launch(void* const* d_in, const int* in_sizes, int n_in, void* d_out, int out_size, void* d_ws, size_t ws_size, hipStream_t stream) {
    if (n_in != 24 || ws_size < WS_END || out_size != ML * D) { fprintf(stderr, "kernel_launch: unexpected sizes (n_in %d, ws %zu, out %d)\n", n_in, ws_size, out_size); return; }
    static int grid = 0;
    if (grid == 0) {
        int dev = 0, cus = 0, per_cu = 0;
        if (hipGetDevice(&dev) != hipSuccess || hipDeviceGetAttribute(&cus, hipDeviceAttributeMultiprocessorCount, dev) != hipSuccess) { grid = -1; return; }
        if (hipFuncSetAttribute((const void*)mk_fwd, hipFuncAttributeMaxDynamicSharedMemorySize, LDS_BYTES) != hipSuccess) { fprintf(stderr, "kernel_launch: hipFuncSetAttribute failed\n"); grid = -1; return; }
        if (hipOccupancyMaxActiveBlocksPerMultiprocessor(&per_cu, (const void*)mk_fwd, 512, LDS_BYTES) != hipSuccess || per_cu < 1) fprintf(stderr, "kernel_launch: occupancy query reports %d\n", per_cu);
        (void)hipGetLastError();
        grid = cus;
    }
    if (grid < 0) return;
    (void)hipMemsetAsync((char*)d_ws + WS_CTL, 0, 1 * MiB, stream);
    Args a; memset(&a, 0, sizeof a);
    for (int i = 0; i < 24; ++i) a.in[i] = (const float*)d_in[i];
    a.out = (float*)d_out; a.ws = (unsigned char*)d_ws;
#if MK_PER_PHASE
    for (int p = 0; p < NPHASE; ++p) { a.ph_lo = p; a.ph_hi = p + 1; hipLaunchKernelGGL(mk_fwd, dim3(grid), dim3(512), LDS_BYTES, stream, a); }
#else
    a.ph_lo = 0; a.ph_hi = NPHASE; hipLaunchKernelGGL(mk_fwd, dim3(grid), dim3(512), LDS_BYTES, stream, a);
#endif
#ifdef MK_PROBE_MASK
    for (int p = 0; p < NPHASE; ++p) if ((MK_PROBE_MASK >> p) & 1) { a.ph_lo = p; a.ph_hi = p + 1; hipLaunchKernelGGL(mk_fwd, dim3(grid), dim3(512), LDS_BYTES, stream, a); }
#endif
}
```

```cpp
#include <hip/hip_runtime.h>
#include <cstdio>
#include <cstdint>
#include <cstring>

#define LAS __attribute__((address_space(3)))
typedef unsigned short bf16_t;
typedef short bf16x8 __attribute__((ext_vector_type(8)));
typedef float f32x4 __attribute__((ext_vector_type(4)));
typedef float f32x2 __attribute__((ext_vector_type(2)));
typedef unsigned u32x4 __attribute__((ext_vector_type(4)));
typedef unsigned u32x2 __attribute__((ext_vector_type(2)));

constexpr int D = 2048, NBATCH = 2, SEQ = 4096, CTXL = 256;
constexpr int ML = NBATCH * SEQ;
constexpr int MC = NBATCH * CTXL;
constexpr int MA = ML + MC;
constexpr int INW = 4128, INWP = 4352;
constexpr int DFF = 5632, NE = 8;
constexpr int GH = 4, DK = 128, DV = 256;
constexpr int C_Q = 0, C_K = 512, C_V = 1024, C_G = 2048, C_P = 3072, C_R = 4096;
constexpr float EPS = 1e-6f;
constexpr int MODW = 6 * D;

constexpr size_t MiB = 1u << 20;
constexpr size_t WS_CTL = 0;
constexpr size_t WS_MODV = 1 * MiB;
constexpr size_t WS_LIST = 2 * MiB;
constexpr size_t WS_GEP = WS_LIST + 256 * 1024;
constexpr size_t WS_SLOT = WS_GEP + 256 * 1024;
constexpr size_t WS_R = 3 * MiB;
constexpr size_t WS_WPOOL = 5 * MiB;
constexpr size_t WS_WIN = 6 * MiB;
constexpr size_t WS_WOUT = 40 * MiB;
constexpr size_t WS_W13 = 56 * MiB;
constexpr size_t WS_W2 = 100 * MiB;
constexpr size_t WS_MW13 = 122 * MiB;
constexpr size_t WS_MW2 = 474 * MiB;
constexpr size_t WS_XR = 650 * MiB;
constexpr size_t WS_XN = 718 * MiB;
constexpr size_t WS_U = 752 * MiB;
constexpr size_t WS_Y = 825 * MiB;
constexpr size_t WS_MIX = 859 * MiB;
constexpr size_t WS_HH = 876 * MiB;
constexpr size_t WS_QA = 1074 * MiB;
constexpr size_t WS_BT = 1096 * MiB;
constexpr size_t WS_DS = 1182 * MiB;
constexpr size_t WS_DEC = 1318 * MiB;
constexpr size_t WS_YD = WS_QA;
constexpr size_t WS_END = 1320 * MiB;
constexpr int CW_CNT = 1024;
constexpr int LDS_MISC = 147456;
constexpr int MOE_TAB = 131072, MOE_ROWS = 131072 + 256, MOE_MAXU = 15, MOE_LDS = MOE_ROWS + MOE_MAXU * 1024;

__device__ __forceinline__ int my_tid(int wv) { int t = wv * 64 + (int)__builtin_amdgcn_mbcnt_hi(~0u, __builtin_amdgcn_mbcnt_lo(~0u, 0u)); asm volatile("" : "+v"(t)); return t; }
namespace pg8 {
constexpr int BM = 256, BK = 64, HALF = 128, HTB = HALF * BK * 2, STAGE_BYTES = 8 * HTB, NXCD = 8, WGM = 8;
__host__ __device__ __forceinline__ int lds_byte(int r, int c) { const int st = (r >> 4) * 2 + (c >> 5), rr = r & 15, cc = c & 31, ob = rr * 64 + cc * 2; return st * 1024 + (ob ^ (((ob >> 9) & 1) << 5)); }
__host__ __device__ __forceinline__ void stage_rc(int b, int& R, int& C) { const int st = b / 1024, sb = b % 1024, swz = sb ^ (((sb >> 9) & 1) << 5); R = (st >> 1) * 16 + swz / 64; C = (st & 1) * 32 + (swz % 64) / 2; }
__host__ __device__ __forceinline__ int perm32(int rho) { const int n = rho >> 4, i = rho & 15; return 8 * (i >> 2) + 4 * n + (i & 3); }

struct Unit { const char* a; const char* b; int pm, pn, e, pml; };
struct Gemm { int K, lda, ldb, pad; };

struct TileOrder {
    static constexpr bool GATHER = false;
    const char* A; const char* Bt; size_t a_mstep, a_nstep, b_nstep; int nM, nN, nwg, G, c; int pre = 0;
    __device__ __forceinline__ bool next(int i, Unit& u) const {
        const long L = (long)i * G + c; if (L >= nwg) return false;
        const int npre = pre * nN;
        if ((int)L < npre) { u.pm = (nM - pre) + (int)L / nN; u.pn = (int)L % nN; }
        else {
        const int nw2 = nwg - npre, nM2 = nM - pre;
        int wgid = (int)L - npre; { const int q = nw2 / NXCD, r = nw2 % NXCD, xcd = wgid % NXCD, off = wgid / NXCD; wgid = (xcd < r ? xcd * (q + 1) : r * (q + 1) + (xcd - r) * q) + off; }
        const int nig = WGM * nN, gid = wgid / nig, fm = gid * WGM, gsz = (nM2 - fm) < WGM ? (nM2 - fm) : WGM;
        u.pm = fm + ((wgid % nig) % gsz); u.pn = (wgid % nig) / gsz; }
        u.a = A + (size_t)u.pm * a_mstep + (size_t)u.pn * a_nstep; u.b = Bt + (size_t)u.pn * b_nstep; u.e = 0; u.pml = u.pm; return true;
    }
    __device__ __forceinline__ void a_off(int, const Unit&, int tid, int lda, unsigned (&v)[4]) const {
#pragma unroll
        for (int i = 0; i < 2; ++i) { int R, C; stage_rc(tid * 16 + i * 8192, R, C); v[i] = (unsigned)(R * lda + C) * 2u; v[2 + i] = (unsigned)((R + HALF) * lda + C) * 2u; }
    }
};

typedef __bf16 bf16x2_hw __attribute__((ext_vector_type(2)));
__device__ __forceinline__ unsigned cvt_pk_bf16(float lo, float hi) { const f32x2 v = {lo, hi}; const bf16x2_hw b = __builtin_convertvector(v, bf16x2_hw); return __builtin_bit_cast(unsigned, b); }

__device__ __forceinline__ void glds16(unsigned voff, const char* sbase, unsigned lds_dst) {
    unsigned keep;
    asm volatile("s_nop 4\n\ts_mov_b32 %0, m0\n\ts_mov_b32 m0, %2\n\ts_nop 0\n\tglobal_load_lds_dwordx4 %1, %3\n\ts_mov_b32 m0, %0" : "=&s"(keep) : "v"(voff), "s"(lds_dst), "s"(sbase) : "memory");
}
__device__ __forceinline__ const char* ubase(const char* p) {
    const unsigned long long v = (unsigned long long)p;
    const unsigned lo = __builtin_amdgcn_readfirstlane((unsigned)v), hi = __builtin_amdgcn_readfirstlane((unsigned)(v >> 32));
    return (const char*)(((unsigned long long)hi << 32) | lo);
}
typedef int v4i_t __attribute__((ext_vector_type(4)));
typedef int v8i_t __attribute__((ext_vector_type(8)));
__device__ __forceinline__ v8i_t cat8(bf16x8 lo, bf16x8 hi) { const v4i_t a = __builtin_bit_cast(v4i_t, lo), b = __builtin_bit_cast(v4i_t, hi); return __builtin_shufflevector(a, b, 0, 1, 2, 3, 4, 5, 6, 7); }
template <class Epi, class Sched, bool ALIGN_EPI, bool FP8 = false>
__device__ __forceinline__ void gemm_phase(const int wv, LAS unsigned char* lds, const Gemm g, const Sched& S, const Epi& E) {
    int tid = my_tid(wv);
    const int wid = __builtin_amdgcn_readfirstlane(tid >> 6), lane = tid & 63, wr = wid >> 2, wc = wid & 3, fr = lane & 15, fq = lane >> 4;
    const int K = g.K, nt = K / BK;
    unsigned voffB[2];
#pragma unroll
    for (int i = 0; i < 2; ++i) { int R, C; stage_rc(tid * 16 + i * 8192, R, C); const int Rb = Epi::PERM ? ((R & ~31) + perm32(R & 31)) : R;
        voffB[i] = (unsigned)(Rb * g.ldb + C) * 2u; }
    const size_t kstep = (size_t)(BK * 2);
    const size_t hB = (size_t)HALF * g.ldb * 2, hA = (size_t)HALF * g.lda * 2;
    const unsigned ldsw = (unsigned)wid * 1024u;
    constexpr bool ASMDMA = FP8 && !Sched::GATHER;
    const unsigned ldsb = (unsigned)__builtin_amdgcn_readfirstlane((int)(unsigned)(unsigned long long)(lds + ldsw));
    const int scl8 = 0x7c7c7c7c;
    const int aoff = lds_byte(wr * 64 + fr, fq * 8), boff = lds_byte(wc * 32 + fr, fq * 8);
#define PG8_SA(b, h) (((b) * 2 + (h)) * HTB)
#define PG8_SB(b, h) ((4 + (b) * 2 + (h)) * HTB)
#define PG8_STAGE(bufoff, gbase, voff) do { if constexpr (ASMDMA) { const char* _gb = ubase((const char*)(gbase)); _Pragma("unroll") for (int _i = 0; _i < 2; ++_i) glds16((voff)[_i], _gb, ldsb + (unsigned)((bufoff) + _i * 8192)); } \
        else { _Pragma("unroll") for (int _i = 0; _i < 2; ++_i) __builtin_amdgcn_global_load_lds((const unsigned*)((const char*)(gbase) + (voff)[_i]), (LAS unsigned*)(lds + (bufoff) + ldsw + _i * 8192), 16, 0, 0); } } while (0)
#define PG8_STAGEA(bufoff, gbase, voff, hh) do { if constexpr (ASMDMA) { const char* _gb = ubase((const char*)(gbase) + (hh) * hA); _Pragma("unroll") for (int _i = 0; _i < 2; ++_i) glds16((voff)[_i], _gb, ldsb + (unsigned)((bufoff) + _i * 8192)); } \
        else { _Pragma("unroll") for (int _i = 0; _i < 2; ++_i) { \
        if constexpr (Sched::GATHER) __builtin_amdgcn_global_load_lds((const unsigned*)((const char*)(gbase) + (voff)[(hh) * 2 + _i]), (LAS unsigned*)(lds + (bufoff) + ldsw + _i * 8192), 16, 0, 0); \
        else __builtin_amdgcn_global_load_lds((const unsigned*)((const char*)(gbase) + (hh) * hA + (voff)[_i]), (LAS unsigned*)(lds + (bufoff) + ldsw + _i * 8192), 16, 0, 0); } } } while (0)
#define PG8_LDA(dst, b, h) do { _Pragma("unroll") for (int m = 0; m < 4; ++m) _Pragma("unroll") for (int k = 0; k < 2; ++k) dst[m][k] = *(const LAS bf16x8*)(lds + PG8_SA(b, h) + aoff + m * 2048 + k * 1024); } while (0)
#define PG8_LDB(dst, b, h) do { _Pragma("unroll") for (int n = 0; n < 2; ++n) _Pragma("unroll") for (int k = 0; k < 2; ++k) dst[n][k] = *(const LAS bf16x8*)(lds + PG8_SB(b, h) + boff + n * 2048 + k * 1024); } while (0)
#define PG8_MMA(ai, bj, At, Bt) do { __builtin_amdgcn_s_setprio(1); \
        if constexpr (FP8) { _Pragma("unroll") for (int m = 0; m < 4; ++m) _Pragma("unroll") for (int n = 0; n < 2; ++n) \
            acc[ai][bj][m][n] = __builtin_amdgcn_mfma_scale_f32_16x16x128_f8f6f4(cat8(Bt[n][0], Bt[n][1]), cat8(At[m][0], At[m][1]), acc[ai][bj][m][n], 0, 0, 0, scl8, 0, scl8); } \
        else { _Pragma("unroll") for (int m = 0; m < 4; ++m) _Pragma("unroll") for (int n = 0; n < 2; ++n) _Pragma("unroll") for (int k = 0; k < 2; ++k) \
            acc[ai][bj][m][n] = __builtin_amdgcn_mfma_f32_16x16x32_bf16(Bt[n][k], At[m][k], acc[ai][bj][m][n], 0, 0, 0); } \
        __builtin_amdgcn_s_setprio(0); } while (0)
#define PG8_WAIT_V(n) asm volatile("s_waitcnt vmcnt(" #n ")" ::: "memory")
#define PG8_WAIT_L(n) asm volatile("s_waitcnt lgkmcnt(" #n ")" ::: "memory")
#define PG8_BAR __builtin_amdgcn_s_barrier()
#define PG8_SCHED __builtin_amdgcn_sched_barrier(0)
    Unit cur, nxt; int ui = 0;
    if (!S.next(0, cur)) return;
    f32x4 acc[2][2][4][2];
#pragma unroll
    for (int a = 0; a < 2; ++a)
#pragma unroll
        for (int b = 0; b < 2; ++b)
#pragma unroll
            for (int m = 0; m < 4; ++m)
#pragma unroll
                for (int n = 0; n < 2; ++n) acc[a][b][m][n] = (f32x4){0.f, 0.f, 0.f, 0.f};
    bf16x8 At[4][2], B0[2][2], B1[2][2];
    const char* cA = cur.a; const char* cB = cur.b;
    unsigned vA[4];
    S.a_off(0, cur, tid, g.lda, vA);
    PG8_STAGE(PG8_SB(0, 0), cB, voffB); PG8_STAGE(PG8_SB(0, 1), cB + hB, voffB); PG8_STAGEA(PG8_SA(0, 0), cA, vA, 0); PG8_STAGEA(PG8_SA(0, 1), cA, vA, 1);
    if (wr == 1) PG8_BAR;
    PG8_WAIT_V(2); PG8_BAR;
    PG8_STAGE(PG8_SB(1, 0), cB + kstep, voffB); PG8_STAGEA(PG8_SA(1, 0), cA + kstep, vA, 0); PG8_STAGE(PG8_SB(1, 1), cB + hB + kstep, voffB);
    PG8_WAIT_V(6); PG8_BAR;
    for (;;) {
        const bool has_next = S.next(ui + 1, nxt);
        const char* nA = has_next ? nxt.a : cA; const char* nB = has_next ? nxt.b : cB;
        for (int t = 0; t < nt; t += 2) {
            const bool last = (t == nt - 2);
            const char* a1 = cA + (size_t)(t + 1) * kstep;
            const char* a2 = last ? nA : cA + (size_t)(t + 2) * kstep; const char* b2 = last ? nB : cB + (size_t)(t + 2) * kstep;
            const char* a3 = a2 + kstep; const char* b3 = b2 + kstep;
            PG8_LDB(B0, 0, 0); PG8_LDB(B1, 0, 1); PG8_SCHED; PG8_LDA(At, 0, 0); PG8_STAGEA(PG8_SA(1, 1), a1, vA, 1);
            if constexpr (Sched::GATHER) { if (last && has_next) S.a_off(ui + 1, nxt, my_tid(wv), g.lda, vA); }
            PG8_WAIT_V(8); PG8_WAIT_L(0); PG8_BAR; PG8_MMA(0, 0, At, B0); PG8_MMA(0, 1, At, B1); PG8_BAR; PG8_SCHED;
            PG8_LDA(At, 0, 1); PG8_STAGE(PG8_SB(0, 0), b2, voffB); PG8_STAGE(PG8_SB(0, 1), b2 + hB, voffB); PG8_STAGEA(PG8_SA(0, 0), a2, vA, 0);
            PG8_WAIT_V(8); PG8_WAIT_L(0); PG8_BAR; PG8_MMA(1, 0, At, B0); PG8_MMA(1, 1, At, B1); PG8_BAR; PG8_SCHED;
            PG8_LDB(B0, 1, 0); PG8_LDB(B1, 1, 1); PG8_SCHED; PG8_LDA(At, 1, 0); PG8_STAGEA(PG8_SA(0, 1), a2, vA, 1);
            PG8_WAIT_V(8); PG8_WAIT_L(0); PG8_BAR; PG8_MMA(0, 0, At, B0); PG8_MMA(0, 1, At, B1); PG8_BAR; PG8_SCHED;
            PG8_LDA(At, 1, 1); PG8_STAGE(PG8_SB(1, 0), b3, voffB); PG8_STAGE(PG8_SB(1, 1), b3 + hB, voffB); PG8_STAGEA(PG8_SA(1, 0), a3, vA, 0);
            PG8_WAIT_V(8); PG8_WAIT_L(0); PG8_BAR; PG8_MMA(1, 0, At, B0); PG8_MMA(1, 1, At, B1); PG8_BAR; PG8_SCHED;
        }
        if constexpr (ALIGN_EPI) { if (wr == 0) PG8_BAR; }
        { const int te = my_tid(wv), le = te & 63, we = __builtin_amdgcn_readfirstlane(te >> 6); E(acc, cur, we >> 2, we & 3, le & 15, le >> 4); }
        if (!has_next) break;
#pragma unroll
        for (int a = 0; a < 2; ++a)
#pragma unroll
            for (int b = 0; b < 2; ++b)
#pragma unroll
                for (int m = 0; m < 4; ++m)
#pragma unroll
                    for (int n = 0; n < 2; ++n) acc[a][b][m][n] = (f32x4){0.f, 0.f, 0.f, 0.f};
        cur = nxt; cA = nA; cB = nB; ++ui;
        if constexpr (ALIGN_EPI) { if (wr == 1) PG8_BAR; }
    }
    PG8_WAIT_V(0);
    if constexpr (!ALIGN_EPI) { if (wr == 0) PG8_BAR; }
    PG8_BAR;
#undef PG8_SA
#undef PG8_SB
#undef PG8_STAGE
#undef PG8_STAGEA
#undef PG8_LDA
#undef PG8_LDB
#undef PG8_MMA
#undef PG8_WAIT_V
#undef PG8_WAIT_L
#undef PG8_BAR
#undef PG8_SCHED
}
}
using pg8::cvt_pk_bf16;
typedef f32x4 Acc[2][2][4][2];

__device__ __forceinline__ float bf2f(bf16_t v) { return __uint_as_float(((unsigned)v) << 16); }
__device__ __forceinline__ float siluf(float a) { return a * __builtin_amdgcn_rcpf(1.f + __expf(-a)); }
__device__ __forceinline__ int mod_index(int row) { return row < SEQ ? 0 : (row < ML ? 1 : 2); }

struct EpiIn {
    static constexpr bool PERM = true;
    bf16_t* U; float* R; int floff;
    static __device__ __forceinline__ void st_wt(void* p, u32x4 w) {
        __hip_atomic_store((unsigned long long*)p, (unsigned long long)w.x | ((unsigned long long)w.y << 32), __ATOMIC_RELAXED, __HIP_MEMORY_SCOPE_AGENT);
        __hip_atomic_store((unsigned long long*)p + 1, (unsigned long long)w.z | ((unsigned long long)w.w << 32), __ATOMIC_RELAXED, __HIP_MEMORY_SCOPE_AGENT); }
    __device__ __forceinline__ void operator()(const Acc& acc, const pg8::Unit& u, int wr, int wc, int fr, int fq) const {
        const int row0 = u.pm * 256 + wr * 64 + fr, col0 = u.pn * 256 + wc * 32 + 8 * fq;
        const float sc = (u.pn < 2) ? 0.08838834764831845f : 1.f;
        const bool wt = u.pm >= ML / 256;
#pragma unroll
        for (int ai = 0; ai < 2; ++ai)
#pragma unroll
            for (int m = 0; m < 4; ++m) { const int row = row0 + ai * 128 + m * 16; bf16_t* rowp = U + (size_t)row * INWP + col0;
#pragma unroll
                for (int bj = 0; bj < 2; ++bj) { const f32x4 v0 = acc[ai][bj][m][0] * sc, v1 = acc[ai][bj][m][1] * sc;
                    u32x4 w; w.x = cvt_pk_bf16(v0[0], v0[1]); w.y = cvt_pk_bf16(v0[2], v0[3]); w.z = cvt_pk_bf16(v1[0], v1[1]); w.w = cvt_pk_bf16(v1[2], v1[3]);
                    if (wt) st_wt(rowp + bj * 128, w); else *(u32x4*)(rowp + bj * 128) = w; }
                if (u.pn == 16 && wc == 0) { float* rp = R + (size_t)row * 32 + 8 * fq;
                    if (wt) { st_wt(rp, __builtin_bit_cast(u32x4, acc[ai][0][m][0])); st_wt(rp + 4, __builtin_bit_cast(u32x4, acc[ai][0][m][1])); }
                    else { *(f32x4*)rp = acc[ai][0][m][0]; *(f32x4*)(rp + 4) = acc[ai][0][m][1]; } } }
        if (wt) { asm volatile("s_waitcnt vmcnt(0)" ::: "memory");
            if (fr == 0 && fq == 0) (void)__hip_atomic_fetch_add((unsigned*)((unsigned char*)U - WS_U + WS_CTL) + floff + 64 * (u.pm - ML / 256), 1u, __ATOMIC_RELAXED, __HIP_MEMORY_SCOPE_AGENT); }
    }
};
struct EpiPool {
    static constexpr bool PERM = true;
    bf16_t* Y; const float* scale;
    __device__ __forceinline__ void operator()(const Acc& acc, const pg8::Unit& u, int wr, int wc, int fr, int fq) const {
        const int row0 = u.pm * 256 + wr * 64 + fr, col0 = u.pn * 256 + wc * 32 + 8 * fq;
        f32x4 sv[2][2];
#pragma unroll
        for (int bj = 0; bj < 2; ++bj)
#pragma unroll
            for (int n = 0; n < 2; ++n) sv[bj][n] = *(const f32x4*)(scale + col0 + bj * 128 + 4 * n);
#pragma unroll
        for (int ai = 0; ai < 2; ++ai)
#pragma unroll
            for (int m = 0; m < 4; ++m) { bf16_t* rowp = Y + (size_t)(row0 + ai * 128 + m * 16) * D + 1024 + col0;
#pragma unroll
                for (int bj = 0; bj < 2; ++bj) { const f32x4 v0 = acc[ai][bj][m][0] * sv[bj][0], v1 = acc[ai][bj][m][1] * sv[bj][1];
                    u32x4 w; w.x = cvt_pk_bf16(v0[0], v0[1]); w.y = cvt_pk_bf16(v0[2], v0[3]); w.z = cvt_pk_bf16(v1[0], v1[1]); w.w = cvt_pk_bf16(v1[2], v1[3]);
                    *(u32x4*)(rowp + bj * 128) = w; } }
    }
};
struct EpiResid {
    static constexpr bool PERM = false;
    const float* src_lat; const float* src_ctx; float* XR; const float* gate; const float* rowgate; int rg_stride, ctx_row0;
    __device__ __forceinline__ void operator()(const Acc& acc, const pg8::Unit& u, int wr, int wc, int fr, int fq) const {
        const int row0 = u.pm * 256 + wr * 64 + fr, col0 = u.pn * 256 + wc * 32 + 4 * fq;
        const int mi = u.pm < 16 ? 0 : (u.pm < 32 ? 1 : 2);
        const float* src = u.pm < 32 ? src_lat : src_ctx - (size_t)ctx_row0 * D;
        f32x4 gv[2][2];
#pragma unroll
        for (int bj = 0; bj < 2; ++bj)
#pragma unroll
            for (int n = 0; n < 2; ++n) gv[bj][n] = *(const f32x4*)(gate + (size_t)mi * MODW + col0 + bj * 128 + n * 16);
#pragma unroll
        for (int ai = 0; ai < 2; ++ai)
#pragma unroll
            for (int mp = 0; mp < 2; ++mp) { f32x4 bs[2][2][2];
#pragma unroll
                for (int mm = 0; mm < 2; ++mm) { const size_t off = (size_t)(row0 + ai * 128 + (2 * mp + mm) * 16) * D + col0;
#pragma unroll
                    for (int bj = 0; bj < 2; ++bj)
#pragma unroll
                        for (int n = 0; n < 2; ++n) bs[mm][bj][n] = *(const f32x4*)(src + off + bj * 128 + n * 16); }
#pragma unroll
                for (int mm = 0; mm < 2; ++mm) { const size_t off = (size_t)(row0 + ai * 128 + (2 * mp + mm) * 16) * D + col0;
#pragma unroll
                    for (int bj = 0; bj < 2; ++bj)
#pragma unroll
                        for (int n = 0; n < 2; ++n) *(f32x4*)(XR + off + bj * 128 + n * 16) = bs[mm][bj][n] + gv[bj][n] * acc[ai][bj][2 * mp + mm][n]; } }
    }
};
struct EpiSwiglu {
    static constexpr bool PERM = true;
    bf16_t* H; int ldh, pad;
    __device__ __forceinline__ void operator()(const Acc& acc, const pg8::Unit& u, int wr, int wc, int fr, int fq) const {
        const int row0 = u.pm * 256 + wr * 64 + fr, col0 = u.pn * 128 + wc * 32 + 8 * fq;
#pragma unroll
        for (int ai = 0; ai < 2; ++ai)
#pragma unroll
            for (int m = 0; m < 4; ++m) { bf16_t* rowp = H + (size_t)(row0 + ai * 128 + m * 16) * ldh + col0;
                float h[8];
#pragma unroll
                for (int n = 0; n < 2; ++n)
#pragma unroll
                    for (int j = 0; j < 4; ++j) h[n * 4 + j] = siluf(acc[ai][0][m][n][j]) * acc[ai][1][m][n][j];
                u32x4 w; w.x = cvt_pk_bf16(h[0], h[1]); w.y = cvt_pk_bf16(h[2], h[3]); w.z = cvt_pk_bf16(h[4], h[5]); w.w = cvt_pk_bf16(h[6], h[7]);
                *(u32x4*)rowp = w; }
    }
};

struct EpiSwiglu8 {
    static constexpr bool PERM = true;
    unsigned char* H; int ldh, pad;
    __device__ __forceinline__ void operator()(const Acc& acc, const pg8::Unit& u, int wr, int wc, int fr, int fq) const {
        const int row0 = u.pm * 256 + wr * 64 + fr, col0 = u.pn * 128 + wc * 32 + 8 * fq;
#pragma unroll
        for (int ai = 0; ai < 2; ++ai)
#pragma unroll
            for (int m = 0; m < 4; ++m) { unsigned char* rowp = H + (size_t)(row0 + ai * 128 + m * 16) * ldh + col0;
                float h[8];
#pragma unroll
                for (int n = 0; n < 2; ++n)
#pragma unroll
                    for (int j = 0; j < 4; ++j) h[n * 4 + j] = siluf(acc[ai][0][m][n][j]) * acc[ai][1][m][n][j];
                int x0 = 0, x1 = 0;
                x0 = __builtin_amdgcn_cvt_pk_fp8_f32(h[0], h[1], x0, false); x0 = __builtin_amdgcn_cvt_pk_fp8_f32(h[2], h[3], x0, true);
                x1 = __builtin_amdgcn_cvt_pk_fp8_f32(h[4], h[5], x1, false); x1 = __builtin_amdgcn_cvt_pk_fp8_f32(h[6], h[7], x1, true);
                *(u32x2*)rowp = (u32x2){(unsigned)x0, (unsigned)x1}; }
    }
};
__device__ __forceinline__ void moe_tab_init(const int wv, LAS int* tab, const unsigned* cnt, int nN) {
    if (my_tid(wv) == 0) { int tb = 0, hr = 0;
        for (int e = 0; e < NE; ++e) { const int n = (int)cnt[64 * e], r = (n + 255) >> 8; tab[e] = tb; tab[16 + e] = hr; tab[32 + e] = r; tab[48 + e] = n; tb += r * nN; hr += r; }
        tab[8] = tb; tab[24] = hr; }
    __syncthreads();
}
template <bool GATHER_> struct MoeOrder {
    static constexpr bool GATHER = GATHER_; static constexpr int gather = GATHER_ ? 1 : 0;
    const char* A; const char* Bt; size_t a_mstep, b_estep, b_nstep; const LAS int* tab; const LAS int* rows; int nN, G, c;
    __device__ __forceinline__ bool next(int i, pg8::Unit& u) const {
        const int nwg = __builtin_amdgcn_readfirstlane(tab[8]); const long L = (long)i * G + c; if (L >= nwg || i >= MOE_MAXU) return false;
        int wgid = (int)L; { const int q = nwg / 8, r = nwg % 8, xcd = wgid % 8, off = wgid / 8; wgid = (xcd < r ? xcd * (q + 1) : r * (q + 1) + (xcd - r) * q) + off; }
        int e = 0;
#pragma unroll
        for (int k = 1; k < NE; ++k) e += (wgid >= tab[k]) ? 1 : 0;
        e = __builtin_amdgcn_readfirstlane(e);
        const int loc = wgid - __builtin_amdgcn_readfirstlane(tab[e]), nM = __builtin_amdgcn_readfirstlane(tab[32 + e]);
        const int nig = 8 * nN, gid = loc / nig, fm = gid * 8, gsz = (nM - fm) < 8 ? (nM - fm) : 8;
        u.pml = fm + ((loc % nig) % gsz); u.pn = (loc % nig) / gsz; u.e = e; u.pm = __builtin_amdgcn_readfirstlane(tab[16 + e]) + u.pml;
        u.a = gather ? A : A + (size_t)u.pm * a_mstep; u.b = Bt + (size_t)e * b_estep + (size_t)u.pn * b_nstep; return true;
    }
    __device__ __forceinline__ void a_off(int ui, const pg8::Unit&, int tid, int lda, unsigned (&v)[4]) const {
#pragma unroll
        for (int i = 0; i < 2; ++i) { int R, C; pg8::stage_rc(tid * 16 + i * 8192, R, C);
#pragma unroll
            for (int hh = 0; hh < 2; ++hh) { const int row = gather ? rows[ui * 256 + hh * 128 + R] : (R + hh * 128); v[hh * 2 + i] = (unsigned)(row * lda + C) * 2u; } }
    }
};
struct EpiMoeDown {
    static constexpr bool PERM = true;
    bf16_t* YD;
    __device__ __forceinline__ void operator()(const Acc& acc, const pg8::Unit& u, int wr, int wc, int fr, int fq) const {
        const int row0 = u.pm * 256 + wr * 64 + fr, col0 = u.pn * 256 + wc * 32 + 8 * fq;
#pragma unroll
        for (int ai = 0; ai < 2; ++ai)
#pragma unroll
            for (int m = 0; m < 4; ++m) { bf16_t* rowp = YD + (size_t)(row0 + ai * 128 + m * 16) * D + col0;
#pragma unroll
                for (int bj = 0; bj < 2; ++bj) { const f32x4 v0 = acc[ai][bj][m][0], v1 = acc[ai][bj][m][1];
                    u32x4 w; w.x = cvt_pk_bf16(v0[0], v0[1]); w.y = cvt_pk_bf16(v0[2], v0[3]); w.z = cvt_pk_bf16(v1[0], v1[1]); w.w = cvt_pk_bf16(v1[2], v1[3]);
                    *(u32x4*)(rowp + bj * 128) = w; } }
    }
};
__device__ __forceinline__ float wave_sum(float v) {
#pragma unroll
    for (int o = 1; o < 64; o <<= 1) v += __shfl_xor(v, o);
    return v;
}
__device__ __forceinline__ unsigned f2bf(float f) { unsigned u = __float_as_uint(f); return (u + 0x7fffu + ((u >> 16) & 1u)) >> 16; }
constexpr int NCH = 68, NUN = 8 * NCH, KQ = 320;
constexpr int G1_CUM = 0, G1_QP = 33792, G1_KI = 51200, G1_KT = 68608, G1_VT = 87040, G1_WG = 123904, G1_BG = 140288, G1_AS = G1_QP  , G1_LDS = 141312;
__device__ __forceinline__ int gla_row0(int b, int c) { return c < 4 ? ML + b * CTXL + c * 64 : b * SEQ + (c - 4) * 64; }
__device__ __forceinline__ float bflo(unsigned w) { return __uint_as_float(w << 16); }
__device__ __forceinline__ float bfhi(unsigned w) { return __uint_as_float(w & 0xffff0000u); }
__device__ __forceinline__ float wave_scan_incl(float x, int lane) {
    x += __builtin_bit_cast(float, __builtin_amdgcn_update_dpp(0, __builtin_bit_cast(int, x), 0x111, 0xf, 0xf, false));
    x += __builtin_bit_cast(float, __builtin_amdgcn_update_dpp(0, __builtin_bit_cast(int, x), 0x112, 0xf, 0xf, false));
    x += __builtin_bit_cast(float, __builtin_amdgcn_update_dpp(0, __builtin_bit_cast(int, x), 0x114, 0xf, 0xf, false));
    x += __builtin_bit_cast(float, __builtin_amdgcn_update_dpp(0, __builtin_bit_cast(int, x), 0x118, 0xf, 0xf, false));
    const float t0 = __builtin_bit_cast(float, __builtin_amdgcn_readlane(__builtin_bit_cast(int, x), 15)), t1 = __builtin_bit_cast(float, __builtin_amdgcn_readlane(__builtin_bit_cast(int, x), 31)),
                t2 = __builtin_bit_cast(float, __builtin_amdgcn_readlane(__builtin_bit_cast(int, x), 47));
    return x + (lane >= 16 ? t0 : 0.f) + (lane >= 32 ? t1 : 0.f) + (lane >= 48 ? t2 : 0.f);
}
__device__ __forceinline__ float log_sigmoid_fast(float x) { return fminf(x, 0.f) - __logf(1.f + __expf(-fabsf(x))); }

__device__ __forceinline__ void gla_g1_unit(const int wv, LAS unsigned char* lds, int un, const bf16_t* U, const float* R, const float* wg, const float* bg, bf16_t* QAF, bf16_t* BTF, bf16_t* DSF, float* DEC) {
    int tid = my_tid(wv);
    const int lane = tid & 63, wid = __builtin_amdgcn_readfirstlane(tid >> 6), fr = lane & 15, fq = lane >> 4;
    const int bh = un / NCH, c = un % NCH, b = bh >> 2, h = bh & 3;
    const int row0 = gla_row0(b, c);
    LAS float* CUM = (LAS float*)(lds + G1_CUM);
    LAS bf16_t* QP = (LAS bf16_t*)(lds + G1_QP); LAS bf16_t* KI = (LAS bf16_t*)(lds + G1_KI); LAS bf16_t* KT = (LAS bf16_t*)(lds + G1_KT);
    LAS bf16_t* VT = (LAS bf16_t*)(lds + G1_VT); LAS bf16_t* AS = (LAS bf16_t*)(lds + G1_AS);
    LAS float* WG = (LAS float*)(lds + G1_WG); LAS float* BG = (LAS float*)(lds + G1_BG);
    u32x4 qv[2], kv[2];
#pragma unroll
    for (int i = 0; i < 2; ++i) { const int dg = (tid + 512 * i) >> 6;
        qv[i] = *(const u32x4*)(U + (size_t)(row0 + lane) * INWP + C_Q + h * DK + dg * 8); kv[i] = *(const u32x4*)(U + (size_t)(row0 + lane) * INWP + C_K + h * DK + dg * 8); }
    f32x4 rq[2][4];
#pragma unroll
    for (int dr = 0; dr < 2; ++dr) { const float* rp = R + (size_t)(row0 + (dr == 0 ? lane : 63 - lane)) * 32 + dr * 16;
#pragma unroll
        for (int x = 0; x < 4; ++x) rq[dr][x] = *(const f32x4*)(rp + 4 * x); }
    { const int e0 = tid * 8, rw = e0 >> 7, d0 = e0 & 127;
      const f32x4 w0 = *(const f32x4*)(wg + (size_t)rw * 512 + h * DK + d0), w1 = *(const f32x4*)(wg + (size_t)rw * 512 + h * DK + d0 + 4);
      *(LAS f32x4*)(WG + e0) = w0; *(LAS f32x4*)(WG + e0 + 4) = w1;
      if (tid < 64) { const int b0 = tid * 4; *(LAS f32x4*)(BG + b0) = *(const f32x4*)(bg + (size_t)(b0 >> 7) * 512 + h * DK + (b0 & 127)); } }
#pragma unroll
    for (int i = 0; i < 4; ++i) { const int idx = tid + 512 * i, jg = idx >> 6, s = idx & 63;
        const u32x4 q = *(const u32x4*)(U + (size_t)(row0 + s) * INWP + C_V + h * DV + jg * 8);
        LAS bf16_t* vp = VT + (jg * 8) * 72 + s;
        vp[0] = (bf16_t)(q.x & 0xffffu); vp[72] = (bf16_t)(q.x >> 16); vp[144] = (bf16_t)(q.y & 0xffffu); vp[216] = (bf16_t)(q.y >> 16);
        vp[288] = (bf16_t)(q.z & 0xffffu); vp[360] = (bf16_t)(q.z >> 16); vp[432] = (bf16_t)(q.w & 0xffffu); vp[504] = (bf16_t)(q.w >> 16); }
    f32x4 Aacc[2]; Aacc[0] = (f32x4){0.f, 0.f, 0.f, 0.f}; Aacc[1] = (f32x4){0.f, 0.f, 0.f, 0.f};
    __syncthreads();
    for (int dir = 0; dir < 2; ++dir) {
        { const int t = dir == 0 ? lane : 63 - lane;
          const f32x4 r0 = dir == 0 ? rq[0][0] : rq[1][0], r1 = dir == 0 ? rq[0][1] : rq[1][1], r2 = dir == 0 ? rq[0][2] : rq[1][2], r3 = dir == 0 ? rq[0][3] : rq[1][3];
          const float rr[16] = {r0.x, r0.y, r0.z, r0.w, r1.x, r1.y, r1.z, r1.w, r2.x, r2.y, r2.z, r2.w, r3.x, r3.y, r3.z, r3.w};
          for (int dd = 0; dd < 16; dd += 4) { const int d = wid * 16 + dd;
              const f32x4 b4 = *(const LAS f32x4*)(BG + dir * 128 + d);
              float pre[4] = {b4.x, b4.y, b4.z, b4.w};
#pragma unroll
              for (int k = 0; k < 16; ++k) { const f32x4 w4 = *(const LAS f32x4*)(WG + (dir * 16 + k) * 128 + d); pre[0] += rr[k] * w4.x; pre[1] += rr[k] * w4.y; pre[2] += rr[k] * w4.z; pre[3] += rr[k] * w4.w; }
#pragma unroll
              for (int q = 0; q < 4; ++q) CUM[t * 132 + d + q] = wave_scan_incl(log_sigmoid_fast(pre[q]) * (1.f / 16.f), lane); } }
        __syncthreads();
        if (dir == 0) {
#pragma unroll
            for (int i = 0; i < 4; ++i) { const int idx = tid + 512 * i, j = idx >> 3, sg = idx & 7;
                *(u32x4*)(BTF + ((((size_t)un * 16 + (j >> 4)) * 10 + 8 + (sg >> 2)) * 64 + (sg & 3) * 16 + (j & 15)) * 8) = *(const LAS u32x4*)(VT + j * 72 + sg * 8); } }
        const int tl = dir == 0 ? 63 : 0;
#pragma unroll
        for (int i = 0; i < 2; ++i) { const int dg = (tid + 512 * i) >> 6, s = lane;
            const f32x4 c0 = *(const LAS f32x4*)(CUM + s * 132 + dg * 8), c1 = *(const LAS f32x4*)(CUM + s * 132 + dg * 8 + 4);
            const f32x4 l0 = *(const LAS f32x4*)(CUM + tl * 132 + dg * 8), l1 = *(const LAS f32x4*)(CUM + tl * 132 + dg * 8 + 4);
            const float qf[8] = {bflo(qv[i].x), bfhi(qv[i].x), bflo(qv[i].y), bfhi(qv[i].y), bflo(qv[i].z), bfhi(qv[i].z), bflo(qv[i].w), bfhi(qv[i].w)};
            const float kf[8] = {bflo(kv[i].x), bfhi(kv[i].x), bflo(kv[i].y), bfhi(kv[i].y), bflo(kv[i].z), bfhi(kv[i].z), bflo(kv[i].w), bfhi(kv[i].w)};
            const float cc[8] = {c0.x, c0.y, c0.z, c0.w, c1.x, c1.y, c1.z, c1.w}, cl[8] = {l0.x, l0.y, l0.z, l0.w, l1.x, l1.y, l1.z, l1.w};
            float qp[8], ki[8], ke[8];
#pragma unroll
            for (int e = 0; e < 8; ++e) { qp[e] = qf[e] * __expf(cc[e]); ki[e] = kf[e] * __expf(fminf(-cc[e], 80.f)); ke[e] = kf[e] * __expf(cl[e] - cc[e]); }
            u32x4 w; w.x = cvt_pk_bf16(qp[0], qp[1]); w.y = cvt_pk_bf16(qp[2], qp[3]); w.z = cvt_pk_bf16(qp[4], qp[5]); w.w = cvt_pk_bf16(qp[6], qp[7]);
            *(LAS u32x4*)(QP + s * 136 + dg * 8) = w;
            *(u32x4*)(QAF + ((((size_t)un * 4 + (s >> 4)) * 10 + dir * 4 + (dg >> 2)) * 64 + (dg & 3) * 16 + (s & 15)) * 8) = w;
            u32x4 w2; w2.x = cvt_pk_bf16(ki[0], ki[1]); w2.y = cvt_pk_bf16(ki[2], ki[3]); w2.z = cvt_pk_bf16(ki[4], ki[5]); w2.w = cvt_pk_bf16(ki[6], ki[7]);
            *(LAS u32x4*)(KI + s * 136 + dg * 8) = w2;
#pragma unroll
            for (int e = 0; e < 8; ++e) KT[(dg * 8 + e) * 72 + s] = (bf16_t)f2bf(ke[e]);
            if (s == tl) { float* dp = DEC + ((size_t)un * 2 + dir) * 128 + dg * 8;
                *(f32x4*)dp = (f32x4){__expf(cl[0]), __expf(cl[1]), __expf(cl[2]), __expf(cl[3])}; *(f32x4*)(dp + 4) = (f32x4){__expf(cl[4]), __expf(cl[5]), __expf(cl[6]), __expf(cl[7])}; } }
        __syncthreads();
        { const int tb = wid >> 1;
#pragma unroll
          for (int x = 0; x < 2; ++x) { const int sb = (wid & 1) * 2 + x; f32x4 a = (f32x4){0.f, 0.f, 0.f, 0.f};
#pragma unroll
              for (int ks = 0; ks < 4; ++ks) { const bf16x8 Af = *(const LAS bf16x8*)(QP + (tb * 16 + fr) * 136 + ks * 32 + fq * 8), Bf = *(const LAS bf16x8*)(KI + (sb * 16 + fr) * 136 + ks * 32 + fq * 8);
                  a = __builtin_amdgcn_mfma_f32_16x16x32_bf16(Af, Bf, a, 0, 0, 0); }
#pragma unroll
              for (int jj = 0; jj < 4; ++jj) { const int t = tb * 16 + 4 * fq + jj, sx = sb * 16 + fr; const bool keep = dir == 0 ? (sx <= t) : (sx >= t); Aacc[x][jj] += keep ? a[jj] : 0.f; } } }
#pragma unroll
        for (int jbi = 0; jbi < 2; ++jbi) { const int jb = wid * 2 + jbi;
            const bf16x8 Bf0 = *(const LAS bf16x8*)(VT + (jb * 16 + fr) * 72 + fq * 8), Bf1 = *(const LAS bf16x8*)(VT + (jb * 16 + fr) * 72 + 32 + fq * 8);
#pragma unroll
            for (int db = 0; db < 8; ++db) { const bf16x8 Af0 = *(const LAS bf16x8*)(KT + (db * 16 + fr) * 72 + fq * 8), Af1 = *(const LAS bf16x8*)(KT + (db * 16 + fr) * 72 + 32 + fq * 8);
                f32x4 a = (f32x4){0.f, 0.f, 0.f, 0.f};
                a = __builtin_amdgcn_mfma_f32_16x16x32_bf16(Af0, Bf0, a, 0, 0, 0); a = __builtin_amdgcn_mfma_f32_16x16x32_bf16(Af1, Bf1, a, 0, 0, 0);
                u32x2 w; w.x = cvt_pk_bf16(a.x, a.y); w.y = cvt_pk_bf16(a.z, a.w);
                *(u32x2*)(DSF + (((((size_t)un * 2 + dir) * 16 + jb) * 4 + (db >> 1)) * 64 + ((db & 1) * 2 + (fq >> 1)) * 16 + fr) * 8 + (fq & 1) * 4) = w; } }
        __syncthreads();
    }
    { const int tb = wid >> 1;
#pragma unroll
      for (int x = 0; x < 2; ++x) { const int sb = (wid & 1) * 2 + x;
#pragma unroll
          for (int jj = 0; jj < 4; ++jj) AS[(tb * 16 + 4 * fq + jj) * 72 + sb * 16 + fr] = (bf16_t)f2bf(Aacc[x][jj]); } }
    __syncthreads();
    { const int t = tid >> 3, sg = tid & 7;
      *(u32x4*)(QAF + ((((size_t)un * 4 + (t >> 4)) * 10 + 8 + (sg >> 2)) * 64 + (sg & 3) * 16 + (t & 15)) * 8) = *(const LAS u32x4*)(AS + t * 72 + sg * 8); }
    __syncthreads();
}
__device__ __forceinline__ void gla_g3_unit(const int wv, LAS unsigned char* lds, int un, const bf16_t* QAF, const bf16_t* BTF, const bf16_t* U, const float* gain, bf16_t* Y) {
    int tid = my_tid(wv);
    const int lane = tid & 63, wid = __builtin_amdgcn_readfirstlane(tid >> 6), fr = lane & 15, fq = lane >> 4;
    const int bh = un / NCH, c = un % NCH, b = bh >> 2, h = bh & 3, row0 = gla_row0(b, c);
    const int tb = wid & 3, jh = wid >> 2;
    const bf16_t* qa = QAF + ((size_t)un * 4 + tb) * 10 * 512 + lane * 8;
    const bf16_t* bt = BTF + ((size_t)un * 16 + jh * 8) * 10 * 512 + lane * 8;
    f32x4 acc[8];
#pragma unroll
    for (int jb = 0; jb < 8; ++jb) acc[jb] = (f32x4){0.f, 0.f, 0.f, 0.f};
    bf16x8 Bc = *(const bf16x8*)qa, Ac[8];
#pragma unroll
    for (int jb = 0; jb < 8; ++jb) Ac[jb] = *(const bf16x8*)(bt + (size_t)jb * 10 * 512);
#pragma unroll
    for (int ks = 0; ks < 10; ++ks) {
        bf16x8 Bn = Bc, An[8];
#pragma unroll
        for (int jb = 0; jb < 8; ++jb) An[jb] = Ac[jb];
        if (ks < 9) { Bn = *(const bf16x8*)(qa + (ks + 1) * 512);
#pragma unroll
            for (int jb = 0; jb < 8; ++jb) An[jb] = *(const bf16x8*)(bt + ((size_t)jb * 10 + ks + 1) * 512); }
#pragma unroll
        for (int jb = 0; jb < 8; ++jb) acc[jb] = __builtin_amdgcn_mfma_f32_16x16x32_bf16(Ac[jb], Bc, acc[jb], 0, 0, 0);
        Bc = Bn;
#pragma unroll
        for (int jb = 0; jb < 8; ++jb) Ac[jb] = An[jb];
    }
    float ss = 0.f;
#pragma unroll
    for (int jb = 0; jb < 8; ++jb) ss += (acc[jb].x * acc[jb].x + acc[jb].y * acc[jb].y) + (acc[jb].z * acc[jb].z + acc[jb].w * acc[jb].w);
    ss += __shfl_xor(ss, 16); ss += __shfl_xor(ss, 32);
    LAS float* P = (LAS float*)lds;
    if (fq == 0) P[wid * 16 + fr] = ss;
    __syncthreads();
    const float tot = P[wid * 16 + fr] + P[(wid ^ 4) * 16 + fr];
    const float rstd = 1.0f / sqrtf(tot * (1.f / DV) + EPS);
    const int row = row0 + tb * 16 + fr;
#pragma unroll
    for (int jb = 0; jb < 8; ++jb) { const int col = h * DV + jh * 128 + jb * 16 + 4 * fq;
        const f32x4 gn = *(const f32x4*)(gain + col); const u32x2 gw = *(const u32x2*)(U + (size_t)row * INWP + C_G + col);
        const f32x4 o = acc[jb] * rstd * gn;
        u32x2 w; w.x = cvt_pk_bf16(o.x * siluf(bflo(gw.x)), o.y * siluf(bfhi(gw.x))); w.y = cvt_pk_bf16(o.z * siluf(bflo(gw.y)), o.w * siluf(bfhi(gw.y)));
        *(u32x2*)(Y + (size_t)row * D + col) = w; }
    __syncthreads();
}

__device__ __forceinline__ const void* ldptr(volatile LAS unsigned long long* tab, int i) {
    const unsigned long long v = tab[i];
    const unsigned lo = __builtin_amdgcn_readfirstlane((unsigned)v), hi = __builtin_amdgcn_readfirstlane((unsigned)(v >> 32));
    return (const void*)(((unsigned long long)hi << 32) | lo);
}
constexpr int CVT_TILE_F = 128 * 33;
__device__ __forceinline__ void cvt_item(LAS float* t, int lane, const float* srcb, bf16_t* dstb, size_t sms, size_t dms, int K, int N, int nb, int rs, int off, int ktiles, int per, int it) {
    const int lr = lane >> 4, lc = (lane & 15) * 4;
    const int sr = lane >> 3, sk = (lane & 7) * 8;
    const int mat = it / per, r = it % per, nt = r / ktiles, kt = r % ktiles, k0 = kt * 64, n0 = nt * 64;
    const float* src = srcb + (size_t)mat * sms + (size_t)(k0 + lr) * N + n0 + lc;
    const bool inb = (n0 + lc) < N;
    f32x4 v[16];
#pragma unroll
    for (int i = 0; i < 16; ++i) v[i] = inb ? __builtin_nontemporal_load((const f32x4*)(src + (size_t)(4 * i) * N)) : (f32x4){0.f, 0.f, 0.f, 0.f};
#pragma unroll
    for (int i = 0; i < 16; ++i) { LAS float* tp = t + (lr + 4 * i) * 65 + lc; tp[0] = v[i].x; tp[1] = v[i].y; tp[2] = v[i].z; tp[3] = v[i].w; }
    asm volatile("s_waitcnt lgkmcnt(0)" ::: "memory");
    bf16_t* dst = dstb + (size_t)mat * dms;
#pragma unroll
    for (int p = 0; p < 8; ++p) { const int nn = sr + 8 * p, n = n0 + nn; const int drow = (n / nb) * rs + (n % nb) + off;
        const LAS float* tp = t + sk * 65 + nn;
        u32x4 w; w.x = cvt_pk_bf16(tp[0], tp[65]); w.y = cvt_pk_bf16(tp[2 * 65], tp[3 * 65]); w.z = cvt_pk_bf16(tp[4 * 65], tp[5 * 65]); w.w = cvt_pk_bf16(tp[6 * 65], tp[7 * 65]);
        __builtin_nontemporal_store(w, (u32x4*)(dst + (size_t)drow * K + k0 + sk)); }
    asm volatile("s_waitcnt lgkmcnt(0)" ::: "memory");
}
__device__ __forceinline__ void p_convert(const int wv, LAS unsigned char* lds, const float* srcb, bf16_t* dstb, size_t sms, size_t dms, int K, int N, int NP, int nb, int rs, int off, int nmat) {
    int tid = my_tid(wv);
    const int lane = tid & 63, wave = tid >> 6;
    LAS float* t = (LAS float*)lds + wave * CVT_TILE_F;
    const int ktiles = K / 64, ntiles = NP / 64, per = ktiles * ntiles, total = per * nmat;
    for (int it = blockIdx.x * 8 + wave; it < total; it += gridDim.x * 8) cvt_item(t, lane, srcb, dstb, sms, dms, K, N, nb, rs, off, ktiles, per, it);
}
__device__ __forceinline__ void cvt8_item(LAS float* t, int lane, const float* srcb, unsigned char* dstb, size_t sms, size_t dms, int K, int N, int nb, int rs, int off, int ktiles, int per, int it) {
    const int lr = lane >> 3, lc = (lane & 7) * 4;
    const int sr = lane >> 3, sk = (lane & 7) * 16;
    const int mat = it / per, r = it % per, nt = r / ktiles, kt = r % ktiles, k0 = kt * 128, n0 = nt * 32;
    const float* src = srcb + (size_t)mat * sms + (size_t)(k0 + lr) * N + n0 + lc;
    f32x4 v[16];
#pragma unroll
    for (int i = 0; i < 16; ++i) v[i] = __builtin_nontemporal_load((const f32x4*)(src + (size_t)(8 * i) * N));
#pragma unroll
    for (int i = 0; i < 16; ++i) { LAS float* tp = t + (lr + 8 * i) * 33 + lc; tp[0] = v[i].x * 64.f; tp[1] = v[i].y * 64.f; tp[2] = v[i].z * 64.f; tp[3] = v[i].w * 64.f; }
    asm volatile("s_waitcnt lgkmcnt(0)" ::: "memory");
    unsigned char* dst = dstb + (size_t)mat * dms;
#pragma unroll
    for (int p = 0; p < 4; ++p) { const int nn = sr + 8 * p, n = n0 + nn; const int drow = (n / nb) * rs + (n % nb) + off;
        const LAS float* tp = t + sk * 33 + nn;
        unsigned w[4];
#pragma unroll
        for (int q = 0; q < 4; ++q) { int x = 0; x = __builtin_amdgcn_cvt_pk_fp8_f32(tp[(4 * q) * 33], tp[(4 * q + 1) * 33], x, false); x = __builtin_amdgcn_cvt_pk_fp8_f32(tp[(4 * q + 2) * 33], tp[(4 * q + 3) * 33], x, true); w[q] = (unsigned)x; }
        __builtin_nontemporal_store((u32x4){w[0], w[1], w[2], w[3]}, (u32x4*)(dst + (size_t)drow * K + k0 + sk)); }
    asm volatile("s_waitcnt lgkmcnt(0)" ::: "memory");
}
constexpr int CW_Q = 2048, CW_DONE = 2112;
constexpr int QJ_WOUT = (D / 64) * (D / 64), QJ_F13 = (D / 64) * (DFF / 64), QJ_WIN = (D / 64) * (INWP / 64), QJ_MOE = NE * QJ_F13;
constexpr int Q_WOUT0 = QJ_WOUT, Q_F3 = Q_WOUT0 + 2 * QJ_F13, Q_F2 = Q_F3 + QJ_F13, Q_WIN1 = Q_F2 + QJ_WIN, Q_WOUT1 = Q_WIN1 + QJ_WOUT, Q_ALL = Q_WOUT1 + 3 * QJ_MOE;
__device__ __forceinline__ void q_item(LAS float* t, int lane, int item, volatile LAS unsigned long long* PT) {
    unsigned char* ws = (unsigned char*)ldptr(PT, 25);
    const float* src; bf16_t* dst; size_t sms = 0, dms = 0; int K = D, N = D, NP = D, nb = 1 << 30, rs = 0, off = 0, it = item;
    if (item < Q_WOUT0) { src = (const float*)ldptr(PT, 14); dst = (bf16_t*)(ws + WS_WOUT); }
    else if (item < Q_F3) { const int j = (item - Q_WOUT0) / QJ_F13; it = item - Q_WOUT0 - j * QJ_F13; src = (const float*)ldptr(PT, 15 + j); dst = (bf16_t*)(ws + WS_W13); N = DFF; NP = DFF; nb = 128; rs = 256; off = j * 128; }
    else if (item < Q_F2) { it = item - Q_F3; cvt8_item(t, lane, (const float*)ldptr(PT, 17), ws + WS_W2, 0, 0, DFF, D, 1 << 30, 0, 0, DFF / 128, (DFF / 128) * (D / 32), it); return; }
    else if (item < Q_WIN1) { it = item - Q_F2; src = (const float*)ldptr(PT, 8) + (size_t)D * INW; dst = (bf16_t*)(ws + WS_WIN) + (size_t)INWP * D; N = INW; NP = INWP; }
    else if (item < Q_WOUT1) { it = item - Q_WIN1; src = (const float*)ldptr(PT, 14) + (size_t)D * D; dst = (bf16_t*)(ws + WS_WOUT) + (size_t)D * D; }
    else { const int j = (item - Q_WOUT1) / QJ_MOE; it = item - Q_WOUT1 - j * QJ_MOE; src = (const float*)ldptr(PT, 20 + j); sms = (size_t)D * DFF;
        if (j < 2) { cvt8_item(t, lane, src, ws + WS_MW13, sms, (size_t)2 * DFF * D, D, DFF, 128, 256, j * 128, D / 128, (D / 128) * (DFF / 32), it); return; }
        cvt8_item(t, lane, src, ws + WS_MW2, sms, (size_t)D * DFF, DFF, D, 1 << 30, 0, 0, DFF / 128, (DFF / 128) * (D / 32), it); return; }
    cvt_item(t, lane, src, dst, sms, dms, K, N, nb, rs, off, K / 64, (K / 64) * (NP / 64), it);
}
__device__ __forceinline__ void q_help(const int wv, LAS unsigned char* lds, volatile LAS unsigned long long* PT, int phase, int LIMIT, int qoff = 0) {
    int tid = my_tid(wv);
    const int lane = tid & 63, wave = __builtin_amdgcn_readfirstlane(tid >> 6);
    LAS float* t = (LAS float*)lds + wave * CVT_TILE_F;
    volatile LAS unsigned* MISC = (volatile LAS unsigned*)(lds + LDS_MISC);
    unsigned* ctl = (unsigned*)((unsigned char*)ldptr(PT, 25) + WS_CTL);
    const unsigned G = gridDim.x;
    const unsigned per_wave = LIMIT < 0 ? 1u : 6u;
    __syncthreads();
    if (LIMIT < 0 && tid == 0) (void)__hip_atomic_fetch_add(ctl + CW_DONE + 64 * phase, 1u, __ATOMIC_RELAXED, __HIP_MEMORY_SCOPE_AGENT);
    for (;;) {
        if (tid == 0) { unsigned base = 0xffffffffu;
            const bool pull = LIMIT < 0 ? __hip_atomic_load(ctl + CW_DONE + 64 * phase, __ATOMIC_RELAXED, __HIP_MEMORY_SCOPE_AGENT) < G
                                        : __hip_atomic_load(ctl + CW_Q + qoff, __ATOMIC_RELAXED, __HIP_MEMORY_SCOPE_AGENT) < (unsigned)LIMIT;
            if (pull) base = __hip_atomic_fetch_add(ctl + CW_Q + qoff, 8u * per_wave, __ATOMIC_RELAXED, __HIP_MEMORY_SCOPE_AGENT);
            MISC[4] = base; }
        __syncthreads();
        const unsigned base = MISC[4];
        __syncthreads();
        if (base == 0xffffffffu) break;
#pragma unroll 1
        for (unsigned k = 0; k < per_wave; ++k) { const unsigned item = base + 8u * k + wave; if (item < (unsigned)Q_ALL) q_item(t, lane, (int)item, PT); }
        if (base >= (unsigned)Q_ALL) break;
    }
}
__device__ __forceinline__ void p_ada(const int wv, LAS unsigned char* lds, const float* c, const float* c_ctx, const float* w_ada, const float* b_ada, float* modv) {
    int tid = my_tid(wv);
    LAS float* scv = (LAS float*)lds; LAS float* red = scv + 3 * D;
    for (int i = tid; i < 3 * D; i += 512) { const int r = i / D, k = i % D; const float v = r < 2 ? c[r * D + k] : c_ctx[k]; scv[i] = v / (1.f + expf(-v)); }
    __syncthreads();
    for (int cb = blockIdx.x; cb < 2 * MODW / 96; cb += gridDim.x) {
        const int colg = cb * 96, l = colg / MODW, n0 = colg % MODW;
        if (tid < 504) { const int kg = tid / 24, c4 = tid % 24;
            f32x4 a0 = (f32x4){0.f, 0.f, 0.f, 0.f}, a1 = a0, a2 = a0;
            const float* w = w_ada + (size_t)l * D * MODW + n0 + c4 * 4;
            for (int i0 = 0; i0 < 98; i0 += 14) {
                f32x4 wv[14];
#pragma unroll
                for (int i = 0; i < 14; ++i) { const int k = kg + 21 * (i0 + i), kc = k < D ? k : D - 1; wv[i] = __builtin_nontemporal_load((const f32x4*)(w + (size_t)kc * MODW)); }
#pragma unroll
                for (int i = 0; i < 14; ++i) { const int k = kg + 21 * (i0 + i); const bool ok = k < D; const int kc = ok ? k : D - 1;
                    const float s0 = ok ? scv[kc] : 0.f, s1 = ok ? scv[D + kc] : 0.f, s2 = ok ? scv[2 * D + kc] : 0.f; a0 += wv[i] * s0; a1 += wv[i] * s1; a2 += wv[i] * s2; }
            }
            *(LAS f32x4*)(red + kg * 288 + c4 * 4) = a0; *(LAS f32x4*)(red + kg * 288 + 96 + c4 * 4) = a1; *(LAS f32x4*)(red + kg * 288 + 192 + c4 * 4) = a2; }
        __syncthreads();
        if (tid < 288) { const int r = tid / 96, cl = tid % 96; float sacc = 0.f;
#pragma unroll
            for (int kg = 0; kg < 21; ++kg) sacc += red[kg * 288 + tid];
            modv[((size_t)l * 3 + r) * MODW + n0 + cl] = sacc + b_ada[l * MODW + n0 + cl]; }
        __syncthreads();
    }
}
template <bool OUT8> __device__ __forceinline__ void p_ln(const int wv, LAS unsigned char* lds, const float* src_lat, const float* src_ctx, int ctx_row0, const float* gn, const float* sh, const float* sc, bf16_t* XN, int nrows) {
    int tz = my_tid(wv);
    const int lane = tz & 63, gw = blockIdx.x * 8 + (tz >> 6), NGW = gridDim.x * 8;
    LAS f32x4* SA = (LAS f32x4*)lds; LAS f32x4* SB = SA + 3 * (D / 4);
    __syncthreads();
    for (int q = tz; q < 3 * (D / 4); q += 512) { const int mi = q / (D / 4), c4 = q % (D / 4);
        const f32x4 g = *(const f32x4*)(gn + 4 * c4), a = *(const f32x4*)(sc + (size_t)mi * MODW + 4 * c4);
        SA[q] = g * (a + 1.0f); SB[q] = *(const f32x4*)(sh + (size_t)mi * MODW + 4 * c4); }
    __syncthreads();
    for (int row = gw; row < nrows; row += NGW) {
        const float* x = row < ML ? src_lat + (size_t)row * D : src_ctx + (size_t)(row - ctx_row0) * D;
        const int mi = mod_index(row);
        f32x4 v[8]; float s = 0.f;
#pragma unroll
        for (int j = 0; j < 8; ++j) { v[j] = *(const f32x4*)(x + 4 * lane + 256 * j); s += (v[j].x * v[j].x + v[j].y * v[j].y) + (v[j].z * v[j].z + v[j].w * v[j].w); }
        const float rstd = 1.0f / sqrtf(wave_sum(s) * (1.f / D) + EPS);
#pragma unroll
        for (int j = 0; j < 8; ++j) { const int cc = 4 * lane + 256 * j;
            const f32x4 h = v[j] * rstd * SA[mi * (D / 4) + lane + 64 * j] + SB[mi * (D / 4) + lane + 64 * j];
            if constexpr (OUT8) { int x8 = 0; x8 = __builtin_amdgcn_cvt_pk_fp8_f32(h.x, h.y, x8, false); x8 = __builtin_amdgcn_cvt_pk_fp8_f32(h.z, h.w, x8, true); *(unsigned*)((unsigned char*)XN + (size_t)row * D + cc) = (unsigned)x8; }
            else { u32x2 w; w.x = cvt_pk_bf16(h.x, h.y); w.y = cvt_pk_bf16(h.z, h.w); *(u32x2*)(XN + (size_t)row * D + cc) = w; } }
    }
}
__device__ __forceinline__ void p_gla_g2(const int wv, const bf16_t* DSF, const float* DEC, bf16_t* BTF) {
    int tz = my_tid(wv);
    for (int gi = blockIdx.x * 512 + tz; gi < 16 * 16 * 4 * 128; gi += gridDim.x * 512) {
        const int sl = gi & 127, kd = (gi >> 7) & 3, jb = (gi >> 9) & 15, chain = gi >> 13, dir = chain & 1, bh = chain >> 1;
        const int d = kd * 32 + (sl >> 5) * 8 + (sl & 1) * 4;
        f32x4 S = (f32x4){0.f, 0.f, 0.f, 0.f};
        for (int s0 = 0; s0 < NCH; s0 += 17) {
            f32x4 dec[17]; u32x2 q[17];
#pragma unroll
            for (int i = 0; i < 17; ++i) { const int step = s0 + i, c = dir == 0 ? step : (step < 4 ? 3 - step : 71 - step), un = bh * NCH + c;
                dec[i] = *(const f32x4*)(DEC + ((size_t)un * 2 + dir) * 128 + d);
                q[i] = __builtin_nontemporal_load((const u32x2*)(DSF + ((((size_t)un * 2 + dir) * 16 + jb) * 4 + kd) * 512 + sl * 4)); }
#pragma unroll
            for (int i = 0; i < 17; ++i) { const int step = s0 + i, c = dir == 0 ? step : (step < 4 ? 3 - step : 71 - step), un = bh * NCH + c;
                u32x2 w; w.x = cvt_pk_bf16(S.x, S.y); w.y = cvt_pk_bf16(S.z, S.w);
                *(u32x2*)(BTF + (((size_t)un * 16 + jb) * 10 + dir * 4 + kd) * 512 + sl * 4) = w;
                S = dec[i] * S + (f32x4){bflo(q[i].x), bfhi(q[i].x), bflo(q[i].y), bfhi(q[i].y)}; }
        }
    }
}
template <int W> __device__ __forceinline__ void pool_item(const bf16_t* U, bf16_t* MIX, int row, int ch) {
    int L, j, base;
    if (row < ML) { L = 64; j = row & 63; base = row - j; } else { L = CTXL; j = (row - ML) & (CTXL - 1); base = row - j; }
    const bf16_t* up = U + (size_t)base * INWP + C_P + ch;
    u32x4 q[W];
#pragma unroll
    for (int p = 0; p < W; ++p) { const int r = j - W / 2 + p; const bool ok = r >= 0 && r < L; q[p] = ok ? *(const u32x4*)(up + (size_t)r * INWP) : (u32x4){0u, 0u, 0u, 0u}; }
    float s[8];
#pragma unroll
    for (int i = 0; i < 8; ++i) s[i] = 0.f;
#pragma unroll
    for (int p = 0; p < W; ++p) { s[0] += bflo(q[p].x); s[1] += bfhi(q[p].x); s[2] += bflo(q[p].y); s[3] += bfhi(q[p].y); s[4] += bflo(q[p].z); s[5] += bfhi(q[p].z); s[6] += bflo(q[p].w); s[7] += bfhi(q[p].w); }
    int lo = j - W / 2, hi = lo + W; lo = lo < 0 ? 0 : lo; hi = hi > L ? L : hi;
    const u32x4 me = q[W / 2];
    const float inv = 1.f / (float)(hi - lo);
    u32x4 o; o.x = cvt_pk_bf16(s[0] * inv - bflo(me.x), s[1] * inv - bfhi(me.x)); o.y = cvt_pk_bf16(s[2] * inv - bflo(me.y), s[3] * inv - bfhi(me.y));
    o.z = cvt_pk_bf16(s[4] * inv - bflo(me.z), s[5] * inv - bfhi(me.z)); o.w = cvt_pk_bf16(s[6] * inv - bflo(me.w), s[7] * inv - bfhi(me.w));
    *(u32x4*)(MIX + (size_t)row * 1024 + ch) = o;
}
__device__ __forceinline__ void p_pool(const int wv, const bf16_t* U, bf16_t* MIX, int nrows) {
    int tz = my_tid(wv);
    const int per = nrows * 32;
    for (int gi = blockIdx.x * 512 + tz; gi < per; gi += gridDim.x * 512) { const int row = gi >> 5, cb = (gi & 31) * 8;
        pool_item<2>(U, MIX, row, cb); pool_item<4>(U, MIX, row, 256 + cb); pool_item<8>(U, MIX, row, 512 + cb); pool_item<16>(U, MIX, row, 768 + cb); }
}
__device__ __forceinline__ void p_router(const int wv, LAS unsigned char* lds, const float* XR, const float* gn, const float* sh, const float* sc, const float* w_r, const float* b_r, unsigned* cnt, int* list, float* gep, int* slot, unsigned char* XN8) {
    int tz = my_tid(wv);
    const int lane = tz & 63, gw = blockIdx.x * 8 + (tz >> 6), NGW = gridDim.x * 8;
    LAS f32x4* WR = (LAS f32x4*)lds;
    __syncthreads();
    for (int q = tz; q < 4096; q += 512) { const int ln = q & 63, j = (q >> 6) & 7, hf = (q >> 9) & 1, i = q >> 10;
        WR[q] = *(const f32x4*)(w_r + (size_t)(4 * ln + 256 * j + i) * 8 + 4 * hf); }
    LAS f32x4* SA = WR + 4096; LAS f32x4* SB = SA + 2 * (D / 4);
    for (int q = tz; q < 2 * (D / 4); q += 512) { const int mi = q / (D / 4), c4 = q % (D / 4);
        SA[q] = *(const f32x4*)(gn + 4 * c4) * (*(const f32x4*)(sc + (size_t)mi * MODW + 4 * c4) + 1.0f); SB[q] = *(const f32x4*)(sh + (size_t)mi * MODW + 4 * c4); }
    __syncthreads();
    for (int row = gw; row < ML; row += NGW) {
        const float* x = XR + (size_t)row * D; const int mi = mod_index(row);
        float s = 0.f;
#pragma unroll
        for (int j = 0; j < 8; ++j) { const f32x4 v = *(const f32x4*)(x + 4 * lane + 256 * j); s += (v.x * v.x + v.y * v.y) + (v.z * v.z + v.w * v.w); }
        const float rstd = 1.0f / sqrtf(wave_sum(s) * (1.f / D) + EPS);
        float lg0 = 0.f, lg1 = 0.f, lg2 = 0.f, lg3 = 0.f, lg4 = 0.f, lg5 = 0.f, lg6 = 0.f, lg7 = 0.f;
#pragma unroll 1
        for (int j = 0; j < 8; ++j) { const int cc = 4 * lane + 256 * j;
            const f32x4 v = *(const f32x4*)(x + cc);
            const f32x4 h = v * rstd * SA[mi * (D / 4) + lane + 64 * j] + SB[mi * (D / 4) + lane + 64 * j];
            { int x8 = 0; x8 = __builtin_amdgcn_cvt_pk_fp8_f32(h.x, h.y, x8, false); x8 = __builtin_amdgcn_cvt_pk_fp8_f32(h.z, h.w, x8, true); *(unsigned*)(XN8 + (size_t)row * D + cc) = (unsigned)x8; }
#pragma unroll
            for (int i = 0; i < 4; ++i) { const f32x4 w0 = WR[((i * 2 + 0) * 8 + j) * 64 + lane], w1 = WR[((i * 2 + 1) * 8 + j) * 64 + lane];
                lg0 += h[i] * w0.x; lg1 += h[i] * w0.y; lg2 += h[i] * w0.z; lg3 += h[i] * w0.w; lg4 += h[i] * w1.x; lg5 += h[i] * w1.y; lg6 += h[i] * w1.z; lg7 += h[i] * w1.w; } }
        float lg[8] = {lg0, lg1, lg2, lg3, lg4, lg5, lg6, lg7};
#pragma unroll
        for (int e = 0; e < 8; ++e) lg[e] = wave_sum(lg[e]) + b_r[e];
        int i0 = 0; float m0 = lg[0];
#pragma unroll
        for (int e = 1; e < 8; ++e) if (lg[e] > m0) { m0 = lg[e]; i0 = e; }
        int i1 = -1; float m1 = -3.0e38f;
#pragma unroll
        for (int e = 0; e < 8; ++e) if (e != i0 && lg[e] > m1) { m1 = lg[e]; i1 = e; }
        const float p1 = expf(m1 - m0), g0 = 1.f / (1.f + p1), g1 = p1 / (1.f + p1);
        if (lane == 0) {
            const unsigned q0 = atomicAdd(cnt + 64 * i0, 1u), q1 = atomicAdd(cnt + 64 * i1, 1u);
            list[(size_t)i0 * 8192 + q0] = row; list[(size_t)i1 * 8192 + q1] = row; gep[(size_t)i0 * 8192 + q0] = g0; gep[(size_t)i1 * 8192 + q1] = g1;
            slot[row * 2] = i0 * 8192 + (int)q0; slot[row * 2 + 1] = i1 * 8192 + (int)q1; }
    }
}
__device__ __forceinline__ void p_final(const int wv, LAS unsigned char* lds, const float* XR, const bf16_t* YD, const int* slot, const float* gep, const unsigned* cnt, const float* g2, const float* gn, float* out) {
    int tz = my_tid(wv);
    const int lane = tz & 63, gw = blockIdx.x * 8 + (tz >> 6), NGW = gridDim.x * 8;
    LAS f32x4* G2 = (LAS f32x4*)lds; LAS f32x4* FG = G2 + 2 * (D / 4);
    __syncthreads();
    for (int q = tz; q < 3 * (D / 4); q += 512) { const int mi = q / (D / 4), c4 = q % (D / 4); G2[q] = mi < 2 ? *(const f32x4*)(g2 + (size_t)mi * MODW + 4 * c4) : *(const f32x4*)(gn + 4 * c4); }
    __syncthreads();
    for (int row = gw; row < ML; row += NGW) {
        const float* x = XR + (size_t)row * D; const int mi = mod_index(row);
        const int s0 = slot[row * 2], s1 = slot[row * 2 + 1], e0 = s0 >> 13, e1 = s1 >> 13;
        const float ga = gep[s0], gb = gep[s1];
        int h0 = 0, h1 = 0;
#pragma unroll
        for (int e = 0; e < NE; ++e) { const int r = ((int)cnt[64 * e] + 255) >> 8; h0 += e < e0 ? r : 0; h1 += e < e1 ? r : 0; }
        const bf16_t* y0 = YD + ((size_t)h0 * 256 + (s0 & 8191)) * D; const bf16_t* y1 = YD + ((size_t)h1 * 256 + (s1 & 8191)) * D;
        f32x4 v[8]; float s = 0.f;
#pragma unroll
        for (int j = 0; j < 8; ++j) { const int cc = 4 * lane + 256 * j; const u32x2 a = *(const u32x2*)(y0 + cc), b = *(const u32x2*)(y1 + cc);
            const f32x4 ya = (f32x4){ga * bflo(a.x) + gb * bflo(b.x), ga * bfhi(a.x) + gb * bfhi(b.x), ga * bflo(a.y) + gb * bflo(b.y), ga * bfhi(a.y) + gb * bfhi(b.y)};
            v[j] = *(const f32x4*)(x + cc) + G2[mi * (D / 4) + lane + 64 * j] * ya;
            s += (v[j].x * v[j].x + v[j].y * v[j].y) + (v[j].z * v[j].z + v[j].w * v[j].w); }
        const float rstd = 1.0f / sqrtf(wave_sum(s) * (1.f / D) + EPS);
#pragma unroll
        for (int j = 0; j < 8; ++j) { const int cc = 4 * lane + 256 * j; *(f32x4*)(out + (size_t)row * D + cc) = v[j] * rstd * FG[lane + 64 * j]; }
    }
}

#define XB_TMO      128
#define XB_XCNT(j)  (256  + 64 * (j))
#define XB_XSUB(j)  (1280 + 64 * (j))
#define XB_XGEN(j)  (2304 + 64 * (j))
#define XB_TOP      3328
#define XB_TOPGEN   3392
#define XCD_BAR_WORDS 3456
#define XB_SPIN_CAP (1u << 18)

__device__ __forceinline__ unsigned xb_ld(unsigned* p)              { return __hip_atomic_load(p, __ATOMIC_RELAXED, __HIP_MEMORY_SCOPE_AGENT); }
__device__ __forceinline__ unsigned xb_add(unsigned* p, unsigned v) { return __hip_atomic_fetch_add(p, v, __ATOMIC_RELAXED, __HIP_MEMORY_SCOPE_AGENT); }
__device__ __forceinline__ unsigned xb_xcc_id() { return (unsigned)__builtin_amdgcn_s_getreg((3 << 11) | 20) & 0xFu; }
#define XB_SPIN(cond, bar) do { unsigned _sp = 0; while (cond) { __builtin_amdgcn_s_sleep(1); \
    if ((++_sp & 255u) == 0u) { if (xb_ld(&(bar)[XB_TMO])) break; if (_sp > XB_SPIN_CAP) { atomicAdd(&(bar)[XB_TMO], 1u); break; } } } } while (0)

struct XcdBarrier {
    unsigned* bar; unsigned x;
    volatile LAS unsigned* st;
};

__device__ __forceinline__ XcdBarrier xcd_barrier_post(unsigned* bar, volatile LAS unsigned* st) {
    XcdBarrier b; b.bar = bar; b.x = xb_xcc_id(); b.st = st;
    if (threadIdx.x == 0) (void)xb_add(&bar[XB_XCNT(b.x)], 1u);
    return b;
}
__device__ __forceinline__ void xcd_barrier_complete(unsigned* bar, unsigned x, unsigned& nloc, unsigned& nx) {
    const unsigned G = gridDim.x * gridDim.y * gridDim.z;
    unsigned sum, cnt, mine, sp = 0u;
    for (;;) {
        sum = 0u; cnt = 0u; mine = 0u;
#pragma unroll
        for (unsigned j = 0; j < 16; ++j) { const unsigned c = xb_ld(&bar[XB_XCNT(j)]); sum += c; cnt += (c > 0u) ? 1u : 0u; mine = (j == x) ? c : mine; }
        if (sum == G) break;
        __builtin_amdgcn_s_sleep(1);
        if ((++sp & 255u) == 0u) { if (xb_ld(&bar[XB_TMO])) break; if (sp > XB_SPIN_CAP) { atomicAdd(&bar[XB_TMO], 1u); break; } }
    }
    nloc = mine > 0u ? mine : 1u; nx = cnt > 0u ? cnt : 1u;
}

__device__ __forceinline__ void xcd_barrier(const XcdBarrier& b, const int wv) {
    asm volatile("s_waitcnt vmcnt(0)" ::: "memory");
    __syncthreads();
    if (my_tid(wv) == 0) {
        unsigned* bar = b.bar;
        __builtin_amdgcn_s_waitcnt(0);
        unsigned nloc = b.st[0], nx = b.st[1];
        if (nloc == 0u) { xcd_barrier_complete(bar, b.x, nloc, nx); b.st[0] = nloc; b.st[1] = nx; }
        const unsigned old = xb_add(&bar[XB_XSUB(b.x)], 1u);
        const unsigned gen = old / nloc;
        if (old + 1u == (gen + 1u) * nloc) {
            __builtin_amdgcn_fence(__ATOMIC_RELEASE, "agent");
            asm volatile("s_waitcnt vmcnt(0)" ::: "memory");
            const unsigned og = xb_add(&bar[XB_TOP], 1u);
            const unsigned tg = og / nx;
            if (og + 1u == (tg + 1u) * nx) xb_add(&bar[XB_TOPGEN], 1u);
            else XB_SPIN(xb_ld(&bar[XB_TOPGEN]) == tg, bar);
            __builtin_amdgcn_fence(__ATOMIC_ACQUIRE, "agent");
            xb_add(&bar[XB_XGEN(b.x)], 1u);
            asm volatile("s_waitcnt vmcnt(0)" ::: "memory");
        } else {
            XB_SPIN(xb_ld(&bar[XB_XGEN(b.x)]) == gen, bar);
            __builtin_amdgcn_fence(__ATOMIC_ACQUIRE, "agent");
            asm volatile("s_waitcnt vmcnt(0)" ::: "memory");
        }
    }
    __syncthreads();
}

constexpr int CW_FLG = 3584;
constexpr int CW_BAR = 4096;
constexpr int LDS_BYTES = LDS_MISC + 64 + 256;
static_assert(MOE_LDS <= LDS_MISC && G1_LDS <= LDS_MISC, "LDS map");
#ifndef MK_PER_PHASE
#define MK_PER_PHASE 0
#endif
constexpr int NPHASE = 20;

#define RUN(p) (lo <= (p) && (p) < hi)
#define SEAM(p) do { if (RUN(p) && RUN((p) + 1)) xcd_barrier(bar, wv); } while (0)
#define PTR(i) ((const float*)ldptr(PT, (i)))
#define WSP ((unsigned char*)ldptr(PT, 25))
#define HELP(ph) q_help(wv, lds, PT, (ph), -1)
#define DRAINQ(n) q_help(wv, lds, PT, 0, (n))
template <int l> __device__ __forceinline__ void layer_phases(const int wv, LAS unsigned char* lds, volatile LAS unsigned long long* PT, const int lo, const int hi, const XcdBarrier& bar, const int G, const int blk) {
        const int pb = 1 + 9 * l;
        const int ctx_row0 = l == 0 ? ML : 0;
        const int nMo = (l == 0) ? MA / 256 : ML / 256;
        if (RUN(pb + 0)) { unsigned char* ws = WSP; const float* modv_l = (const float*)(ws + WS_MODV) + (size_t)l * 3 * MODW; const float* XRc = (const float*)(ws + WS_XR);
            p_ln<false>(wv, lds, l == 0 ? PTR(0) : XRc, l == 0 ? PTR(2) : XRc, ctx_row0, PTR(6) + l * D, modv_l + 0, modv_l + D, (bf16_t*)(ws + WS_XN), MA);
            if constexpr (l == 1) DRAINQ(Q_WIN1); }
        SEAM(pb + 0);
        if (RUN(pb + 1)) { unsigned char* ws = WSP;
            pg8::TileOrder S; S.A = (const char*)(ws + WS_XN); S.Bt = (const char*)((bf16_t*)(ws + WS_WIN) + (size_t)l * INWP * D); S.a_mstep = (size_t)256 * D * 2; S.a_nstep = 0; S.b_nstep = (size_t)256 * D * 2;
            S.nM = MA / 256; S.nN = INWP / 256; S.nwg = S.nM * S.nN; S.G = G; S.c = blk; S.pre = 2;
            pg8::Gemm g; g.K = D; g.lda = D; g.ldb = D; g.pad = 0;
            EpiIn E; E.U = (bf16_t*)(ws + WS_U); E.R = (float*)(ws + WS_R); E.floff = CW_FLG + 128 * l;
            pg8::gemm_phase<EpiIn, pg8::TileOrder, true>(wv, lds, g, S, E);
            if (blk >= G - 32) {
                const int j = blk - (G - 32), bh = j >> 2, c = j & 3;
                if (my_tid(wv) == 0) { unsigned* fw = (unsigned*)(ws + WS_CTL) + CW_FLG + 128 * l + 64 * (bh >> 2);
                    XB_SPIN(xb_ld(fw) < 136u, bar.bar);
                    __builtin_amdgcn_fence(__ATOMIC_ACQUIRE, "agent"); asm volatile("s_waitcnt vmcnt(0)" ::: "memory"); }
                __syncthreads();
                gla_g1_unit(wv, lds, bh * NCH + c, (const bf16_t*)(ws + WS_U), (const float*)(ws + WS_R), PTR(9) + (size_t)l * 2 * 16 * 512, PTR(10) + (size_t)l * 2 * 512, (bf16_t*)(ws + WS_QA), (bf16_t*)(ws + WS_BT), (bf16_t*)(ws + WS_DS), (float*)(ws + WS_DEC)); }
            HELP(pb + 1);
        }
        SEAM(pb + 1);
        if (RUN(pb + 2)) { unsigned char* ws = WSP; const float* wgp = PTR(9) + (size_t)l * 2 * 16 * 512; const float* bgp = PTR(10) + (size_t)l * 2 * 512;
            for (int v = blk; v < NUN - 32; v += G) gla_g1_unit(wv, lds, (v >> 6) * NCH + 4 + (v & 63), (const bf16_t*)(ws + WS_U), (const float*)(ws + WS_R), wgp, bgp, (bf16_t*)(ws + WS_QA), (bf16_t*)(ws + WS_BT), (bf16_t*)(ws + WS_DS), (float*)(ws + WS_DEC));
            p_pool(wv, (const bf16_t*)(ws + WS_U), (bf16_t*)(ws + WS_MIX), MA);
        }
        SEAM(pb + 2);
        if (RUN(pb + 3)) { unsigned char* ws = WSP;
            p_gla_g2(wv, (const bf16_t*)(ws + WS_DS), (const float*)(ws + WS_DEC), (bf16_t*)(ws + WS_BT));
        }
        SEAM(pb + 3);
        if (RUN(pb + 4)) { unsigned char* ws = WSP; const float* gain = PTR(11) + l * 1024;
            if (blk >= G - 136) { pg8::TileOrder S; S.A = (const char*)(ws + WS_MIX); S.Bt = (const char*)((bf16_t*)(ws + WS_WPOOL) + (size_t)l * 4 * 256 * 256); S.a_mstep = (size_t)256 * 1024 * 2; S.a_nstep = (size_t)256 * 2; S.b_nstep = (size_t)256 * 256 * 2;
              S.nM = MA / 256; S.nN = 4; S.nwg = S.nM * S.nN; S.G = 136; S.c = blk - (G - 136);
              pg8::Gemm g; g.K = 256; g.lda = 1024; g.ldb = 256; g.pad = 0;
              EpiPool E; E.Y = (bf16_t*)(ws + WS_Y); E.scale = PTR(13) + l * 1024;
              pg8::gemm_phase<EpiPool, pg8::TileOrder, true>(wv, lds, g, S, E); }
            for (int un = blk; un < NUN; un += G) { if (l == 1 && (un % NCH) < 4) continue; gla_g3_unit(wv, lds, un, (const bf16_t*)(ws + WS_QA), (const bf16_t*)(ws + WS_BT), (const bf16_t*)(ws + WS_U), gain, (bf16_t*)(ws + WS_Y)); }
            DRAINQ(l == 0 ? Q_WOUT0 : Q_WOUT1);
        }
        SEAM(pb + 4);
        if (RUN(pb + 5)) { unsigned char* ws = WSP; const float* modv_l = (const float*)(ws + WS_MODV) + (size_t)l * 3 * MODW; float* XR = (float*)(ws + WS_XR);
            pg8::TileOrder S; S.A = (const char*)(ws + WS_Y); S.Bt = (const char*)((bf16_t*)(ws + WS_WOUT) + (size_t)l * D * D); S.a_mstep = (size_t)256 * D * 2; S.a_nstep = 0; S.b_nstep = (size_t)256 * D * 2;
            S.nM = nMo; S.nN = D / 256; S.nwg = S.nM * S.nN; S.G = G; S.c = blk;
            pg8::Gemm g; g.K = D; g.lda = D; g.ldb = D; g.pad = 0;
            EpiResid E; E.src_lat = l == 0 ? PTR(0) : XR; E.src_ctx = l == 0 ? PTR(2) : XR; E.XR = XR; E.gate = modv_l + 2 * D; E.rowgate = nullptr; E.rg_stride = 0; E.ctx_row0 = ctx_row0;
            pg8::gemm_phase<EpiResid, pg8::TileOrder, true>(wv, lds, g, S, E);
            if constexpr (l == 0) HELP(pb + 5);
        }
        SEAM(pb + 5);
        if (RUN(pb + 6)) { unsigned char* ws = WSP; const float* modv_l = (const float*)(ws + WS_MODV) + (size_t)l * 3 * MODW; const float* XR = (const float*)(ws + WS_XR);
            if constexpr (l == 0) p_ln<false>(wv, lds, XR, XR, 0, PTR(7) + l * D, modv_l + 3 * D, modv_l + 4 * D, (bf16_t*)(ws + WS_XN), nMo * 256);
            if constexpr (l == 0) DRAINQ(Q_F3); else DRAINQ(Q_ALL);
            if constexpr (l == 1) p_router(wv, lds, XR, PTR(7) + l * D, modv_l + 3 * D, modv_l + 4 * D, PTR(18), PTR(19), (unsigned*)(ws + WS_CTL) + CW_CNT, (int*)(ws + WS_LIST), (float*)(ws + WS_GEP), (int*)(ws + WS_SLOT), ws + WS_XN);
        }
        SEAM(pb + 6);
        if (RUN(pb + 7)) { unsigned char* ws = WSP;
            if constexpr (l == 0) {
                pg8::TileOrder S; S.A = (const char*)(ws + WS_XN); S.Bt = (const char*)(ws + WS_W13); S.a_mstep = (size_t)256 * D * 2; S.a_nstep = 0; S.b_nstep = (size_t)256 * D * 2;
                S.nM = MA / 256; S.nN = 2 * DFF / 256; S.nwg = S.nM * S.nN; S.G = G; S.c = blk;
                pg8::Gemm g; g.K = D; g.lda = D; g.ldb = D; g.pad = 0;
                EpiSwiglu8 E; E.H = ws + WS_HH; E.ldh = DFF; E.pad = 0;
                pg8::gemm_phase<EpiSwiglu8, pg8::TileOrder, true>(wv, lds, g, S, E);
                HELP(pb + 7); DRAINQ(Q_F2);
            } else {
                LAS int* tab = (LAS int*)(lds + MOE_TAB); LAS int* rows = (LAS int*)(lds + MOE_ROWS);
                moe_tab_init(wv, tab, (const unsigned*)(ws + WS_CTL) + CW_CNT, 2 * DFF / 256);
                MoeOrder<true> S; S.A = (const char*)(ws + WS_XN); S.Bt = (const char*)(ws + WS_MW13); S.a_mstep = 0; S.b_estep = (size_t)2 * DFF * D; S.b_nstep = (size_t)256 * D; S.tab = tab; S.rows = rows; S.nN = 2 * DFF / 256; S.G = G; S.c = blk;
                { pg8::Unit u; const int* LIST = (const int*)(ws + WS_LIST);
                  for (int ui = 0; S.next(ui, u); ++ui) { const int n = tab[48 + u.e];
                      for (int r = my_tid(wv); r < 256; r += 512) { const int p = u.pml * 256 + r; rows[ui * 256 + r] = LIST[(size_t)u.e * 8192 + (p < n ? p : 0)]; } }
                  __syncthreads(); }
                pg8::Gemm g; g.K = D / 2; g.lda = D / 2; g.ldb = D / 2; g.pad = 0;
                EpiSwiglu8 E; E.H = ws + WS_HH; E.ldh = DFF; E.pad = 0;
                pg8::gemm_phase<EpiSwiglu8, MoeOrder<true>, true, true>(wv, lds, g, S, E);
            }
        }
        SEAM(pb + 7);
        if (RUN(pb + 8)) { unsigned char* ws = WSP;
            if constexpr (l == 0) { const float* modv_l = (const float*)(ws + WS_MODV); float* XR = (float*)(ws + WS_XR);
                pg8::TileOrder S; S.A = (const char*)(ws + WS_HH); S.Bt = (const char*)(ws + WS_W2); S.a_mstep = (size_t)256 * DFF; S.a_nstep = 0; S.b_nstep = (size_t)256 * DFF;
                S.nM = MA / 256; S.nN = D / 256; S.nwg = S.nM * S.nN; S.G = G; S.c = blk;
                pg8::Gemm g; g.K = DFF / 2; g.lda = DFF / 2; g.ldb = DFF / 2; g.pad = 0;
                EpiResid E; E.src_lat = XR; E.src_ctx = XR; E.XR = XR; E.gate = modv_l + 5 * D; E.rowgate = nullptr; E.rg_stride = 0; E.ctx_row0 = 0;
                pg8::gemm_phase<EpiResid, pg8::TileOrder, true, true>(wv, lds, g, S, E);
                HELP(pb + 8);
            } else {
                LAS int* tab = (LAS int*)(lds + MOE_TAB); LAS int* rows = (LAS int*)(lds + MOE_ROWS);
                moe_tab_init(wv, tab, (const unsigned*)(ws + WS_CTL) + CW_CNT, D / 256);
                MoeOrder<false> S; S.A = (const char*)(ws + WS_HH); S.Bt = (const char*)(ws + WS_MW2); S.a_mstep = (size_t)256 * DFF; S.b_estep = (size_t)D * DFF; S.b_nstep = (size_t)256 * DFF; S.tab = tab; S.rows = rows; S.nN = D / 256; S.G = G; S.c = blk;
                pg8::Gemm g; g.K = DFF / 2; g.lda = DFF / 2; g.ldb = DFF / 2; g.pad = 0;
                EpiMoeDown E; E.YD = (bf16_t*)(ws + WS_YD);
                pg8::gemm_phase<EpiMoeDown, MoeOrder<false>, true, true>(wv, lds, g, S, E);
            }
        }
        SEAM(pb + 8);
}

struct Args { const float* in[24]; float* out; unsigned char* ws; int ph_lo, ph_hi; };
__global__ void __launch_bounds__(512, 2) mk_fwd(Args args) {
    extern __shared__ __attribute__((aligned(16))) unsigned char lds_raw[];
    LAS unsigned char* lds = (LAS unsigned char*)lds_raw;
    volatile LAS unsigned* MISC = (volatile LAS unsigned*)(lds + LDS_MISC);
    const int wv = __builtin_amdgcn_readfirstlane((int)threadIdx.x >> 6);
    if (threadIdx.x < 16) MISC[threadIdx.x] = 0u;
    __syncthreads();
    volatile LAS unsigned long long* PT = (volatile LAS unsigned long long*)(lds + LDS_MISC + 64);
    if (threadIdx.x < 24) PT[threadIdx.x] = (unsigned long long)args.in[threadIdx.x];
    if (threadIdx.x == 24) PT[24] = (unsigned long long)args.out;
    if (threadIdx.x == 25) PT[25] = (unsigned long long)args.ws;
    __syncthreads();
    const int lo = args.ph_lo, hi = args.ph_hi;
    XcdBarrier bar; bar.bar = (unsigned*)(args.ws + WS_CTL) + CW_BAR; bar.x = 0; bar.st = MISC;
    if (hi - lo > 1) bar = xcd_barrier_post((unsigned*)(args.ws + WS_CTL) + CW_BAR, MISC);
    const int G = gridDim.x, blk = blockIdx.x;

    if (RUN(0)) {
        unsigned char* ws = WSP;
        p_ada(wv, lds, PTR(1), PTR(3), PTR(4), PTR(5), (float*)(ws + WS_MODV));
        p_convert(wv, lds, PTR(8), (bf16_t*)(ws + WS_WIN), (size_t)D * INW, (size_t)INWP * D, D, INW, INWP, 1 << 30, 0, 0, 1);
        p_convert(wv, lds, PTR(12), (bf16_t*)(ws + WS_WPOOL), (size_t)256 * 256, (size_t)256 * 256, 256, 256, 256, 1 << 30, 0, 0, 8);
    }
    SEAM(0);
    layer_phases<0>(wv, lds, PT, lo, hi, bar, G, blk);
    layer_phases<1>(wv, lds, PT, lo, hi, bar, G, blk);
    if (RUN(19)) { unsigned char* ws = WSP;
        p_final(wv, lds, (const float*)(ws + WS_XR), (const bf16_t*)(ws + WS_YD), (const int*)(ws + WS_SLOT), (const float*)(ws + WS_GEP), (const unsigned*)(ws + WS_CTL) + CW_CNT, (const float*)(ws + WS_MODV) + 3 * MODW + 5 * D, PTR(23), (float*)ldptr(PT, 24)); }
#undef RUN
#undef SEAM
#undef PTR
#undef WSP
}

extern "C" void kernel_launch(void* const* d_in, const int* in_sizes, int n_in, void* d_out, int out_size, void* d_ws, size_t ws_size, hipStream_t stream) {
    if (n_in != 24 || ws_size < WS_END || out_size != ML * D) { fprintf(stderr, "kernel_launch: unexpected sizes (n_in %d, ws %zu, out %d)\n", n_in, ws_size, out_size); return; }
    static int grid = 0;
    if (grid == 0) {
        int dev = 0, cus = 0, per_cu = 0;
        if (hipGetDevice(&dev) != hipSuccess || hipDeviceGetAttribute(&cus, hipDeviceAttributeMultiprocessorCount, dev) != hipSuccess) { grid = -1; return; }
        if (hipFuncSetAttribute((const void*)mk_fwd, hipFuncAttributeMaxDynamicSharedMemorySize, LDS_BYTES) != hipSuccess) { fprintf(stderr, "kernel_launch: hipFuncSetAttribute failed\n"); grid = -1; return; }
        if (hipOccupancyMaxActiveBlocksPerMultiprocessor(&per_cu, (const void*)mk_fwd, 512, LDS_BYTES) != hipSuccess || per_cu < 1) fprintf(stderr, "kernel_launch: occupancy query reports %d\n", per_cu);
        (void)hipGetLastError();
        grid = cus;
    }
    if (grid < 0) return;
    (void)hipMemsetAsync((char*)d_ws + WS_CTL, 0, 1 * MiB, stream);
    Args a; memset(&a, 0, sizeof a);
    for (int i = 0; i < 24; ++i) a.in[i] = (const float*)d_in[i];
    a.out = (float*)d_out; a.ws = (unsigned char*)d_ws;
#if MK_PER_PHASE
    for (int p = 0; p < NPHASE; ++p) { a.ph_lo = p; a.ph_hi = p + 1; hipLaunchKernelGGL(mk_fwd, dim3(grid), dim3(512), LDS_BYTES, stream, a); }
#else
    a.ph_lo = 0; a.ph_hi = NPHASE; hipLaunchKernelGGL(mk_fwd, dim3(grid), dim3(512), LDS_BYTES, stream, a);
#endif
#ifdef MK_PROBE_MASK
    for (int p = 0; p < NPHASE; ++p) if ((MK_PROBE_MASK >> p) & 1) { a.ph_lo = p; a.ph_hi = p + 1; hipLaunchKernelGGL(mk_fwd, dim3(grid), dim3(512), LDS_BYTES, stream, a); }
#endif
}
```

```cpp
#include <hip/hip_runtime.h>
#include <cstdio>
#include <cstdint>
#include <cstring>

#define LAS __attribute__((address_space(3)))
typedef unsigned short bf16_t;
typedef short bf16x8 __attribute__((ext_vector_type(8)));
typedef float f32x4 __attribute__((ext_vector_type(4)));
typedef float f32x2 __attribute__((ext_vector_type(2)));
typedef unsigned u32x4 __attribute__((ext_vector_type(4)));
typedef unsigned u32x2 __attribute__((ext_vector_type(2)));

constexpr int D = 2048, NBATCH = 2, SEQ = 4096, CTXL = 256;
constexpr int ML = NBATCH * SEQ;
constexpr int MC = NBATCH * CTXL;
constexpr int MA = ML + MC;
constexpr int INW = 4128, INWP = 4352;
constexpr int DFF = 5632, NE = 8;
constexpr int GH = 4, DK = 128, DV = 256;
constexpr int C_Q = 0, C_K = 512, C_V = 1024, C_G = 2048, C_P = 3072, C_R = 4096;
constexpr float EPS = 1e-6f;
constexpr int MODW = 6 * D;

constexpr size_t MiB = 1u << 20;
constexpr size_t WS_CTL = 0;
constexpr size_t WS_MODV = 1 * MiB;
constexpr size_t WS_LIST = 2 * MiB;
constexpr size_t WS_GEP = WS_LIST + 256 * 1024;
constexpr size_t WS_SLOT = WS_GEP + 256 * 1024;
constexpr size_t WS_R = 3 * MiB;
constexpr size_t WS_WPOOL = 5 * MiB;
constexpr size_t WS_WIN = 6 * MiB;
constexpr size_t WS_WOUT = 40 * MiB;
constexpr size_t WS_W13 = 56 * MiB;
constexpr size_t WS_W2 = 100 * MiB;
constexpr size_t WS_MW13 = 122 * MiB;
constexpr size_t WS_MW2 = 474 * MiB;
constexpr size_t WS_XR = 650 * MiB;
constexpr size_t WS_XN = 718 * MiB;
constexpr size_t WS_U = 752 * MiB;
constexpr size_t WS_Y = 825 * MiB;
constexpr size_t WS_MIX = 859 * MiB;
constexpr size_t WS_HH = 876 * MiB;
constexpr size_t WS_QA = 1074 * MiB;
constexpr size_t WS_BT = 1096 * MiB;
constexpr size_t WS_DS = 1182 * MiB;
constexpr size_t WS_DEC = 1318 * MiB;
constexpr size_t WS_YD = WS_QA;
constexpr size_t WS_END = 1320 * MiB;
constexpr int CW_CNT = 1024;
constexpr int LDS_MISC = 147456;
constexpr int MOE_TAB = 131072, MOE_ROWS = 131072 + 256, MOE_MAXU = 15, MOE_LDS = MOE_ROWS + MOE_MAXU * 1024;

__device__ __forceinline__ int my_tid(int wv) { int t = wv * 64 + (int)__builtin_amdgcn_mbcnt_hi(~0u, __builtin_amdgcn_mbcnt_lo(~0u, 0u)); asm volatile("" : "+v"(t)); return t; }
namespace pg8 {
constexpr int BM = 256, BK = 64, HALF = 128, HTB = HALF * BK * 2, STAGE_BYTES = 8 * HTB, NXCD = 8, WGM = 8;
__host__ __device__ __forceinline__ int lds_byte(int r, int c) { const int st = (r >> 4) * 2 + (c >> 5), rr = r & 15, cc = c & 31, ob = rr * 64 + cc * 2; return st * 1024 + (ob ^ (((ob >> 9) & 1) << 5)); }
__host__ __device__ __forceinline__ void stage_rc(int b, int& R, int& C) { const int st = b / 1024, sb = b % 1024, swz = sb ^ (((sb >> 9) & 1) << 5); R = (st >> 1) * 16 + swz / 64; C = (st & 1) * 32 + (swz % 64) / 2; }
__host__ __device__ __forceinline__ int perm32(int rho) { const int n = rho >> 4, i = rho & 15; return 8 * (i >> 2) + 4 * n + (i & 3); }

struct Unit { const char* a; const char* b; int pm, pn, e, pml; };
struct Gemm { int K, lda, ldb, pad; };

struct TileOrder {
    static constexpr bool GATHER = false;
    const char* A; const char* Bt; size_t a_mstep, a_nstep, b_nstep; int nM, nN, nwg, G, c; int pre = 0;
    __device__ __forceinline__ bool next(int i, Unit& u) const {
        const long L = (long)i * G + c; if (L >= nwg) return false;
        const int npre = pre * nN;
        if ((int)L < npre) { u.pm = (nM - pre) + (int)L / nN; u.pn = (int)L % nN; }
        else {
        const int nw2 = nwg - npre, nM2 = nM - pre;
        int wgid = (int)L - npre; { const int q = nw2 / NXCD, r = nw2 % NXCD, xcd = wgid % NXCD, off = wgid / NXCD; wgid = (xcd < r ? xcd * (q + 1) : r * (q + 1) + (xcd - r) * q) + off; }
        const int nig = WGM * nN, gid = wgid / nig, fm = gid * WGM, gsz = (nM2 - fm) < WGM ? (nM2 - fm) : WGM;
        u.pm = fm + ((wgid % nig) % gsz); u.pn = (wgid % nig) / gsz; }
        u.a = A + (size_t)u.pm * a_mstep + (size_t)u.pn * a_nstep; u.b = Bt + (size_t)u.pn * b_nstep; u.e = 0; u.pml = u.pm; return true;
    }
    __device__ __forceinline__ void a_off(int, const Unit&, int tid, int lda, unsigned (&v)[4]) const {
#pragma unroll
        for (int i = 0; i < 2; ++i) { int R, C; stage_rc(tid * 16 + i * 8192, R, C); v[i] = (unsigned)(R * lda + C) * 2u; v[2 + i] = (unsigned)((R + HALF) * lda + C) * 2u; }
    }
};

typedef __bf16 bf16x2_hw __attribute__((ext_vector_type(2)));
__device__ __forceinline__ unsigned cvt_pk_bf16(float lo, float hi) { const f32x2 v = {lo, hi}; const bf16x2_hw b = __builtin_convertvector(v, bf16x2_hw); return __builtin_bit_cast(unsigned, b); }

__device__ __forceinline__ void glds16(unsigned voff, const char* sbase, unsigned lds_dst) {
    unsigned keep;
    asm volatile("s_nop 4\n\ts_mov_b32 %0, m0\n\ts_mov_b32 m0, %2\n\ts_nop 0\n\tglobal_load_lds_dwordx4 %1, %3\n\ts_mov_b32 m0, %0" : "=&s"(keep) : "v"(voff), "s"(lds_dst), "s"(sbase) : "memory");
}
__device__ __forceinline__ const char* ubase(const char* p) {
    const unsigned long long v = (unsigned long long)p;
    const unsigned lo = __builtin_amdgcn_readfirstlane((unsigned)v), hi = __builtin_amdgcn_readfirstlane((unsigned)(v >> 32));
    return (const char*)(((unsigned long long)hi << 32) | lo);
}
typedef int v4i_t __attribute__((ext_vector_type(4)));
typedef int v8i_t __attribute__((ext_vector_type(8)));
__device__ __forceinline__ v8i_t cat8(bf16x8 lo, bf16x8 hi) { const v4i_t a = __builtin_bit_cast(v4i_t, lo), b = __builtin_bit_cast(v4i_t, hi); return __builtin_shufflevector(a, b, 0, 1, 2, 3, 4, 5, 6, 7); }
template <class Epi, class Sched, bool ALIGN_EPI, bool FP8 = false>
__device__ __forceinline__ void gemm_phase(const int wv, LAS unsigned char* lds, const Gemm g, const Sched& S, const Epi& E) {
    int tid = my_tid(wv);
    const int wid = __builtin_amdgcn_readfirstlane(tid >> 6), lane = tid & 63, wr = wid >> 2, wc = wid & 3, fr = lane & 15, fq = lane >> 4;
    const int K = g.K, nt = K / BK;
    unsigned voffB[2];
#pragma unroll
    for (int i = 0; i < 2; ++i) { int R, C; stage_rc(tid * 16 + i * 8192, R, C); const int Rb = Epi::PERM ? ((R & ~31) + perm32(R & 31)) : R;
        voffB[i] = (unsigned)(Rb * g.ldb + C) * 2u; }
    const size_t kstep = (size_t)(BK * 2);
    const size_t hB = (size_t)HALF * g.ldb * 2, hA = (size_t)HALF * g.lda * 2;
    const unsigned ldsw = (unsigned)wid * 1024u;
    constexpr bool ASMDMA = FP8 && !Sched::GATHER;
    const unsigned ldsb = (unsigned)__builtin_amdgcn_readfirstlane((int)(unsigned)(unsigned long long)(lds + ldsw));
    const int scl8 = 0x7c7c7c7c;
    const int aoff = lds_byte(wr * 64 + fr, fq * 8), boff = lds_byte(wc * 32 + fr, fq * 8);
#define PG8_SA(b, h) (((b) * 2 + (h)) * HTB)
#define PG8_SB(b, h) ((4 + (b) * 2 + (h)) * HTB)
#define PG8_STAGE(bufoff, gbase, voff) do { if constexpr (ASMDMA) { const char* _gb = ubase((const char*)(gbase)); _Pragma("unroll") for (int _i = 0; _i < 2; ++_i) glds16((voff)[_i], _gb, ldsb + (unsigned)((bufoff) + _i * 8192)); } \
        else { _Pragma("unroll") for (int _i = 0; _i < 2; ++_i) __builtin_amdgcn_global_load_lds((const unsigned*)((const char*)(gbase) + (voff)[_i]), (LAS unsigned*)(lds + (bufoff) + ldsw + _i * 8192), 16, 0, 0); } } while (0)
#define PG8_STAGEA(bufoff, gbase, voff, hh) do { if constexpr (ASMDMA) { const char* _gb = ubase((const char*)(gbase) + (hh) * hA); _Pragma("unroll") for (int _i = 0; _i < 2; ++_i) glds16((voff)[_i], _gb, ldsb + (unsigned)((bufoff) + _i * 8192)); } \
        else { _Pragma("unroll") for (int _i = 0; _i < 2; ++_i) { \
        if constexpr (Sched::GATHER) __builtin_amdgcn_global_load_lds((const unsigned*)((const char*)(gbase) + (voff)[(hh) * 2 + _i]), (LAS unsigned*)(lds + (bufoff) + ldsw + _i * 8192), 16, 0, 0); \
        else __builtin_amdgcn_global_load_lds((const unsigned*)((const char*)(gbase) + (hh) * hA + (voff)[_i]), (LAS unsigned*)(lds + (bufoff) + ldsw + _i * 8192), 16, 0, 0); } } } while (0)
#define PG8_LDA(dst, b, h) do { _Pragma("unroll") for (int m = 0; m < 4; ++m) _Pragma("unroll") for (int k = 0; k < 2; ++k) dst[m][k] = *(const LAS bf16x8*)(lds + PG8_SA(b, h) + aoff + m * 2048 + k * 1024); } while (0)
#define PG8_LDB(dst, b, h) do { _Pragma("unroll") for (int n = 0; n < 2; ++n) _Pragma("unroll") for (int k = 0; k < 2; ++k) dst[n][k] = *(const LAS bf16x8*)(lds + PG8_SB(b, h) + boff + n * 2048 + k * 1024); } while (0)
#define PG8_MMA(ai, bj, At, Bt) do { __builtin_amdgcn_s_setprio(1); \
        if constexpr (FP8) { _Pragma("unroll") for (int m = 0; m < 4; ++m) _Pragma("unroll") for (int n = 0; n < 2; ++n) \
            acc[ai][bj][m][n] = __builtin_amdgcn_mfma_scale_f32_16x16x128_f8f6f4(cat8(Bt[n][0], Bt[n][1]), cat8(At[m][0], At[m][1]), acc[ai][bj][m][n], 0, 0, 0, scl8, 0, scl8); } \
        else { _Pragma("unroll") for (int m = 0; m < 4; ++m) _Pragma("unroll") for (int n = 0; n < 2; ++n) _Pragma("unroll") for (int k = 0; k < 2; ++k) \
            acc[ai][bj][m][n] = __builtin_amdgcn_mfma_f32_16x16x32_bf16(Bt[n][k], At[m][k], acc[ai][bj][m][n], 0, 0, 0); } \
        __builtin_amdgcn_s_setprio(0); } while (0)
#define PG8_WAIT_V(n) asm volatile("s_waitcnt vmcnt(" #n ")" ::: "memory")
#define PG8_WAIT_L(n) asm volatile("s_waitcnt lgkmcnt(" #n ")" ::: "memory")
#define PG8_BAR __builtin_amdgcn_s_barrier()
#define PG8_SCHED __builtin_amdgcn_sched_barrier(0)
    Unit cur, nxt; int ui = 0;
    if (!S.next(0, cur)) return;
    f32x4 acc[2][2][4][2];
#pragma unroll
    for (int a = 0; a < 2; ++a)
#pragma unroll
        for (int b = 0; b < 2; ++b)
#pragma unroll
            for (int m = 0; m < 4; ++m)
#pragma unroll
                for (int n = 0; n < 2; ++n) acc[a][b][m][n] = (f32x4){0.f, 0.f, 0.f, 0.f};
    bf16x8 At[4][2], B0[2][2], B1[2][2];
    const char* cA = cur.a; const char* cB = cur.b;
    unsigned vA[4];
    S.a_off(0, cur, tid, g.lda, vA);
    PG8_STAGE(PG8_SB(0, 0), cB, voffB); PG8_STAGE(PG8_SB(0, 1), cB + hB, voffB); PG8_STAGEA(PG8_SA(0, 0), cA, vA, 0); PG8_STAGEA(PG8_SA(0, 1), cA, vA, 1);
    if (wr == 1) PG8_BAR;
    PG8_WAIT_V(2); PG8_BAR;
    PG8_STAGE(PG8_SB(1, 0), cB + kstep, voffB); PG8_STAGEA(PG8_SA(1, 0), cA + kstep, vA, 0); PG8_STAGE(PG8_SB(1, 1), cB + hB + kstep, voffB);
    PG8_WAIT_V(6); PG8_BAR;
    for (;;) {
        const bool has_next = S.next(ui + 1, nxt);
        const char* nA = has_next ? nxt.a : cA; const char* nB = has_next ? nxt.b : cB;
        for (int t = 0; t < nt; t += 2) {
            const bool last = (t == nt - 2);
            const char* a1 = cA + (size_t)(t + 1) * kstep;
            const char* a2 = last ? nA : cA + (size_t)(t + 2) * kstep; const char* b2 = last ? nB : cB + (size_t)(t + 2) * kstep;
            const char* a3 = a2 + kstep; const char* b3 = b2 + kstep;
            PG8_LDB(B0, 0, 0); PG8_LDB(B1, 0, 1); PG8_SCHED; PG8_LDA(At, 0, 0); PG8_STAGEA(PG8_SA(1, 1), a1, vA, 1);
            if constexpr (Sched::GATHER) { if (last && has_next) S.a_off(ui + 1, nxt, my_tid(wv), g.lda, vA); }
            PG8_WAIT_V(8); PG8_WAIT_L(0); PG8_BAR; PG8_MMA(0, 0, At, B0); PG8_MMA(0, 1, At, B1); PG8_BAR; PG8_SCHED;
            PG8_LDA(At, 0, 1); PG8_STAGE(PG8_SB(0, 0), b2, voffB); PG8_STAGE(PG8_SB(0, 1), b2 + hB, voffB); PG8_STAGEA(PG8_SA(0, 0), a2, vA, 0);
            PG8_WAIT_V(8); PG8_WAIT_L(0); PG8_BAR; PG8_MMA(1, 0, At, B0); PG8_MMA(1, 1, At, B1); PG8_BAR; PG8_SCHED;
            PG8_LDB(B0, 1, 0); PG8_LDB(B1, 1, 1); PG8_SCHED; PG8_LDA(At, 1, 0); PG8_STAGEA(PG8_SA(0, 1), a2, vA, 1);
            PG8_WAIT_V(8); PG8_WAIT_L(0); PG8_BAR; PG8_MMA(0, 0, At, B0); PG8_MMA(0, 1, At, B1); PG8_BAR; PG8_SCHED;
            PG8_LDA(At, 1, 1); PG8_STAGE(PG8_SB(1, 0), b3, voffB); PG8_STAGE(PG8_SB(1, 1), b3 + hB, voffB); PG8_STAGEA(PG8_SA(1, 0), a3, vA, 0);
            PG8_WAIT_V(8); PG8_WAIT_L(0); PG8_BAR; PG8_MMA(1, 0, At, B0); PG8_MMA(1, 1, At, B1); PG8_BAR; PG8_SCHED;
        }
        if constexpr (ALIGN_EPI) { if (wr == 0) PG8_BAR; }
        { const int te = my_tid(wv), le = te & 63, we = __builtin_amdgcn_readfirstlane(te >> 6); E(acc, cur, we >> 2, we & 3, le & 15, le >> 4); }
        if (!has_next) break;
#pragma unroll
        for (int a = 0; a < 2; ++a)
#pragma unroll
            for (int b = 0; b < 2; ++b)
#pragma unroll
                for (int m = 0; m < 4; ++m)
#pragma unroll
                    for (int n = 0; n < 2; ++n) acc[a][b][m][n] = (f32x4){0.f, 0.f, 0.f, 0.f};
        cur = nxt; cA = nA; cB = nB; ++ui;
        if constexpr (ALIGN_EPI) { if (wr == 1) PG8_BAR; }
    }
    PG8_WAIT_V(0);
    if constexpr (!ALIGN_EPI) { if (wr == 0) PG8_BAR; }
    PG8_BAR;
#undef PG8_SA
#undef PG8_SB
#undef PG8_STAGE
#undef PG8_STAGEA
#undef PG8_LDA
#undef PG8_LDB
#undef PG8_MMA
#undef PG8_WAIT_V
#undef PG8_WAIT_L
#undef PG8_BAR
#undef PG8_SCHED
}
}
using pg8::cvt_pk_bf16;
typedef f32x4 Acc[2][2][4][2];

__device__ __forceinline__ float bf2f(bf16_t v) { return __uint_as_float(((unsigned)v) << 16); }
__device__ __forceinline__ float siluf(float a) { return a * __builtin_amdgcn_rcpf(1.f + __expf(-a)); }
__device__ __forceinline__ int mod_index(int row) { return row < SEQ ? 0 : (row < ML ? 1 : 2); }

struct EpiIn {
    static constexpr bool PERM = true;
    bf16_t* U; float* R; int floff;
    static __device__ __forceinline__ void st_wt(void* p, u32x4 w) {
        __hip_atomic_store((unsigned long long*)p, (unsigned long long)w.x | ((unsigned long long)w.y << 32), __ATOMIC_RELAXED, __HIP_MEMORY_SCOPE_AGENT);
        __hip_atomic_store((unsigned long long*)p + 1, (unsigned long long)w.z | ((unsigned long long)w.w << 32), __ATOMIC_RELAXED, __HIP_MEMORY_SCOPE_AGENT); }
    __device__ __forceinline__ void operator()(const Acc& acc, const pg8::Unit& u, int wr, int wc, int fr, int fq) const {
        const int row0 = u.pm * 256 + wr * 64 + fr, col0 = u.pn * 256 + wc * 32 + 8 * fq;
        const float sc = (u.pn < 2) ? 0.08838834764831845f : 1.f;
        const bool wt = u.pm >= ML / 256;
#pragma unroll
        for (int ai = 0; ai < 2; ++ai)
#pragma unroll
            for (int m = 0; m < 4; ++m) { const int row = row0 + ai * 128 + m * 16; bf16_t* rowp = U + (size_t)row * INWP + col0;
#pragma unroll
                for (int bj = 0; bj < 2; ++bj) { const f32x4 v0 = acc[ai][bj][m][0] * sc, v1 = acc[ai][bj][m][1] * sc;
                    u32x4 w; w.x = cvt_pk_bf16(v0[0], v0[1]); w.y = cvt_pk_bf16(v0[2], v0[3]); w.z = cvt_pk_bf16(v1[0], v1[1]); w.w = cvt_pk_bf16(v1[2], v1[3]);
                    if (wt) st_wt(rowp + bj * 128, w); else *(u32x4*)(rowp + bj * 128) = w; }
                if (u.pn == 16 && wc == 0) { float* rp = R + (size_t)row * 32 + 8 * fq;
                    if (wt) { st_wt(rp, __builtin_bit_cast(u32x4, acc[ai][0][m][0])); st_wt(rp + 4, __builtin_bit_cast(u32x4, acc[ai][0][m][1])); }
                    else { *(f32x4*)rp = acc[ai][0][m][0]; *(f32x4*)(rp + 4) = acc[ai][0][m][1]; } } }
        if (wt) { asm volatile("s_waitcnt vmcnt(0)" ::: "memory");
            if (fr == 0 && fq == 0) (void)__hip_atomic_fetch_add((unsigned*)((unsigned char*)U - WS_U + WS_CTL) + floff + 64 * (u.pm - ML / 256), 1u, __ATOMIC_RELAXED, __HIP_MEMORY_SCOPE_AGENT); }
    }
};
struct EpiPool {
    static constexpr bool PERM = true;
    bf16_t* Y; const float* scale;
    __device__ __forceinline__ void operator()(const Acc& acc, const pg8::Unit& u, int wr, int wc, int fr, int fq) const {
        const int row0 = u.pm * 256 + wr * 64 + fr, col0 = u.pn * 256 + wc * 32 + 8 * fq;
        f32x4 sv[2][2];
#pragma unroll
        for (int bj = 0; bj < 2; ++bj)
#pragma unroll
            for (int n = 0; n < 2; ++n) sv[bj][n] = *(const f32x4*)(scale + col0 + bj * 128 + 4 * n);
#pragma unroll
        for (int ai = 0; ai < 2; ++ai)
#pragma unroll
            for (int m = 0; m < 4; ++m) { bf16_t* rowp = Y + (size_t)(row0 + ai * 128 + m * 16) * D + 1024 + col0;
#pragma unroll
                for (int bj = 0; bj < 2; ++bj) { const f32x4 v0 = acc[ai][bj][m][0] * sv[bj][0], v1 = acc[ai][bj][m][1] * sv[bj][1];
                    u32x4 w; w.x = cvt_pk_bf16(v0[0], v0[1]); w.y = cvt_pk_bf16(v0[2], v0[3]); w.z = cvt_pk_bf16(v1[0], v1[1]); w.w = cvt_pk_bf16(v1[2], v1[3]);
                    *(u32x4*)(rowp + bj * 128) = w; } }
    }
};
struct EpiResid {
    static constexpr bool PERM = false;
    const float* src_lat; const float* src_ctx; float* XR; const float* gate; const float* rowgate; int rg_stride, ctx_row0;
    __device__ __forceinline__ void operator()(const Acc& acc, const pg8::Unit& u, int wr, int wc, int fr, int fq) const {
        const int row0 = u.pm * 256 + wr * 64 + fr, col0 = u.pn * 256 + wc * 32 + 4 * fq;
        const int mi = u.pm < 16 ? 0 : (u.pm < 32 ? 1 : 2);
        const float* src = u.pm < 32 ? src_lat : src_ctx - (size_t)ctx_row0 * D;
        f32x4 gv[2][2];
#pragma unroll
        for (int bj = 0; bj < 2; ++bj)
#pragma unroll
            for (int n = 0; n < 2; ++n) gv[bj][n] = *(const f32x4*)(gate + (size_t)mi * MODW + col0 + bj * 128 + n * 16);
#pragma unroll
        for (int ai = 0; ai < 2; ++ai)
#pragma unroll
            for (int mp = 0; mp < 2; ++mp) { f32x4 bs[2][2][2];
#pragma unroll
                for (int mm = 0; mm < 2; ++mm) { const size_t off = (size_t)(row0 + ai * 128 + (2 * mp + mm) * 16) * D + col0;
#pragma unroll
                    for (int bj = 0; bj < 2; ++bj)
#pragma unroll
                        for (int n = 0; n < 2; ++n) bs[mm][bj][n] = *(const f32x4*)(src + off + bj * 128 + n * 16); }
#pragma unroll
                for (int mm = 0; mm < 2; ++mm) { const size_t off = (size_t)(row0 + ai * 128 + (2 * mp + mm) * 16) * D + col0;
#pragma unroll
                    for (int bj = 0; bj < 2; ++bj)
#pragma unroll
                        for (int n = 0; n < 2; ++n) *(f32x4*)(XR + off + bj * 128 + n * 16) = bs[mm][bj][n] + gv[bj][n] * acc[ai][bj][2 * mp + mm][n]; } }
    }
};
struct EpiSwiglu {
    static constexpr bool PERM = true;
    bf16_t* H; int ldh, pad;
    __device__ __forceinline__ void operator()(const Acc& acc, const pg8::Unit& u, int wr, int wc, int fr, int fq) const {
        const int row0 = u.pm * 256 + wr * 64 + fr, col0 = u.pn * 128 + wc * 32 + 8 * fq;
#pragma unroll
        for (int ai = 0; ai < 2; ++ai)
#pragma unroll
            for (int m = 0; m < 4; ++m) { bf16_t* rowp = H + (size_t)(row0 + ai * 128 + m * 16) * ldh + col0;
                float h[8];
#pragma unroll
                for (int n = 0; n < 2; ++n)
#pragma unroll
                    for (int j = 0; j < 4; ++j) h[n * 4 + j] = siluf(acc[ai][0][m][n][j]) * acc[ai][1][m][n][j];
                u32x4 w; w.x = cvt_pk_bf16(h[0], h[1]); w.y = cvt_pk_bf16(h[2], h[3]); w.z = cvt_pk_bf16(h[4], h[5]); w.w = cvt_pk_bf16(h[6], h[7]);
                *(u32x4*)rowp = w; }
    }
};

struct EpiSwiglu8 {
    static constexpr bool PERM = true;
    unsigned char* H; int ldh, pad;
    __device__ __forceinline__ void operator()(const Acc& acc, const pg8::Unit& u, int wr, int wc, int fr, int fq) const {
        const int row0 = u.pm * 256 + wr * 64 + fr, col0 = u.pn * 128 + wc * 32 + 8 * fq;
#pragma unroll
        for (int ai = 0; ai < 2; ++ai)
#pragma unroll
            for (int m = 0; m < 4; ++m) { unsigned char* rowp = H + (size_t)(row0 + ai * 128 + m * 16) * ldh + col0;
                float h[8];
#pragma unroll
                for (int n = 0; n < 2; ++n)
#pragma unroll
                    for (int j = 0; j < 4; ++j) h[n * 4 + j] = siluf(acc[ai][0][m][n][j]) * acc[ai][1][m][n][j];
                int x0 = 0, x1 = 0;
                x0 = __builtin_amdgcn_cvt_pk_fp8_f32(h[0], h[1], x0, false); x0 = __builtin_amdgcn_cvt_pk_fp8_f32(h[2], h[3], x0, true);
                x1 = __builtin_amdgcn_cvt_pk_fp8_f32(h[4], h[5], x1, false); x1 = __builtin_amdgcn_cvt_pk_fp8_f32(h[6], h[7], x1, true);
                *(u32x2*)rowp = (u32x2){(unsigned)x0, (unsigned)x1}; }
    }
};
__device__ __forceinline__ void moe_tab_init(const int wv, LAS int* tab, const unsigned* cnt, int nN) {
    if (my_tid(wv) == 0) { int tb = 0, hr = 0;
        for (int e = 0; e < NE; ++e) { const int n = (int)cnt[64 * e], r = (n + 255) >> 8; tab[e] = tb; tab[16 + e] = hr; tab[32 + e] = r; tab[48 + e] = n; tb += r * nN; hr += r; }
        tab[8] = tb; tab[24] = hr; }
    __syncthreads();
}
template <bool GATHER_> struct MoeOrder {
    static constexpr bool GATHER = GATHER_; static constexpr int gather = GATHER_ ? 1 : 0;
    const char* A; const char* Bt; size_t a_mstep, b_estep, b_nstep; const LAS int* tab; const LAS int* rows; int nN, G, c;
    __device__ __forceinline__ bool next(int i, pg8::Unit& u) const {
        const int nwg = __builtin_amdgcn_readfirstlane(tab[8]); const long L = (long)i * G + c; if (L >= nwg || i >= MOE_MAXU) return false;
        int wgid = (int)L; { const int q = nwg / 8, r = nwg % 8, xcd = wgid % 8, off = wgid / 8; wgid = (xcd < r ? xcd * (q + 1) : r * (q + 1) + (xcd - r) * q) + off; }
        int e = 0;
#pragma unroll
        for (int k = 1; k < NE; ++k) e += (wgid >= tab[k]) ? 1 : 0;
        e = __builtin_amdgcn_readfirstlane(e);
        const int loc = wgid - __builtin_amdgcn_readfirstlane(tab[e]), nM = __builtin_amdgcn_readfirstlane(tab[32 + e]);
        const int nig = 8 * nN, gid = loc / nig, fm = gid * 8, gsz = (nM - fm) < 8 ? (nM - fm) : 8;
        u.pml = fm + ((loc % nig) % gsz); u.pn = (loc % nig) / gsz; u.e = e; u.pm = __builtin_amdgcn_readfirstlane(tab[16 + e]) + u.pml;
        u.a = gather ? A : A + (size_t)u.pm * a_mstep; u.b = Bt + (size_t)e * b_estep + (size_t)u.pn * b_nstep; return true;
    }
    __device__ __forceinline__ void a_off(int ui, const pg8::Unit&, int tid, int lda, unsigned (&v)[4]) const {
#pragma unroll
        for (int i = 0; i < 2; ++i) { int R, C; pg8::stage_rc(tid * 16 + i * 8192, R, C);
#pragma unroll
            for (int hh = 0; hh < 2; ++hh) { const int row = gather ? rows[ui * 256 + hh * 128 + R] : (R + hh * 128); v[hh * 2 + i] = (unsigned)(row * lda + C) * 2u; } }
    }
};
struct EpiMoeDown {
    static constexpr bool PERM = true;
    bf16_t* YD;
    __device__ __forceinline__ void operator()(const Acc& acc, const pg8::Unit& u, int wr, int wc, int fr, int fq) const {
        const int row0 = u.pm * 256 + wr * 64 + fr, col0 = u.pn * 256 + wc * 32 + 8 * fq;
#pragma unroll
        for (int ai = 0; ai < 2; ++ai)
#pragma unroll
            for (int m = 0; m < 4; ++m) { bf16_t* rowp = YD + (size_t)(row0 + ai * 128 + m * 16) * D + col0;
#pragma unroll
                for (int bj = 0; bj < 2; ++bj) { const f32x4 v0 = acc[ai][bj][m][0], v1 = acc[ai][bj][m][1];
                    u32x4 w; w.x = cvt_pk_bf16(v0[0], v0[1]); w.y = cvt_pk_bf16(v0[2], v0[3]); w.z = cvt_pk_bf16(v1[0], v1[1]); w.w = cvt_pk_bf16(v1[2], v1[3]);
                    *(u32x4*)(rowp + bj * 128) = w; } }
    }
};
__device__ __forceinline__ float wave_sum(float v) {
#pragma unroll
    for (int o = 1; o < 64; o <<= 1) v += __shfl_xor(v, o);
    return v;
}
__device__ __forceinline__ unsigned f2bf(float f) { unsigned u = __float_as_uint(f); return (u + 0x7fffu + ((u >> 16) & 1u)) >> 16; }
constexpr int NCH = 68, NUN = 8 * NCH, KQ = 320;
constexpr int G1_CUM = 0, G1_QP = 33792, G1_KI = 51200, G1_KT = 68608, G1_VT = 87040, G1_WG = 123904, G1_BG = 140288, G1_AS = G1_QP  , G1_LDS = 141312;
__device__ __forceinline__ int gla_row0(int b, int c) { return c < 4 ? ML + b * CTXL + c * 64 : b * SEQ + (c - 4) * 64; }
__device__ __forceinline__ float bflo(unsigned w) { return __uint_as_float(w << 16); }
__device__ __forceinline__ float bfhi(unsigned w) { return __uint_as_float(w & 0xffff0000u); }
__device__ __forceinline__ float wave_scan_incl(float x, int) {
    x += __builtin_bit_cast(float, __builtin_amdgcn_update_dpp(0, __builtin_bit_cast(int, x), 0x111, 0xf, 0xf, true));
    x += __builtin_bit_cast(float, __builtin_amdgcn_update_dpp(0, __builtin_bit_cast(int, x), 0x112, 0xf, 0xf, true));
    x += __builtin_bit_cast(float, __builtin_amdgcn_update_dpp(0, __builtin_bit_cast(int, x), 0x114, 0xf, 0xf, true));
    x += __builtin_bit_cast(float, __builtin_amdgcn_update_dpp(0, __builtin_bit_cast(int, x), 0x118, 0xf, 0xf, true));
    x += __builtin_bit_cast(float, __builtin_amdgcn_update_dpp(0, __builtin_bit_cast(int, x), 0x142, 0xa, 0xf, false));
    x += __builtin_bit_cast(float, __builtin_amdgcn_update_dpp(0, __builtin_bit_cast(int, x), 0x143, 0xc, 0xf, false));
    return x;
}
__device__ __forceinline__ float log_sigmoid_fast(float x) { return fminf(x, 0.f) - 0.6931471805599453f * __builtin_amdgcn_logf(1.f + __builtin_amdgcn_exp2f(-1.4426950408889634f * fabsf(x))); }

__device__ __forceinline__ void gla_g1_unit(const int wv, LAS unsigned char* lds, int un, const bf16_t* U, const float* R, const float* wg, const float* bg, bf16_t* QAF, bf16_t* BTF, bf16_t* DSF, float* DEC) {
    int tid = my_tid(wv);
    const int lane = tid & 63, wid = __builtin_amdgcn_readfirstlane(tid >> 6), fr = lane & 15, fq = lane >> 4;
    const int bh = un / NCH, c = un % NCH, b = bh >> 2, h = bh & 3;
    const int row0 = gla_row0(b, c);
    LAS float* CUM = (LAS float*)(lds + G1_CUM);
    LAS bf16_t* QP = (LAS bf16_t*)(lds + G1_QP); LAS bf16_t* KI = (LAS bf16_t*)(lds + G1_KI); LAS bf16_t* KT = (LAS bf16_t*)(lds + G1_KT);
    LAS bf16_t* VT = (LAS bf16_t*)(lds + G1_VT); LAS bf16_t* AS = (LAS bf16_t*)(lds + G1_AS);
    LAS float* WG = (LAS float*)(lds + G1_WG); LAS float* BG = (LAS float*)(lds + G1_BG);
    u32x4 qv[2], kv[2];
#pragma unroll
    for (int i = 0; i < 2; ++i) { const int dg = (tid + 512 * i) >> 6;
        qv[i] = *(const u32x4*)(U + (size_t)(row0 + lane) * INWP + C_Q + h * DK + dg * 8); kv[i] = *(const u32x4*)(U + (size_t)(row0 + lane) * INWP + C_K + h * DK + dg * 8); }
    f32x4 rq[2][4];
#pragma unroll
    for (int dr = 0; dr < 2; ++dr) { const float* rp = R + (size_t)(row0 + (dr == 0 ? lane : 63 - lane)) * 32 + dr * 16;
#pragma unroll
        for (int x = 0; x < 4; ++x) rq[dr][x] = *(const f32x4*)(rp + 4 * x); }
    { const int e0 = tid * 8, rw = e0 >> 7, d0 = e0 & 127;
      const f32x4 w0 = *(const f32x4*)(wg + (size_t)rw * 512 + h * DK + d0), w1 = *(const f32x4*)(wg + (size_t)rw * 512 + h * DK + d0 + 4);
      *(LAS f32x4*)(WG + e0) = w0; *(LAS f32x4*)(WG + e0 + 4) = w1;
      if (tid < 64) { const int b0 = tid * 4; *(LAS f32x4*)(BG + b0) = *(const f32x4*)(bg + (size_t)(b0 >> 7) * 512 + h * DK + (b0 & 127)); } }
#pragma unroll
    for (int i = 0; i < 4; ++i) { const int idx = tid + 512 * i, jg = idx >> 6, s = idx & 63;
        const u32x4 q = *(const u32x4*)(U + (size_t)(row0 + s) * INWP + C_V + h * DV + jg * 8);
        LAS bf16_t* vp = VT + (jg * 8) * 72 + s;
        vp[0] = (bf16_t)(q.x & 0xffffu); vp[72] = (bf16_t)(q.x >> 16); vp[144] = (bf16_t)(q.y & 0xffffu); vp[216] = (bf16_t)(q.y >> 16);
        vp[288] = (bf16_t)(q.z & 0xffffu); vp[360] = (bf16_t)(q.z >> 16); vp[432] = (bf16_t)(q.w & 0xffffu); vp[504] = (bf16_t)(q.w >> 16); }
    f32x4 Aacc[2]; Aacc[0] = (f32x4){0.f, 0.f, 0.f, 0.f}; Aacc[1] = (f32x4){0.f, 0.f, 0.f, 0.f};
    __syncthreads();
    for (int dir = 0; dir < 2; ++dir) {
        { const int t = dir == 0 ? lane : 63 - lane;
          const f32x4 r0 = dir == 0 ? rq[0][0] : rq[1][0], r1 = dir == 0 ? rq[0][1] : rq[1][1], r2 = dir == 0 ? rq[0][2] : rq[1][2], r3 = dir == 0 ? rq[0][3] : rq[1][3];
          const float rr[16] = {r0.x, r0.y, r0.z, r0.w, r1.x, r1.y, r1.z, r1.w, r2.x, r2.y, r2.z, r2.w, r3.x, r3.y, r3.z, r3.w};
          for (int dd = 0; dd < 16; dd += 4) { const int d = wid * 16 + dd;
              const f32x4 b4 = *(const LAS f32x4*)(BG + dir * 128 + d);
              float pre[4] = {b4.x, b4.y, b4.z, b4.w};
#pragma unroll
              for (int k = 0; k < 16; ++k) { const f32x4 w4 = *(const LAS f32x4*)(WG + (dir * 16 + k) * 128 + d); pre[0] += rr[k] * w4.x; pre[1] += rr[k] * w4.y; pre[2] += rr[k] * w4.z; pre[3] += rr[k] * w4.w; }
#pragma unroll
              for (int q = 0; q < 4; ++q) CUM[t * 132 + d + q] = wave_scan_incl(log_sigmoid_fast(pre[q]) * (1.f / 16.f), lane); } }
        __syncthreads();
        if (dir == 0) {
#pragma unroll
            for (int i = 0; i < 4; ++i) { const int idx = tid + 512 * i, j = idx >> 3, sg = idx & 7;
                *(u32x4*)(BTF + ((((size_t)un * 16 + (j >> 4)) * 10 + 8 + (sg >> 2)) * 64 + (sg & 3) * 16 + (j & 15)) * 8) = *(const LAS u32x4*)(VT + j * 72 + sg * 8); } }
        const int tl = dir == 0 ? 63 : 0;
#pragma unroll
        for (int i = 0; i < 2; ++i) { const int dg = (tid + 512 * i) >> 6, s = lane;
            const f32x4 c0 = *(const LAS f32x4*)(CUM + s * 132 + dg * 8), c1 = *(const LAS f32x4*)(CUM + s * 132 + dg * 8 + 4);
            const f32x4 l0 = *(const LAS f32x4*)(CUM + tl * 132 + dg * 8), l1 = *(const LAS f32x4*)(CUM + tl * 132 + dg * 8 + 4);
            const float qf[8] = {bflo(qv[i].x), bfhi(qv[i].x), bflo(qv[i].y), bfhi(qv[i].y), bflo(qv[i].z), bfhi(qv[i].z), bflo(qv[i].w), bfhi(qv[i].w)};
            const float kf[8] = {bflo(kv[i].x), bfhi(kv[i].x), bflo(kv[i].y), bfhi(kv[i].y), bflo(kv[i].z), bfhi(kv[i].z), bflo(kv[i].w), bfhi(kv[i].w)};
            const float cc[8] = {c0.x, c0.y, c0.z, c0.w, c1.x, c1.y, c1.z, c1.w}, cl[8] = {l0.x, l0.y, l0.z, l0.w, l1.x, l1.y, l1.z, l1.w};
            float qp[8], ki[8], ke[8];
#pragma unroll
            for (int e = 0; e < 8; ++e) { qp[e] = qf[e] * __expf(cc[e]); ki[e] = kf[e] * __expf(fminf(-cc[e], 80.f)); ke[e] = kf[e] * __expf(cl[e] - cc[e]); }
            u32x4 w; w.x = cvt_pk_bf16(qp[0], qp[1]); w.y = cvt_pk_bf16(qp[2], qp[3]); w.z = cvt_pk_bf16(qp[4], qp[5]); w.w = cvt_pk_bf16(qp[6], qp[7]);
            *(LAS u32x4*)(QP + s * 136 + dg * 8) = w;
            *(u32x4*)(QAF + ((((size_t)un * 4 + (s >> 4)) * 10 + dir * 4 + (dg >> 2)) * 64 + (dg & 3) * 16 + (s & 15)) * 8) = w;
            u32x4 w2; w2.x = cvt_pk_bf16(ki[0], ki[1]); w2.y = cvt_pk_bf16(ki[2], ki[3]); w2.z = cvt_pk_bf16(ki[4], ki[5]); w2.w = cvt_pk_bf16(ki[6], ki[7]);
            *(LAS u32x4*)(KI + s * 136 + dg * 8) = w2;
#pragma unroll
            for (int e = 0; e < 8; ++e) KT[(dg * 8 + e) * 72 + s] = (bf16_t)f2bf(ke[e]);
            if (s == tl) { float* dp = DEC + ((size_t)un * 2 + dir) * 128 + dg * 8;
                *(f32x4*)dp = (f32x4){__expf(cl[0]), __expf(cl[1]), __expf(cl[2]), __expf(cl[3])}; *(f32x4*)(dp + 4) = (f32x4){__expf(cl[4]), __expf(cl[5]), __expf(cl[6]), __expf(cl[7])}; } }
        __syncthreads();
        { const int tb = wid >> 1;
#pragma unroll
          for (int x = 0; x < 2; ++x) { const int sb = (wid & 1) * 2 + x; f32x4 a = (f32x4){0.f, 0.f, 0.f, 0.f};
#pragma unroll
              for (int ks = 0; ks < 4; ++ks) { const bf16x8 Af = *(const LAS bf16x8*)(QP + (tb * 16 + fr) * 136 + ks * 32 + fq * 8), Bf = *(const LAS bf16x8*)(KI + (sb * 16 + fr) * 136 + ks * 32 + fq * 8);
                  a = __builtin_amdgcn_mfma_f32_16x16x32_bf16(Af, Bf, a, 0, 0, 0); }
#pragma unroll
              for (int jj = 0; jj < 4; ++jj) { const int t = tb * 16 + 4 * fq + jj, sx = sb * 16 + fr; const bool keep = dir == 0 ? (sx <= t) : (sx >= t); Aacc[x][jj] += keep ? a[jj] : 0.f; } } }
#pragma unroll
        for (int jbi = 0; jbi < 2; ++jbi) { const int jb = wid * 2 + jbi;
            const bf16x8 Bf0 = *(const LAS bf16x8*)(VT + (jb * 16 + fr) * 72 + fq * 8), Bf1 = *(const LAS bf16x8*)(VT + (jb * 16 + fr) * 72 + 32 + fq * 8);
#pragma unroll
            for (int db = 0; db < 8; ++db) { const bf16x8 Af0 = *(const LAS bf16x8*)(KT + (db * 16 + fr) * 72 + fq * 8), Af1 = *(const LAS bf16x8*)(KT + (db * 16 + fr) * 72 + 32 + fq * 8);
                f32x4 a = (f32x4){0.f, 0.f, 0.f, 0.f};
                a = __builtin_amdgcn_mfma_f32_16x16x32_bf16(Af0, Bf0, a, 0, 0, 0); a = __builtin_amdgcn_mfma_f32_16x16x32_bf16(Af1, Bf1, a, 0, 0, 0);
                u32x2 w; w.x = cvt_pk_bf16(a.x, a.y); w.y = cvt_pk_bf16(a.z, a.w);
                *(u32x2*)(DSF + (((((size_t)un * 2 + dir) * 16 + jb) * 4 + (db >> 1)) * 64 + ((db & 1) * 2 + (fq >> 1)) * 16 + fr) * 8 + (fq & 1) * 4) = w; } }
        __syncthreads();
    }
    { const int tb = wid >> 1;
#pragma unroll
      for (int x = 0; x < 2; ++x) { const int sb = (wid & 1) * 2 + x;
#pragma unroll
          for (int jj = 0; jj < 4; ++jj) AS[(tb * 16 + 4 * fq + jj) * 72 + sb * 16 + fr] = (bf16_t)f2bf(Aacc[x][jj]); } }
    __syncthreads();
    { const int t = tid >> 3, sg = tid & 7;
      *(u32x4*)(QAF + ((((size_t)un * 4 + (t >> 4)) * 10 + 8 + (sg >> 2)) * 64 + (sg & 3) * 16 + (t & 15)) * 8) = *(const LAS u32x4*)(AS + t * 72 + sg * 8); }
    __syncthreads();
}
__device__ __forceinline__ void gla_g3_unit(const int wv, LAS unsigned char* lds, int un, const bf16_t* QAF, const bf16_t* BTF, const bf16_t* U, const float* gain, bf16_t* Y) {
    int tid = my_tid(wv);
    const int lane = tid & 63, wid = __builtin_amdgcn_readfirstlane(tid >> 6), fr = lane & 15, fq = lane >> 4;
    const int bh = un / NCH, c = un % NCH, b = bh >> 2, h = bh & 3, row0 = gla_row0(b, c);
    const int tb = wid & 3, jh = wid >> 2;
    const bf16_t* qa = QAF + ((size_t)un * 4 + tb) * 10 * 512 + lane * 8;
    const bf16_t* bt = BTF + ((size_t)un * 16 + jh * 8) * 10 * 512 + lane * 8;
    f32x4 acc[8];
#pragma unroll
    for (int jb = 0; jb < 8; ++jb) acc[jb] = (f32x4){0.f, 0.f, 0.f, 0.f};
    bf16x8 Bc = *(const bf16x8*)qa, Ac[8];
#pragma unroll
    for (int jb = 0; jb < 8; ++jb) Ac[jb] = *(const bf16x8*)(bt + (size_t)jb * 10 * 512);
#pragma unroll
    for (int ks = 0; ks < 10; ++ks) {
        bf16x8 Bn = Bc, An[8];
#pragma unroll
        for (int jb = 0; jb < 8; ++jb) An[jb] = Ac[jb];
        if (ks < 9) { Bn = *(const bf16x8*)(qa + (ks + 1) * 512);
#pragma unroll
            for (int jb = 0; jb < 8; ++jb) An[jb] = *(const bf16x8*)(bt + ((size_t)jb * 10 + ks + 1) * 512); }
#pragma unroll
        for (int jb = 0; jb < 8; ++jb) acc[jb] = __builtin_amdgcn_mfma_f32_16x16x32_bf16(Ac[jb], Bc, acc[jb], 0, 0, 0);
        Bc = Bn;
#pragma unroll
        for (int jb = 0; jb < 8; ++jb) Ac[jb] = An[jb];
    }
    float ss = 0.f;
#pragma unroll
    for (int jb = 0; jb < 8; ++jb) ss += (acc[jb].x * acc[jb].x + acc[jb].y * acc[jb].y) + (acc[jb].z * acc[jb].z + acc[jb].w * acc[jb].w);
    ss += __shfl_xor(ss, 16); ss += __shfl_xor(ss, 32);
    LAS float* P = (LAS float*)lds;
    if (fq == 0) P[wid * 16 + fr] = ss;
    __syncthreads();
    const float tot = P[wid * 16 + fr] + P[(wid ^ 4) * 16 + fr];
    const float rstd = 1.0f / sqrtf(tot * (1.f / DV) + EPS);
    const int row = row0 + tb * 16 + fr;
#pragma unroll
    for (int jb = 0; jb < 8; ++jb) { const int col = h * DV + jh * 128 + jb * 16 + 4 * fq;
        const f32x4 gn = *(const f32x4*)(gain + col); const u32x2 gw = *(const u32x2*)(U + (size_t)row * INWP + C_G + col);
        const f32x4 o = acc[jb] * rstd * gn;
        u32x2 w; w.x = cvt_pk_bf16(o.x * siluf(bflo(gw.x)), o.y * siluf(bfhi(gw.x))); w.y = cvt_pk_bf16(o.z * siluf(bflo(gw.y)), o.w * siluf(bfhi(gw.y)));
        *(u32x2*)(Y + (size_t)row * D + col) = w; }
    __syncthreads();
}

__device__ __forceinline__ const void* ldptr(volatile LAS unsigned long long* tab, int i) {
    const unsigned long long v = tab[i];
    const unsigned lo = __builtin_amdgcn_readfirstlane((unsigned)v), hi = __builtin_amdgcn_readfirstlane((unsigned)(v >> 32));
    return (const void*)(((unsigned long long)hi << 32) | lo);
}
constexpr int CVT_TILE_F = 128 * 33;
__device__ __forceinline__ void cvt_item(LAS float* t, int lane, const float* srcb, bf16_t* dstb, size_t sms, size_t dms, int K, int N, int nb, int rs, int off, int ktiles, int per, int it) {
    const int lr = lane >> 4, lc = (lane & 15) * 4;
    const int sr = lane >> 3, sk = (lane & 7) * 8;
    const int mat = it / per, r = it % per, nt = r / ktiles, kt = r % ktiles, k0 = kt * 64, n0 = nt * 64;
    const float* src = srcb + (size_t)mat * sms + (size_t)(k0 + lr) * N + n0 + lc;
    const bool inb = (n0 + lc) < N;
    f32x4 v[16];
#pragma unroll
    for (int i = 0; i < 16; ++i) v[i] = inb ? __builtin_nontemporal_load((const f32x4*)(src + (size_t)(4 * i) * N)) : (f32x4){0.f, 0.f, 0.f, 0.f};
#pragma unroll
    for (int i = 0; i < 16; ++i) { LAS float* tp = t + (lr + 4 * i) * 65 + lc; tp[0] = v[i].x; tp[1] = v[i].y; tp[2] = v[i].z; tp[3] = v[i].w; }
    asm volatile("s_waitcnt lgkmcnt(0)" ::: "memory");
    bf16_t* dst = dstb + (size_t)mat * dms;
#pragma unroll
    for (int p = 0; p < 8; ++p) { const int nn = sr + 8 * p, n = n0 + nn; const int drow = (n / nb) * rs + (n % nb) + off;
        const LAS float* tp = t + sk * 65 + nn;
        u32x4 w; w.x = cvt_pk_bf16(tp[0], tp[65]); w.y = cvt_pk_bf16(tp[2 * 65], tp[3 * 65]); w.z = cvt_pk_bf16(tp[4 * 65], tp[5 * 65]); w.w = cvt_pk_bf16(tp[6 * 65], tp[7 * 65]);
        __builtin_nontemporal_store(w, (u32x4*)(dst + (size_t)drow * K + k0 + sk)); }
    asm volatile("s_waitcnt lgkmcnt(0)" ::: "memory");
}
__device__ __forceinline__ void p_convert(const int wv, LAS unsigned char* lds, const float* srcb, bf16_t* dstb, size_t sms, size_t dms, int K, int N, int NP, int nb, int rs, int off, int nmat) {
    int tid = my_tid(wv);
    const int lane = tid & 63, wave = tid >> 6;
    LAS float* t = (LAS float*)lds + wave * CVT_TILE_F;
    const int ktiles = K / 64, ntiles = NP / 64, per = ktiles * ntiles, total = per * nmat;
    for (int it = blockIdx.x * 8 + wave; it < total; it += gridDim.x * 8) cvt_item(t, lane, srcb, dstb, sms, dms, K, N, nb, rs, off, ktiles, per, it);
}
__device__ __forceinline__ void cvt8_item(LAS float* t, int lane, const float* srcb, unsigned char* dstb, size_t sms, size_t dms, int K, int N, int nb, int rs, int off, int ktiles, int per, int it) {
    const int lr = lane >> 3, lc = (lane & 7) * 4;
    const int sr = lane >> 3, sk = (lane & 7) * 16;
    const int mat = it / per, r = it % per, nt = r / ktiles, kt = r % ktiles, k0 = kt * 128, n0 = nt * 32;
    const float* src = srcb + (size_t)mat * sms + (size_t)(k0 + lr) * N + n0 + lc;
    f32x4 v[16];
#pragma unroll
    for (int i = 0; i < 16; ++i) v[i] = __builtin_nontemporal_load((const f32x4*)(src + (size_t)(8 * i) * N));
#pragma unroll
    for (int i = 0; i < 16; ++i) { LAS float* tp = t + (lr + 8 * i) * 33 + lc; tp[0] = v[i].x * 64.f; tp[1] = v[i].y * 64.f; tp[2] = v[i].z * 64.f; tp[3] = v[i].w * 64.f; }
    asm volatile("s_waitcnt lgkmcnt(0)" ::: "memory");
    unsigned char* dst = dstb + (size_t)mat * dms;
#pragma unroll
    for (int p = 0; p < 4; ++p) { const int nn = sr + 8 * p, n = n0 + nn; const int drow = (n / nb) * rs + (n % nb) + off;
        const LAS float* tp = t + sk * 33 + nn;
        unsigned w[4];
#pragma unroll
        for (int q = 0; q < 4; ++q) { int x = 0; x = __builtin_amdgcn_cvt_pk_fp8_f32(tp[(4 * q) * 33], tp[(4 * q + 1) * 33], x, false); x = __builtin_amdgcn_cvt_pk_fp8_f32(tp[(4 * q + 2) * 33], tp[(4 * q + 3) * 33], x, true); w[q] = (unsigned)x; }
        __builtin_nontemporal_store((u32x4){w[0], w[1], w[2], w[3]}, (u32x4*)(dst + (size_t)drow * K + k0 + sk)); }
    asm volatile("s_waitcnt lgkmcnt(0)" ::: "memory");
}
constexpr int CW_Q = 2048, CW_DONE = 2112;
constexpr int QJ_WOUT = (D / 64) * (D / 64), QJ_F13 = (D / 64) * (DFF / 64), QJ_WIN = (D / 64) * (INWP / 64), QJ_MOE = NE * QJ_F13;
constexpr int Q_WOUT0 = QJ_WOUT, Q_F3 = Q_WOUT0 + 2 * QJ_F13, Q_F2 = Q_F3 + QJ_F13, Q_WIN1 = Q_F2 + QJ_WIN, Q_WOUT1 = Q_WIN1 + QJ_WOUT, Q_ALL = Q_WOUT1 + 3 * QJ_MOE;
__device__ __forceinline__ void q_item(LAS float* t, int lane, int item, volatile LAS unsigned long long* PT) {
    unsigned char* ws = (unsigned char*)ldptr(PT, 25);
    const float* src; bf16_t* dst; size_t sms = 0, dms = 0; int K = D, N = D, NP = D, nb = 1 << 30, rs = 0, off = 0, it = item;
    if (item < Q_WOUT0) { src = (const float*)ldptr(PT, 14); dst = (bf16_t*)(ws + WS_WOUT); }
    else if (item < Q_F3) { const int j = (item - Q_WOUT0) / QJ_F13; it = item - Q_WOUT0 - j * QJ_F13; src = (const float*)ldptr(PT, 15 + j); dst = (bf16_t*)(ws + WS_W13); N = DFF; NP = DFF; nb = 128; rs = 256; off = j * 128; }
    else if (item < Q_F2) { it = item - Q_F3; cvt8_item(t, lane, (const float*)ldptr(PT, 17), ws + WS_W2, 0, 0, DFF, D, 1 << 30, 0, 0, DFF / 128, (DFF / 128) * (D / 32), it); return; }
    else if (item < Q_WIN1) { it = item - Q_F2; src = (const float*)ldptr(PT, 8) + (size_t)D * INW; dst = (bf16_t*)(ws + WS_WIN) + (size_t)INWP * D; N = INW; NP = INWP; }
    else if (item < Q_WOUT1) { it = item - Q_WIN1; src = (const float*)ldptr(PT, 14) + (size_t)D * D; dst = (bf16_t*)(ws + WS_WOUT) + (size_t)D * D; }
    else { const int j = (item - Q_WOUT1) / QJ_MOE; it = item - Q_WOUT1 - j * QJ_MOE; src = (const float*)ldptr(PT, 20 + j); sms = (size_t)D * DFF;
        if (j < 2) { cvt8_item(t, lane, src, ws + WS_MW13, sms, (size_t)2 * DFF * D, D, DFF, 128, 256, j * 128, D / 128, (D / 128) * (DFF / 32), it); return; }
        cvt8_item(t, lane, src, ws + WS_MW2, sms, (size_t)D * DFF, DFF, D, 1 << 30, 0, 0, DFF / 128, (DFF / 128) * (D / 32), it); return; }
    cvt_item(t, lane, src, dst, sms, dms, K, N, nb, rs, off, K / 64, (K / 64) * (NP / 64), it);
}
__device__ __forceinline__ void q_help(const int wv, LAS unsigned char* lds, volatile LAS unsigned long long* PT, int phase, int LIMIT, int qoff = 0) {
    int tid = my_tid(wv);
    const int lane = tid & 63, wave = __builtin_amdgcn_readfirstlane(tid >> 6);
    LAS float* t = (LAS float*)lds + wave * CVT_TILE_F;
    volatile LAS unsigned* MISC = (volatile LAS unsigned*)(lds + LDS_MISC);
    unsigned* ctl = (unsigned*)((unsigned char*)ldptr(PT, 25) + WS_CTL);
    const unsigned G = gridDim.x;
    const unsigned per_wave = LIMIT < 0 ? 1u : 6u;
    __syncthreads();
    if (LIMIT < 0 && tid == 0) (void)__hip_atomic_fetch_add(ctl + CW_DONE + 64 * phase, 1u, __ATOMIC_RELAXED, __HIP_MEMORY_SCOPE_AGENT);
    for (;;) {
        if (tid == 0) { unsigned base = 0xffffffffu;
            const bool pull = LIMIT < 0 ? __hip_atomic_load(ctl + CW_DONE + 64 * phase, __ATOMIC_RELAXED, __HIP_MEMORY_SCOPE_AGENT) < G
                                        : __hip_atomic_load(ctl + CW_Q + qoff, __ATOMIC_RELAXED, __HIP_MEMORY_SCOPE_AGENT) < (unsigned)LIMIT;
            if (pull) base = __hip_atomic_fetch_add(ctl + CW_Q + qoff, 8u * per_wave, __ATOMIC_RELAXED, __HIP_MEMORY_SCOPE_AGENT);
            MISC[4] = base; }
        __syncthreads();
        const unsigned base = MISC[4];
        __syncthreads();
        if (base == 0xffffffffu) break;
#pragma unroll 1
        for (unsigned k = 0; k < per_wave; ++k) { const unsigned item = base + 8u * k + wave; if (item < (unsigned)Q_ALL) q_item(t, lane, (int)item, PT); }
        if (base >= (unsigned)Q_ALL) break;
    }
}
__device__ __forceinline__ void p_ada(const int wv, LAS unsigned char* lds, const float* c, const float* c_ctx, const float* w_ada, const float* b_ada, float* modv) {
    int tid = my_tid(wv);
    LAS float* scv = (LAS float*)lds; LAS float* red = scv + 3 * D;
    for (int i = tid; i < 3 * D; i += 512) { const int r = i / D, k = i % D; const float v = r < 2 ? c[r * D + k] : c_ctx[k]; scv[i] = v / (1.f + expf(-v)); }
    __syncthreads();
    for (int cb = blockIdx.x; cb < 2 * MODW / 96; cb += gridDim.x) {
        const int colg = cb * 96, l = colg / MODW, n0 = colg % MODW;
        if (tid < 504) { const int kg = tid / 24, c4 = tid % 24;
            f32x4 a0 = (f32x4){0.f, 0.f, 0.f, 0.f}, a1 = a0, a2 = a0;
            const float* w = w_ada + (size_t)l * D * MODW + n0 + c4 * 4;
            for (int i0 = 0; i0 < 98; i0 += 14) {
                f32x4 wv[14];
#pragma unroll
                for (int i = 0; i < 14; ++i) { const int k = kg + 21 * (i0 + i), kc = k < D ? k : D - 1; wv[i] = __builtin_nontemporal_load((const f32x4*)(w + (size_t)kc * MODW)); }
#pragma unroll
                for (int i = 0; i < 14; ++i) { const int k = kg + 21 * (i0 + i); const bool ok = k < D; const int kc = ok ? k : D - 1;
                    const float s0 = ok ? scv[kc] : 0.f, s1 = ok ? scv[D + kc] : 0.f, s2 = ok ? scv[2 * D + kc] : 0.f; a0 += wv[i] * s0; a1 += wv[i] * s1; a2 += wv[i] * s2; }
            }
            *(LAS f32x4*)(red + kg * 288 + c4 * 4) = a0; *(LAS f32x4*)(red + kg * 288 + 96 + c4 * 4) = a1; *(LAS f32x4*)(red + kg * 288 + 192 + c4 * 4) = a2; }
        __syncthreads();
        if (tid < 288) { const int r = tid / 96, cl = tid % 96; float sacc = 0.f;
#pragma unroll
            for (int kg = 0; kg < 21; ++kg) sacc += red[kg * 288 + tid];
            modv[((size_t)l * 3 + r) * MODW + n0 + cl] = sacc + b_ada[l * MODW + n0 + cl]; }
        __syncthreads();
    }
}
template <bool OUT8> __device__ __forceinline__ void p_ln(const int wv, LAS unsigned char* lds, const float* src_lat, const float* src_ctx, int ctx_row0, const float* gn, const float* sh, const float* sc, bf16_t* XN, int nrows) {
    int tz = my_tid(wv);
    const int lane = tz & 63, gw = blockIdx.x * 8 + (tz >> 6), NGW = gridDim.x * 8;
    LAS f32x4* SA = (LAS f32x4*)lds; LAS f32x4* SB = SA + 3 * (D / 4);
    __syncthreads();
    for (int q = tz; q < 3 * (D / 4); q += 512) { const int mi = q / (D / 4), c4 = q % (D / 4);
        const f32x4 g = *(const f32x4*)(gn + 4 * c4), a = *(const f32x4*)(sc + (size_t)mi * MODW + 4 * c4);
        SA[q] = g * (a + 1.0f); SB[q] = *(const f32x4*)(sh + (size_t)mi * MODW + 4 * c4); }
    __syncthreads();
    for (int row = gw; row < nrows; row += NGW) {
        const float* x = row < ML ? src_lat + (size_t)row * D : src_ctx + (size_t)(row - ctx_row0) * D;
        const int mi = mod_index(row);
        f32x4 v[8]; float s = 0.f;
#pragma unroll
        for (int j = 0; j < 8; ++j) { v[j] = *(const f32x4*)(x + 4 * lane + 256 * j); s += (v[j].x * v[j].x + v[j].y * v[j].y) + (v[j].z * v[j].z + v[j].w * v[j].w); }
        const float rstd = 1.0f / sqrtf(wave_sum(s) * (1.f / D) + EPS);
#pragma unroll
        for (int j = 0; j < 8; ++j) { const int cc = 4 * lane + 256 * j;
            const f32x4 h = v[j] * rstd * SA[mi * (D / 4) + lane + 64 * j] + SB[mi * (D / 4) + lane + 64 * j];
            if constexpr (OUT8) { int x8 = 0; x8 = __builtin_amdgcn_cvt_pk_fp8_f32(h.x, h.y, x8, false); x8 = __builtin_amdgcn_cvt_pk_fp8_f32(h.z, h.w, x8, true); *(unsigned*)((unsigned char*)XN + (size_t)row * D + cc) = (unsigned)x8; }
            else { u32x2 w; w.x = cvt_pk_bf16(h.x, h.y); w.y = cvt_pk_bf16(h.z, h.w); *(u32x2*)(XN + (size_t)row * D + cc) = w; } }
    }
}
__device__ __forceinline__ void p_gla_g2(const int wv, const bf16_t* DSF, const float* DEC, bf16_t* BTF) {
    int tz = my_tid(wv);
    for (int gi = blockIdx.x * 512 + tz; gi < 16 * 16 * 4 * 128; gi += gridDim.x * 512) {
        const int sl = gi & 127, kd = (gi >> 7) & 3, jb = (gi >> 9) & 15, chain = gi >> 13, dir = chain & 1, bh = chain >> 1;
        const int d = kd * 32 + (sl >> 5) * 8 + (sl & 1) * 4;
        f32x4 S = (f32x4){0.f, 0.f, 0.f, 0.f};
        for (int s0 = 0; s0 < NCH; s0 += 17) {
            f32x4 dec[17]; u32x2 q[17];
#pragma unroll
            for (int i = 0; i < 17; ++i) { const int step = s0 + i, c = dir == 0 ? step : (step < 4 ? 3 - step : 71 - step), un = bh * NCH + c;
                dec[i] = *(const f32x4*)(DEC + ((size_t)un * 2 + dir) * 128 + d);
                q[i] = __builtin_nontemporal_load((const u32x2*)(DSF + ((((size_t)un * 2 + dir) * 16 + jb) * 4 + kd) * 512 + sl * 4)); }
#pragma unroll
            for (int i = 0; i < 17; ++i) { const int step = s0 + i, c = dir == 0 ? step : (step < 4 ? 3 - step : 71 - step), un = bh * NCH + c;
                u32x2 w; w.x = cvt_pk_bf16(S.x, S.y); w.y = cvt_pk_bf16(S.z, S.w);
                *(u32x2*)(BTF + (((size_t)un * 16 + jb) * 10 + dir * 4 + kd) * 512 + sl * 4) = w;
                S = dec[i] * S + (f32x4){bflo(q[i].x), bfhi(q[i].x), bflo(q[i].y), bfhi(q[i].y)}; }
        }
    }
}
template <int W> __device__ __forceinline__ void pool_item(const bf16_t* U, bf16_t* MIX, int row, int ch) {
    int L, j, base;
    if (row < ML) { L = 64; j = row & 63; base = row - j; } else { L = CTXL; j = (row - ML) & (CTXL - 1); base = row - j; }
    const bf16_t* up = U + (size_t)base * INWP + C_P + ch;
    u32x4 q[W];
#pragma unroll
    for (int p = 0; p < W; ++p) { const int r = j - W / 2 + p; const bool ok = r >= 0 && r < L; q[p] = ok ? *(const u32x4*)(up + (size_t)r * INWP) : (u32x4){0u, 0u, 0u, 0u}; }
    float s[8];
#pragma unroll
    for (int i = 0; i < 8; ++i) s[i] = 0.f;
#pragma unroll
    for (int p = 0; p < W; ++p) { s[0] += bflo(q[p].x); s[1] += bfhi(q[p].x); s[2] += bflo(q[p].y); s[3] += bfhi(q[p].y); s[4] += bflo(q[p].z); s[5] += bfhi(q[p].z); s[6] += bflo(q[p].w); s[7] += bfhi(q[p].w); }
    int lo = j - W / 2, hi = lo + W; lo = lo < 0 ? 0 : lo; hi = hi > L ? L : hi;
    const u32x4 me = q[W / 2];
    const float inv = 1.f / (float)(hi - lo);
    u32x4 o; o.x = cvt_pk_bf16(s[0] * inv - bflo(me.x), s[1] * inv - bfhi(me.x)); o.y = cvt_pk_bf16(s[2] * inv - bflo(me.y), s[3] * inv - bfhi(me.y));
    o.z = cvt_pk_bf16(s[4] * inv - bflo(me.z), s[5] * inv - bfhi(me.z)); o.w = cvt_pk_bf16(s[6] * inv - bflo(me.w), s[7] * inv - bfhi(me.w));
    *(u32x4*)(MIX + (size_t)row * 1024 + ch) = o;
}
__device__ __forceinline__ void p_pool(const int wv, const bf16_t* U, bf16_t* MIX, int nrows) {
    int tz = my_tid(wv);
    const int per = nrows * 32;
    for (int gi = blockIdx.x * 512 + tz; gi < per; gi += gridDim.x * 512) { const int row = gi >> 5, cb = (gi & 31) * 8;
        pool_item<2>(U, MIX, row, cb); pool_item<4>(U, MIX, row, 256 + cb); pool_item<8>(U, MIX, row, 512 + cb); pool_item<16>(U, MIX, row, 768 + cb); }
}
__device__ __forceinline__ void p_router(const int wv, LAS unsigned char* lds, const float* XR, const float* gn, const float* sh, const float* sc, const float* w_r, const float* b_r, unsigned* cnt, int* list, float* gep, int* slot, unsigned char* XN8) {
    int tz = my_tid(wv);
    const int lane = tz & 63, gw = blockIdx.x * 8 + (tz >> 6), NGW = gridDim.x * 8;
    LAS f32x4* WR = (LAS f32x4*)lds;
    __syncthreads();
    for (int q = tz; q < 4096; q += 512) { const int ln = q & 63, j = (q >> 6) & 7, hf = (q >> 9) & 1, i = q >> 10;
        WR[q] = *(const f32x4*)(w_r + (size_t)(4 * ln + 256 * j + i) * 8 + 4 * hf); }
    LAS f32x4* SA = WR + 4096; LAS f32x4* SB = SA + 2 * (D / 4);
    for (int q = tz; q < 2 * (D / 4); q += 512) { const int mi = q / (D / 4), c4 = q % (D / 4);
        SA[q] = *(const f32x4*)(gn + 4 * c4) * (*(const f32x4*)(sc + (size_t)mi * MODW + 4 * c4) + 1.0f); SB[q] = *(const f32x4*)(sh + (size_t)mi * MODW + 4 * c4); }
    __syncthreads();
    for (int row = gw; row < ML; row += NGW) {
        const float* x = XR + (size_t)row * D; const int mi = mod_index(row);
        float s = 0.f;
#pragma unroll
        for (int j = 0; j < 8; ++j) { const f32x4 v = *(const f32x4*)(x + 4 * lane + 256 * j); s += (v.x * v.x + v.y * v.y) + (v.z * v.z + v.w * v.w); }
        const float rstd = 1.0f / sqrtf(wave_sum(s) * (1.f / D) + EPS);
        float lg0 = 0.f, lg1 = 0.f, lg2 = 0.f, lg3 = 0.f, lg4 = 0.f, lg5 = 0.f, lg6 = 0.f, lg7 = 0.f;
#pragma unroll 1
        for (int j = 0; j < 8; ++j) { const int cc = 4 * lane + 256 * j;
            const f32x4 v = *(const f32x4*)(x + cc);
            const f32x4 h = v * rstd * SA[mi * (D / 4) + lane + 64 * j] + SB[mi * (D / 4) + lane + 64 * j];
            { int x8 = 0; x8 = __builtin_amdgcn_cvt_pk_fp8_f32(h.x, h.y, x8, false); x8 = __builtin_amdgcn_cvt_pk_fp8_f32(h.z, h.w, x8, true); *(unsigned*)(XN8 + (size_t)row * D + cc) = (unsigned)x8; }
#pragma unroll
            for (int i = 0; i < 4; ++i) { const f32x4 w0 = WR[((i * 2 + 0) * 8 + j) * 64 + lane], w1 = WR[((i * 2 + 1) * 8 + j) * 64 + lane];
                lg0 += h[i] * w0.x; lg1 += h[i] * w0.y; lg2 += h[i] * w0.z; lg3 += h[i] * w0.w; lg4 += h[i] * w1.x; lg5 += h[i] * w1.y; lg6 += h[i] * w1.z; lg7 += h[i] * w1.w; } }
        float lg[8] = {lg0, lg1, lg2, lg3, lg4, lg5, lg6, lg7};
#pragma unroll
        for (int e = 0; e < 8; ++e) lg[e] = wave_sum(lg[e]) + b_r[e];
        int i0 = 0; float m0 = lg[0];
#pragma unroll
        for (int e = 1; e < 8; ++e) if (lg[e] > m0) { m0 = lg[e]; i0 = e; }
        int i1 = -1; float m1 = -3.0e38f;
#pragma unroll
        for (int e = 0; e < 8; ++e) if (e != i0 && lg[e] > m1) { m1 = lg[e]; i1 = e; }
        const float p1 = expf(m1 - m0), g0 = 1.f / (1.f + p1), g1 = p1 / (1.f + p1);
        if (lane == 0) {
            const unsigned q0 = atomicAdd(cnt + 64 * i0, 1u), q1 = atomicAdd(cnt + 64 * i1, 1u);
            list[(size_t)i0 * 8192 + q0] = row; list[(size_t)i1 * 8192 + q1] = row; gep[(size_t)i0 * 8192 + q0] = g0; gep[(size_t)i1 * 8192 + q1] = g1;
            slot[row * 2] = i0 * 8192 + (int)q0; slot[row * 2 + 1] = i1 * 8192 + (int)q1; }
    }
}
__device__ __forceinline__ void p_final(const int wv, LAS unsigned char* lds, const float* XR, const bf16_t* YD, const int* slot, const float* gep, const unsigned* cnt, const float* g2, const float* gn, float* out) {
    int tz = my_tid(wv);
    const int lane = tz & 63, gw = blockIdx.x * 8 + (tz >> 6), NGW = gridDim.x * 8;
    LAS f32x4* G2 = (LAS f32x4*)lds; LAS f32x4* FG = G2 + 2 * (D / 4);
    __syncthreads();
    for (int q = tz; q < 3 * (D / 4); q += 512) { const int mi = q / (D / 4), c4 = q % (D / 4); G2[q] = mi < 2 ? *(const f32x4*)(g2 + (size_t)mi * MODW + 4 * c4) : *(const f32x4*)(gn + 4 * c4); }
    __syncthreads();
    for (int row = gw; row < ML; row += NGW) {
        const float* x = XR + (size_t)row * D; const int mi = mod_index(row);
        const int s0 = slot[row * 2], s1 = slot[row * 2 + 1], e0 = s0 >> 13, e1 = s1 >> 13;
        const float ga = gep[s0], gb = gep[s1];
        int h0 = 0, h1 = 0;
#pragma unroll
        for (int e = 0; e < NE; ++e) { const int r = ((int)cnt[64 * e] + 255) >> 8; h0 += e < e0 ? r : 0; h1 += e < e1 ? r : 0; }
        const bf16_t* y0 = YD + ((size_t)h0 * 256 + (s0 & 8191)) * D; const bf16_t* y1 = YD + ((size_t)h1 * 256 + (s1 & 8191)) * D;
        f32x4 v[8]; float s = 0.f;
#pragma unroll
        for (int j = 0; j < 8; ++j) { const int cc = 4 * lane + 256 * j; const u32x2 a = *(const u32x2*)(y0 + cc), b = *(const u32x2*)(y1 + cc);
            const f32x4 ya = (f32x4){ga * bflo(a.x) + gb * bflo(b.x), ga * bfhi(a.x) + gb * bfhi(b.x), ga * bflo(a.y) + gb * bflo(b.y), ga * bfhi(a.y) + gb * bfhi(b.y)};
            v[j] = *(const f32x4*)(x + cc) + G2[mi * (D / 4) + lane + 64 * j] * ya;
            s += (v[j].x * v[j].x + v[j].y * v[j].y) + (v[j].z * v[j].z + v[j].w * v[j].w); }
        const float rstd = 1.0f / sqrtf(wave_sum(s) * (1.f / D) + EPS);
#pragma unroll
        for (int j = 0; j < 8; ++j) { const int cc = 4 * lane + 256 * j; *(f32x4*)(out + (size_t)row * D + cc) = v[j] * rstd * FG[lane + 64 * j]; }
    }
}

#define XB_TMO      128
#define XB_XCNT(j)  (256  + 64 * (j))
#define XB_XSUB(j)  (1280 + 64 * (j))
#define XB_XGEN(j)  (2304 + 64 * (j))
#define XB_TOP      3328
#define XB_TOPGEN   3392
#define XCD_BAR_WORDS 3456
#define XB_SPIN_CAP (1u << 18)

__device__ __forceinline__ unsigned xb_ld(unsigned* p)              { return __hip_atomic_load(p, __ATOMIC_RELAXED, __HIP_MEMORY_SCOPE_AGENT); }
__device__ __forceinline__ unsigned xb_add(unsigned* p, unsigned v) { return __hip_atomic_fetch_add(p, v, __ATOMIC_RELAXED, __HIP_MEMORY_SCOPE_AGENT); }
__device__ __forceinline__ unsigned xb_xcc_id() { return (unsigned)__builtin_amdgcn_s_getreg((3 << 11) | 20) & 0xFu; }
#define XB_SPIN(cond, bar) do { unsigned _sp = 0; while (cond) { __builtin_amdgcn_s_sleep(1); \
    if ((++_sp & 255u) == 0u) { if (xb_ld(&(bar)[XB_TMO])) break; if (_sp > XB_SPIN_CAP) { atomicAdd(&(bar)[XB_TMO], 1u); break; } } } } while (0)

struct XcdBarrier {
    unsigned* bar; unsigned x;
    volatile LAS unsigned* st;
};

__device__ __forceinline__ XcdBarrier xcd_barrier_post(unsigned* bar, volatile LAS unsigned* st) {
    XcdBarrier b; b.bar = bar; b.x = xb_xcc_id(); b.st = st;
    if (threadIdx.x == 0) (void)xb_add(&bar[XB_XCNT(b.x)], 1u);
    return b;
}
__device__ __forceinline__ void xcd_barrier_complete(unsigned* bar, unsigned x, unsigned& nloc, unsigned& nx) {
    const unsigned G = gridDim.x * gridDim.y * gridDim.z;
    unsigned sum, cnt, mine, sp = 0u;
    for (;;) {
        sum = 0u; cnt = 0u; mine = 0u;
#pragma unroll
        for (unsigned j = 0; j < 16; ++j) { const unsigned c = xb_ld(&bar[XB_XCNT(j)]); sum += c; cnt += (c > 0u) ? 1u : 0u; mine = (j == x) ? c : mine; }
        if (sum == G) break;
        __builtin_amdgcn_s_sleep(1);
        if ((++sp & 255u) == 0u) { if (xb_ld(&bar[XB_TMO])) break; if (sp > XB_SPIN_CAP) { atomicAdd(&bar[XB_TMO], 1u); break; } }
    }
    nloc = mine > 0u ? mine : 1u; nx = cnt > 0u ? cnt : 1u;
}

__device__ __forceinline__ void xcd_barrier(const XcdBarrier& b, const int wv) {
    asm volatile("s_waitcnt vmcnt(0)" ::: "memory");
    __syncthreads();
    if (my_tid(wv) == 0) {
        unsigned* bar = b.bar;
        __builtin_amdgcn_s_waitcnt(0);
        unsigned nloc = b.st[0], nx = b.st[1];
        if (nloc == 0u) { xcd_barrier_complete(bar, b.x, nloc, nx); b.st[0] = nloc; b.st[1] = nx; }
        const unsigned old = xb_add(&bar[XB_XSUB(b.x)], 1u);
        const unsigned gen = old / nloc;
        if (old + 1u == (gen + 1u) * nloc) {
            __builtin_amdgcn_fence(__ATOMIC_RELEASE, "agent");
            asm volatile("s_waitcnt vmcnt(0)" ::: "memory");
            const unsigned og = xb_add(&bar[XB_TOP], 1u);
            const unsigned tg = og / nx;
            if (og + 1u == (tg + 1u) * nx) xb_add(&bar[XB_TOPGEN], 1u);
            else XB_SPIN(xb_ld(&bar[XB_TOPGEN]) == tg, bar);
            __builtin_amdgcn_fence(__ATOMIC_ACQUIRE, "agent");
            xb_add(&bar[XB_XGEN(b.x)], 1u);
            asm volatile("s_waitcnt vmcnt(0)" ::: "memory");
        } else {
            XB_SPIN(xb_ld(&bar[XB_XGEN(b.x)]) == gen, bar);
            __builtin_amdgcn_fence(__ATOMIC_ACQUIRE, "agent");
            asm volatile("s_waitcnt vmcnt(0)" ::: "memory");
        }
    }
    __syncthreads();
}

constexpr int CW_FLG = 3584;
constexpr int CW_BAR = 4096;
constexpr int LDS_BYTES = LDS_MISC + 64 + 256;
static_assert(MOE_LDS <= LDS_MISC && G1_LDS <= LDS_MISC, "LDS map");
#ifndef MK_PER_PHASE
#define MK_PER_PHASE 0
#endif
constexpr int NPHASE = 20;

#define RUN(p) (lo <= (p) && (p) < hi)
#define SEAM(p) do { if (RUN(p) && RUN((p) + 1)) xcd_barrier(bar, wv); } while (0)
#define PTR(i) ((const float*)ldptr(PT, (i)))
#define WSP ((unsigned char*)ldptr(PT, 25))
#define HELP(ph) q_help(wv, lds, PT, (ph), -1)
#define DRAINQ(n) q_help(wv, lds, PT, 0, (n))
template <int l> __device__ __forceinline__ void layer_phases(const int wv, LAS unsigned char* lds, volatile LAS unsigned long long* PT, const int lo, const int hi, const XcdBarrier& bar, const int G, const int blk) {
        const int pb = 1 + 9 * l;
        const int ctx_row0 = l == 0 ? ML : 0;
        const int nMo = (l == 0) ? MA / 256 : ML / 256;
        if (RUN(pb + 0)) { unsigned char* ws = WSP; const float* modv_l = (const float*)(ws + WS_MODV) + (size_t)l * 3 * MODW; const float* XRc = (const float*)(ws + WS_XR);
            p_ln<false>(wv, lds, l == 0 ? PTR(0) : XRc, l == 0 ? PTR(2) : XRc, ctx_row0, PTR(6) + l * D, modv_l + 0, modv_l + D, (bf16_t*)(ws + WS_XN), MA);
            if constexpr (l == 1) DRAINQ(Q_WIN1); }
        SEAM(pb + 0);
        if (RUN(pb + 1)) { unsigned char* ws = WSP;
            pg8::TileOrder S; S.A = (const char*)(ws + WS_XN); S.Bt = (const char*)((bf16_t*)(ws + WS_WIN) + (size_t)l * INWP * D); S.a_mstep = (size_t)256 * D * 2; S.a_nstep = 0; S.b_nstep = (size_t)256 * D * 2;
            S.nM = MA / 256; S.nN = INWP / 256; S.nwg = S.nM * S.nN; S.G = G; S.c = blk; S.pre = 2;
            pg8::Gemm g; g.K = D; g.lda = D; g.ldb = D; g.pad = 0;
            EpiIn E; E.U = (bf16_t*)(ws + WS_U); E.R = (float*)(ws + WS_R); E.floff = CW_FLG + 128 * l;
            pg8::gemm_phase<EpiIn, pg8::TileOrder, true>(wv, lds, g, S, E);
            if (blk >= G - 32) {
                const int j = blk - (G - 32), bh = j >> 2, c = j & 3;
                if (my_tid(wv) == 0) { unsigned* fw = (unsigned*)(ws + WS_CTL) + CW_FLG + 128 * l + 64 * (bh >> 2);
                    XB_SPIN(xb_ld(fw) < 136u, bar.bar);
                    __builtin_amdgcn_fence(__ATOMIC_ACQUIRE, "agent"); asm volatile("s_waitcnt vmcnt(0)" ::: "memory"); }
                __syncthreads();
                gla_g1_unit(wv, lds, bh * NCH + c, (const bf16_t*)(ws + WS_U), (const float*)(ws + WS_R), PTR(9) + (size_t)l * 2 * 16 * 512, PTR(10) + (size_t)l * 2 * 512, (bf16_t*)(ws + WS_QA), (bf16_t*)(ws + WS_BT), (bf16_t*)(ws + WS_DS), (float*)(ws + WS_DEC)); }
            HELP(pb + 1);
        }
        SEAM(pb + 1);
        if (RUN(pb + 2)) { unsigned char* ws = WSP; const float* wgp = PTR(9) + (size_t)l * 2 * 16 * 512; const float* bgp = PTR(10) + (size_t)l * 2 * 512;
            for (int v = blk; v < NUN - 32; v += G) gla_g1_unit(wv, lds, (v >> 6) * NCH + 4 + (v & 63), (const bf16_t*)(ws + WS_U), (const float*)(ws + WS_R), wgp, bgp, (bf16_t*)(ws + WS_QA), (bf16_t*)(ws + WS_BT), (bf16_t*)(ws + WS_DS), (float*)(ws + WS_DEC));
            p_pool(wv, (const bf16_t*)(ws + WS_U), (bf16_t*)(ws + WS_MIX), MA);
        }
        SEAM(pb + 2);
        if (RUN(pb + 3)) { unsigned char* ws = WSP;
            p_gla_g2(wv, (const bf16_t*)(ws + WS_DS), (const float*)(ws + WS_DEC), (bf16_t*)(ws + WS_BT));
        }
        SEAM(pb + 3);
        if (RUN(pb + 4)) { unsigned char* ws = WSP; const float* gain = PTR(11) + l * 1024;
            if (blk >= G - 136) { pg8::TileOrder S; S.A = (const char*)(ws + WS_MIX); S.Bt = (const char*)((bf16_t*)(ws + WS_WPOOL) + (size_t)l * 4 * 256 * 256); S.a_mstep = (size_t)256 * 1024 * 2; S.a_nstep = (size_t)256 * 2; S.b_nstep = (size_t)256 * 256 * 2;
              S.nM = MA / 256; S.nN = 4; S.nwg = S.nM * S.nN; S.G = 136; S.c = blk - (G - 136);
              pg8::Gemm g; g.K = 256; g.lda = 1024; g.ldb = 256; g.pad = 0;
              EpiPool E; E.Y = (bf16_t*)(ws + WS_Y); E.scale = PTR(13) + l * 1024;
              pg8::gemm_phase<EpiPool, pg8::TileOrder, true>(wv, lds, g, S, E); }
            for (int un = blk; un < NUN; un += G) { if (l == 1 && (un % NCH) < 4) continue; gla_g3_unit(wv, lds, un, (const bf16_t*)(ws + WS_QA), (const bf16_t*)(ws + WS_BT), (const bf16_t*)(ws + WS_U), gain, (bf16_t*)(ws + WS_Y)); }
            DRAINQ(l == 0 ? Q_WOUT0 : Q_WOUT1);
        }
        SEAM(pb + 4);
        if (RUN(pb + 5)) { unsigned char* ws = WSP; const float* modv_l = (const float*)(ws + WS_MODV) + (size_t)l * 3 * MODW; float* XR = (float*)(ws + WS_XR);
            pg8::TileOrder S; S.A = (const char*)(ws + WS_Y); S.Bt = (const char*)((bf16_t*)(ws + WS_WOUT) + (size_t)l * D * D); S.a_mstep = (size_t)256 * D * 2; S.a_nstep = 0; S.b_nstep = (size_t)256 * D * 2;
            S.nM = nMo; S.nN = D / 256; S.nwg = S.nM * S.nN; S.G = G; S.c = blk;
            pg8::Gemm g; g.K = D; g.lda = D; g.ldb = D; g.pad = 0;
            EpiResid E; E.src_lat = l == 0 ? PTR(0) : XR; E.src_ctx = l == 0 ? PTR(2) : XR; E.XR = XR; E.gate = modv_l + 2 * D; E.rowgate = nullptr; E.rg_stride = 0; E.ctx_row0 = ctx_row0;
            pg8::gemm_phase<EpiResid, pg8::TileOrder, true>(wv, lds, g, S, E);
            if constexpr (l == 0) HELP(pb + 5);
        }
        SEAM(pb + 5);
        if (RUN(pb + 6)) { unsigned char* ws = WSP; const float* modv_l = (const float*)(ws + WS_MODV) + (size_t)l * 3 * MODW; const float* XR = (const float*)(ws + WS_XR);
            if constexpr (l == 0) p_ln<false>(wv, lds, XR, XR, 0, PTR(7) + l * D, modv_l + 3 * D, modv_l + 4 * D, (bf16_t*)(ws + WS_XN), nMo * 256);
            if constexpr (l == 0) DRAINQ(Q_F3); else DRAINQ(Q_ALL);
            if constexpr (l == 1) p_router(wv, lds, XR, PTR(7) + l * D, modv_l + 3 * D, modv_l + 4 * D, PTR(18), PTR(19), (unsigned*)(ws + WS_CTL) + CW_CNT, (int*)(ws + WS_LIST), (float*)(ws + WS_GEP), (int*)(ws + WS_SLOT), ws + WS_XN);
        }
        SEAM(pb + 6);
        if (RUN(pb + 7)) { unsigned char* ws = WSP;
            if constexpr (l == 0) {
                pg8::TileOrder S; S.A = (const char*)(ws + WS_XN); S.Bt = (const char*)(ws + WS_W13); S.a_mstep = (size_t)256 * D * 2; S.a_nstep = 0; S.b_nstep = (size_t)256 * D * 2;
                S.nM = MA / 256; S.nN = 2 * DFF / 256; S.nwg = S.nM * S.nN; S.G = G; S.c = blk;
                pg8::Gemm g; g.K = D; g.lda = D; g.ldb = D; g.pad = 0;
                EpiSwiglu8 E; E.H = ws + WS_HH; E.ldh = DFF; E.pad = 0;
                pg8::gemm_phase<EpiSwiglu8, pg8::TileOrder, true>(wv, lds, g, S, E);
                HELP(pb + 7); DRAINQ(Q_F2);
            } else {
                LAS int* tab = (LAS int*)(lds + MOE_TAB); LAS int* rows = (LAS int*)(lds + MOE_ROWS);
                moe_tab_init(wv, tab, (const unsigned*)(ws + WS_CTL) + CW_CNT, 2 * DFF / 256);
                MoeOrder<true> S; S.A = (const char*)(ws + WS_XN); S.Bt = (const char*)(ws + WS_MW13); S.a_mstep = 0; S.b_estep = (size_t)2 * DFF * D; S.b_nstep = (size_t)256 * D; S.tab = tab; S.rows = rows; S.nN = 2 * DFF / 256; S.G = G; S.c = blk;
                { pg8::Unit u; const int* LIST = (const int*)(ws + WS_LIST);
                  for (int ui = 0; S.next(ui, u); ++ui) { const int n = tab[48 + u.e];
                      for (int r = my_tid(wv); r < 256; r += 512) { const int p = u.pml * 256 + r; rows[ui * 256 + r] = LIST[(size_t)u.e * 8192 + (p < n ? p : 0)]; } }
                  __syncthreads(); }
                pg8::Gemm g; g.K = D / 2; g.lda = D / 2; g.ldb = D / 2; g.pad = 0;
                EpiSwiglu8 E; E.H = ws + WS_HH; E.ldh = DFF; E.pad = 0;
                pg8::gemm_phase<EpiSwiglu8, MoeOrder<true>, true, true>(wv, lds, g, S, E);
            }
        }
        SEAM(pb + 7);
        if (RUN(pb + 8)) { unsigned char* ws = WSP;
            if constexpr (l == 0) { const float* modv_l = (const float*)(ws + WS_MODV); float* XR = (float*)(ws + WS_XR);
                pg8::TileOrder S; S.A = (const char*)(ws + WS_HH); S.Bt = (const char*)(ws + WS_W2); S.a_mstep = (size_t)256 * DFF; S.a_nstep = 0; S.b_nstep = (size_t)256 * DFF;
                S.nM = MA / 256; S.nN = D / 256; S.nwg = S.nM * S.nN; S.G = G; S.c = blk;
                pg8::Gemm g; g.K = DFF / 2; g.lda = DFF / 2; g.ldb = DFF / 2; g.pad = 0;
                EpiResid E; E.src_lat = XR; E.src_ctx = XR; E.XR = XR; E.gate = modv_l + 5 * D; E.rowgate = nullptr; E.rg_stride = 0; E.ctx_row0 = 0;
                pg8::gemm_phase<EpiResid, pg8::TileOrder, true, true>(wv, lds, g, S, E);
                HELP(pb + 8);
            } else {
                LAS int* tab = (LAS int*)(lds + MOE_TAB); LAS int* rows = (LAS int*)(lds + MOE_ROWS);
                moe_tab_init(wv, tab, (const unsigned*)(ws + WS_CTL) + CW_CNT, D / 256);
                MoeOrder<false> S; S.A = (const char*)(ws + WS_HH); S.Bt = (const char*)(ws + WS_MW2); S.a_mstep = (size_t)256 * DFF; S.b_estep = (size_t)D * DFF; S.b_nstep = (size_t)256 * DFF; S.tab = tab; S.rows = rows; S.nN = D / 256; S.G = G; S.c = blk;
                pg8::Gemm g; g.K = DFF / 2; g.lda = DFF / 2; g.ldb = DFF / 2; g.pad = 0;
                EpiMoeDown E; E.YD = (bf16_t*)(ws + WS_YD);
                pg8::gemm_phase<EpiMoeDown, MoeOrder<false>, true, true>(wv, lds, g, S, E);
            }
        }
        SEAM(pb + 8);
}

struct Args { const float* in[24]; float* out; unsigned char* ws; int ph_lo, ph_hi; };
__global__ void __launch_bounds__(512, 2) mk_fwd(Args args) {
    extern __shared__ __attribute__((aligned(16))) unsigned char lds_raw[];
    LAS unsigned char* lds = (LAS unsigned char*)lds_raw;
    volatile LAS unsigned* MISC = (volatile LAS unsigned*)(lds + LDS_MISC);
    const int wv = __builtin_amdgcn_readfirstlane((int)threadIdx.x >> 6);
    if (threadIdx.x < 16) MISC[threadIdx.x] = 0u;
    __syncthreads();
    volatile LAS unsigned long long* PT = (volatile LAS unsigned long long*)(lds + LDS_MISC + 64);
    if (threadIdx.x < 24) PT[threadIdx.x] = (unsigned long long)args.in[threadIdx.x];
    if (threadIdx.x == 24) PT[24] = (unsigned long long)args.out;
    if (threadIdx.x == 25) PT[25] = (unsigned long long)args.ws;
    __syncthreads();
    const int lo = args.ph_lo, hi = args.ph_hi;
    XcdBarrier bar; bar.bar = (unsigned*)(args.ws + WS_CTL) + CW_BAR; bar.x = 0; bar.st = MISC;
    if (hi - lo > 1) bar = xcd_barrier_post((unsigned*)(args.ws + WS_CTL) + CW_BAR, MISC);
    const int G = gridDim.x, blk = blockIdx.x;

    if (RUN(0)) {
        unsigned char* ws = WSP;
        p_ada(wv, lds, PTR(1), PTR(3), PTR(4), PTR(5), (float*)(ws + WS_MODV));
        p_convert(wv, lds, PTR(8), (bf16_t*)(ws + WS_WIN), (size_t)D * INW, (size_t)INWP * D, D, INW, INWP, 1 << 30, 0, 0, 1);
        p_convert(wv, lds, PTR(12), (bf16_t*)(ws + WS_WPOOL), (size_t)256 * 256, (size_t)256 * 256, 256, 256, 256, 1 << 30, 0, 0, 8);
    }
    SEAM(0);
    layer_phases<0>(wv, lds, PT, lo, hi, bar, G, blk);
    layer_phases<1>(wv, lds, PT, lo, hi, bar, G, blk);
    if (RUN(19)) { unsigned char* ws = WSP;
        p_final(wv, lds, (const float*)(ws + WS_XR), (const bf16_t*)(ws + WS_YD), (const int*)(ws + WS_SLOT), (const float*)(ws + WS_GEP), (const unsigned*)(ws + WS_CTL) + CW_CNT, (const float*)(ws + WS_MODV) + 3 * MODW + 5 * D, PTR(23), (float*)ldptr(PT, 24)); }
#undef RUN
#undef SEAM
#undef PTR
#undef WSP
}

extern "C" void kernel_launch(void* const* d_in, const int* in_sizes, int n_in, void* d_out, int out_size, void* d_ws, size_t ws_size, hipStream_t stream) {
    if (n_in != 24 || ws_size < WS_END || out_size != ML * D) { fprintf(stderr, "kernel_launch: unexpected sizes (n_in %d, ws %zu, out %d)\n", n_in, ws_size, out_size); return; }
    static int grid = 0;
    if (grid == 0) {
        int dev = 0, cus = 0, per_cu = 0;
        if (hipGetDevice(&dev) != hipSuccess || hipDeviceGetAttribute(&cus, hipDeviceAttributeMultiprocessorCount, dev) != hipSuccess) { grid = -1; return; }
        if (hipFuncSetAttribute((const void*)mk_fwd, hipFuncAttributeMaxDynamicSharedMemorySize, LDS_BYTES) != hipSuccess) { fprintf(stderr, "kernel_launch: hipFuncSetAttribute failed\n"); grid = -1; return; }
        if (hipOccupancyMaxActiveBlocksPerMultiprocessor(&per_cu, (const void*)mk_fwd, 512, LDS_BYTES) != hipSuccess || per_cu < 1) fprintf(stderr, "kernel_launch: occupancy query reports %d\n", per_cu);
        (void)hipGetLastError();
        grid = cus;
    }
    if (grid < 0) return;
    (void)hipMemsetAsync((char*)d_ws + WS_CTL, 0, 1 * MiB, stream);
    Args a; memset(&a, 0, sizeof a);
    for (int i = 0; i < 24; ++i) a.in[i] = (const float*)d_in[i];
    a.out = (float*)d_out; a.ws = (unsigned char*)d_ws;
#if MK_PER_PHASE
    for (int p = 0; p < NPHASE; ++p) { a.ph_lo = p; a.ph_hi = p + 1; hipLaunchKernelGGL(mk_fwd, dim3(grid), dim3(512), LDS_BYTES, stream, a); }
#else
    a.ph_lo = 0; a.ph_hi = NPHASE; hipLaunchKernelGGL(mk_fwd, dim3(grid), dim3(512), LDS_BYTES, stream, a);
#endif
#ifdef MK_PROBE_MASK
    for (int p = 0; p < NPHASE; ++p) if ((MK_PROBE_MASK >> p) & 1) { a.ph_lo = p; a.ph_hi = p + 1; hipLaunchKernelGGL(mk_fwd, dim3(grid), dim3(512), LDS_BYTES, stream, a); }
#endif
}
```
